# Optimizing an MI355X kernel written in HIP

```python
import math
import jax, jax.numpy as jnp
from jax import lax
import numpy as np

D_MODEL = 2048
BATCH = 4
SEQ = 4096
DEPTH = 2

PLE_DIM = 256
EPS = 1e-6
MIX_WIDTH = D_MODEL
ATTN_WIDTH = D_MODEL // 2
POOL_WIDTH = D_MODEL // 4
CONV_WIDTH = D_MODEL // 4
ATTN_HEAD_DIM = 64
ATTN_V_DIM = 2 * ATTN_HEAD_DIM
N_ATTN_HEADS = ATTN_WIDTH // ATTN_V_DIM
QK_COLS = N_ATTN_HEADS * 2 * ATTN_HEAD_DIM
ROPE_DIM = ATTN_HEAD_DIM // 4
ROPE_THETA = 500000.0
Q_BLOCK = 128
SUBLN_EPS = 1e-5
POOL_WINDOWS = (2, 4, 8, 16)
N_POOL_GROUPS = len(POOL_WINDOWS)
POOL_GROUP_DIM = POOL_WIDTH // N_POOL_GROUPS
CONV_KERNEL = 31
LN_EPS = 1e-5
IN_COLS = 2 * QK_COLS + ATTN_WIDTH + POOL_WIDTH + 2 * CONV_WIDTH
SPLIT_POINTS = (QK_COLS, 2 * QK_COLS, 2 * QK_COLS + ATTN_WIDTH, 2 * QK_COLS + ATTN_WIDTH + POOL_WIDTH)
D_FF = 7 * D_MODEL // 2
N_EXPERTS = 8
TOP_K = 2
N_DENSE = (DEPTH + 1) // 2
N_MOE = DEPTH // 2

kernel_name = "hybrid_diffattn_pool_conformer_moe_ple"


def rmsnorm(x, g, eps=EPS):
    x32 = x.astype(jnp.float32)
    y = x32 * lax.rsqrt(jnp.mean(x32 * x32, axis=-1, keepdims=True) + eps)
    return (y * g.astype(jnp.float32)).astype(x.dtype)


def layernorm(x, g, b, eps=LN_EPS):
    x32 = x.astype(jnp.float32)
    mu = jnp.mean(x32, axis=-1, keepdims=True)
    xc = x32 - mu
    y = xc * lax.rsqrt(jnp.mean(xc * xc, axis=-1, keepdims=True) + eps)
    return (y * g.astype(jnp.float32) + b.astype(jnp.float32)).astype(x.dtype)


def rotary_partial(x, cos, sin):
    half = ROPE_DIM // 2
    x1 = x[..., :half]
    x2 = x[..., half:ROPE_DIM]
    return jnp.concatenate([x1 * cos - x2 * sin, x2 * cos + x1 * sin, x[..., ROPE_DIM:]], axis=-1)


def diff_attention(q, k, v, lam):
    B, S, H, _, Dh = q.shape
    nb = S // Q_BLOCK
    scale = Dh ** -0.5
    qb = jnp.moveaxis(q.reshape(B, nb, Q_BLOCK, H, 2, Dh), 1, 0)
    starts = jnp.arange(nb, dtype=jnp.int32) * Q_BLOCK
    k_idx = jnp.arange(S, dtype=jnp.int32)

    def block(args):
        qblk, start = args
        s = jnp.einsum('bqhcd,bkhcd->bhcqk', qblk, k).astype(jnp.float32) * scale
        q_idx = start + jnp.arange(Q_BLOCK, dtype=jnp.int32)
        mask = k_idx[None, :] <= q_idx[:, None]
        a = jax.nn.softmax(jnp.where(mask, s, -jnp.inf), axis=-1)
        w = a[:, :, 0] - lam * a[:, :, 1]
        return jnp.einsum('bhqk,bkhe->bqhe', w.astype(v.dtype), v)

    out = lax.map(block, (qb, starts))
    return jnp.moveaxis(out, 0, 1).reshape(B, S, H, v.shape[-1])


def causal_mean(x, w):
    S = x.shape[1]
    cs = jnp.cumsum(x.astype(jnp.float32), axis=1)
    lower = jnp.pad(cs, ((0, 0), (w, 0), (0, 0)))[:, :S]
    count = jnp.minimum(jnp.arange(1, S + 1, dtype=jnp.float32), float(w))
    return ((cs - lower) / count[None, :, None]).astype(x.dtype)


def pool_mixer(z, w_pool, scale):
    B, S, _ = z.shape
    zg = z.reshape(B, S, N_POOL_GROUPS, POOL_GROUP_DIM)
    pooled = jnp.stack([causal_mean(zg[:, :, g], POOL_WINDOWS[g]) for g in range(N_POOL_GROUPS)], axis=2)
    y = jnp.einsum('bsgc,gcd->bsgd', pooled - zg, w_pool)
    return y.reshape(B, S, POOL_WIDTH) * scale


def conformer_conv(z, dw, dw_b, ln_g, ln_b, w_pw):
    a, b = jnp.split(z, 2, axis=-1)
    c = a * jax.nn.sigmoid(b)
    c = lax.conv_general_dilated(c, dw[:, None, :], window_strides=(1,), padding=[(CONV_KERNEL - 1, 0)],
                                 dimension_numbers=('NWC', 'WIO', 'NWC'),
                                 feature_group_count=CONV_WIDTH) + dw_b
    c = jax.nn.silu(layernorm(c, ln_g, ln_b))
    return c @ w_pw


def swiglu(x, wg, wu, wd):
    return (jax.nn.silu(x @ wg) * (x @ wu)) @ wd


def moe_swiglu(x, w_router, wg, wu, wd):
    logits = (x @ w_router).astype(jnp.float32)
    top_v, top_i = lax.top_k(logits, TOP_K)
    top_w = jax.nn.softmax(top_v, axis=-1)
    gates = jnp.sum(jax.nn.one_hot(top_i, N_EXPERTS, dtype=jnp.float32) * top_w[..., None], axis=-2).astype(x.dtype)
    y = jnp.zeros_like(x)
    for e in range(N_EXPERTS):
        y = y + gates[..., e:e + 1] * swiglu(x, wg[e], wu[e], wd[e])
    return y


def setup_inputs(seed: int = 0) -> dict:
    key = jax.random.key(seed)
    ks = jax.random.split(key, 32)
    f32 = jnp.float32

    def nrm(k, shape, scale):
        return jax.random.normal(k, shape, f32) * scale

    def gain(k, shape):
        return 1.0 + 0.05 * jax.random.normal(k, shape, f32)

    return {
        "x": nrm(ks[0], (BATCH, SEQ, D_MODEL), 1.0),
        "p": nrm(ks[1], (DEPTH, BATCH, SEQ, PLE_DIM), 1.0),
        "positions": jnp.broadcast_to(jnp.arange(SEQ, dtype=jnp.int32), (BATCH, SEQ)),
        "mix_norm": gain(ks[2], (DEPTH, D_MODEL)),
        "w_in": nrm(ks[3], (DEPTH, D_MODEL, IN_COLS), D_MODEL ** -0.5),
        "lambda_q1": nrm(ks[4], (DEPTH, ATTN_HEAD_DIM), 0.1),
        "lambda_k1": nrm(ks[5], (DEPTH, ATTN_HEAD_DIM), 0.1),
        "lambda_q2": nrm(ks[6], (DEPTH, ATTN_HEAD_DIM), 0.1),
        "lambda_k2": nrm(ks[7], (DEPTH, ATTN_HEAD_DIM), 0.1),
        "subln_gain": gain(ks[8], (DEPTH, ATTN_V_DIM)),
        "w_pool": nrm(ks[9], (DEPTH, N_POOL_GROUPS, POOL_GROUP_DIM, POOL_GROUP_DIM), POOL_GROUP_DIM ** -0.5),
        "pool_scale": gain(ks[10], (DEPTH, POOL_WIDTH)),
        "conv_dw": nrm(ks[11], (DEPTH, CONV_KERNEL, CONV_WIDTH), CONV_KERNEL ** -0.5),
        "conv_dw_bias": nrm(ks[12], (DEPTH, CONV_WIDTH), 0.02),
        "conv_ln_gain": gain(ks[13], (DEPTH, CONV_WIDTH)),
        "conv_ln_bias": nrm(ks[14], (DEPTH, CONV_WIDTH), 0.02),
        "w_conv_pw": nrm(ks[15], (DEPTH, CONV_WIDTH, CONV_WIDTH), CONV_WIDTH ** -0.5),
        "w_out": nrm(ks[16], (DEPTH, MIX_WIDTH, D_MODEL), MIX_WIDTH ** -0.5),
        "ffn_norm": gain(ks[17], (DEPTH, D_MODEL)),
        "w_dense_gate": nrm(ks[18], (N_DENSE, D_MODEL, D_FF), D_MODEL ** -0.5),
        "w_dense_up": nrm(ks[19], (N_DENSE, D_MODEL, D_FF), D_MODEL ** -0.5),
        "w_dense_down": nrm(ks[20], (N_DENSE, D_FF, D_MODEL), D_FF ** -0.5),
        "w_router": nrm(ks[21], (N_MOE, D_MODEL, N_EXPERTS), D_MODEL ** -0.5),
        "w_exp_gate": nrm(ks[22], (N_MOE, N_EXPERTS, D_MODEL, D_FF), D_MODEL ** -0.5),
        "w_exp_up": nrm(ks[23], (N_MOE, N_EXPERTS, D_MODEL, D_FF), D_MODEL ** -0.5),
        "w_exp_down": nrm(ks[24], (N_MOE, N_EXPERTS, D_FF, D_MODEL), D_FF ** -0.5),
        "ple_norm": gain(ks[25], (DEPTH, D_MODEL)),
        "w_ple_gate": nrm(ks[26], (DEPTH, D_MODEL, D_MODEL), D_MODEL ** -0.5),
        "w_ple_proj": nrm(ks[27], (DEPTH, PLE_DIM, D_MODEL), PLE_DIM ** -0.5),
        "final_norm": gain(ks[28], (D_MODEL,)),
    }


def reference(x, p, positions, mix_norm, w_in, lambda_q1, lambda_k1, lambda_q2, lambda_k2,
              subln_gain, w_pool, pool_scale, conv_dw, conv_dw_bias, conv_ln_gain, conv_ln_bias,
              w_conv_pw, w_out, ffn_norm, w_dense_gate, w_dense_up, w_dense_down, w_router,
              w_exp_gate, w_exp_up, w_exp_down, ple_norm, w_ple_gate, w_ple_proj, final_norm):
    B, S, _ = x.shape
    f32 = jnp.float32
    inv_freq = ROPE_THETA ** (-jnp.arange(0, ROPE_DIM, 2, dtype=f32) / ROPE_DIM)
    ang = positions.astype(f32)[..., None] * inv_freq
    cos = jnp.cos(ang)[:, :, None, None, :].astype(x.dtype)
    sin = jnp.sin(ang)[:, :, None, None, :].astype(x.dtype)

    h = x
    for i in range(DEPTH):
        lam_init = 0.8 - 0.6 * math.exp(-0.3 * i)
        u = rmsnorm(h, mix_norm[i])
        z = u @ w_in[i]
        zq, zk, zv, zp, zc = jnp.split(z, list(SPLIT_POINTS), axis=-1)
        q = rotary_partial(zq.reshape(B, S, N_ATTN_HEADS, 2, ATTN_HEAD_DIM), cos, sin)
        k = rotary_partial(zk.reshape(B, S, N_ATTN_HEADS, 2, ATTN_HEAD_DIM), cos, sin)
        v = zv.reshape(B, S, N_ATTN_HEADS, ATTN_V_DIM)
        lam = (jnp.exp(jnp.sum(lambda_q1[i].astype(f32) * lambda_k1[i].astype(f32)))
               - jnp.exp(jnp.sum(lambda_q2[i].astype(f32) * lambda_k2[i].astype(f32))) + lam_init)
        o = diff_attention(q, k, v, lam)
        o_attn = (rmsnorm(o, subln_gain[i], eps=SUBLN_EPS) * (1.0 - lam_init)).reshape(B, S, ATTN_WIDTH)
        o_pool = pool_mixer(zp, w_pool[i], pool_scale[i])
        o_conv = conformer_conv(zc, conv_dw[i], conv_dw_bias[i], conv_ln_gain[i], conv_ln_bias[i], w_conv_pw[i])
        h = h + jnp.concatenate([o_attn, o_pool, o_conv], axis=-1) @ w_out[i]
        u2 = rmsnorm(h, ffn_norm[i])
        j = i // 2
        if i % 2 == 0:
            f = swiglu(u2, w_dense_gate[j], w_dense_up[j], w_dense_down[j])
        else:
            f = moe_swiglu(u2, w_router[j], w_exp_gate[j], w_exp_up[j], w_exp_down[j])
        h = h + f
        g = jax.nn.sigmoid(rmsnorm(h, ple_norm[i]) @ w_ple_gate[i])
        h = h + (p[i] @ w_ple_proj[i]) * g
    return rmsnorm(h, final_norm)
```

```cpp
#include <hip/hip_runtime.h>
#include <cstdio>
#include <cstdint>
namespace pg8 {
#define PG8_LAS __attribute__((address_space(3)))
typedef unsigned short bf16_t;
typedef short bf16x8 __attribute__((ext_vector_type(8)));
typedef float f32x4 __attribute__((ext_vector_type(4)));
typedef unsigned u32x4 __attribute__((ext_vector_type(4)));
typedef int i32x4 __attribute__((ext_vector_type(4)));
typedef int i32x8 __attribute__((ext_vector_type(8)));
template <int MODE> struct AccT { typedef f32x4 type; }; template <> struct AccT<1> { typedef i32x4 type; };
constexpr int BM = 256, BK = 64, HALF = 128, HTB = HALF * BK * 2  , STAGE_BYTES = 8 * HTB, NXCD = 8, WGM = 4;

__host__ __device__ __forceinline__ int lds_byte(int r, int c) { const int st = (r >> 4) * 2 + (c >> 5), rr = r & 15, cc = c & 31, ob = rr * 64 + cc * 2; return st * 1024 + (ob ^ (((ob >> 9) & 1) << 5)); }
__host__ __device__ __forceinline__ void stage_rc(int b, int& R, int& C) { const int st = b / 1024, sb = b % 1024, swz = sb ^ (((sb >> 9) & 1) << 5); R = (st >> 1) * 16 + swz / 64; C = (st & 1) * 32 + (swz % 64) / 2; }
__host__ __device__ __forceinline__ int perm32(int rho) { const int n = rho >> 4, i = rho & 15; return 8 * (i >> 2) + 4 * n + (i & 3); }

struct Unit { int pm, pn, eb, ks; };
struct Gemm { const bf16_t* A; const bf16_t* Bt; int M, N, K; size_t bstride; int ldk; size_t kslice; };

struct GOrder {
    int nM, nN, nwg, G, c; int ts[9]; int r0, r1;
    __device__ __forceinline__ void init(int nM_, int nN_, int G_, int c_) { nM = nM_; nN = nN_; nwg = nM * nN; G = G_; c = c_; ts[0] = 0; r0 = 0; r1 = 0x3fffffff;
#pragma unroll
        for (int e = 1; e < 9; ++e) ts[e] = nM_; }
    __device__ __forceinline__ bool next(int i, Unit& u) const {
        if (i + r0 >= r1) return false;
        const long L = (long)(i + r0) * G + c; if (c < 0 || L >= nwg) return false;
        int wgid = (int)L; { const int q = nwg / NXCD, r = nwg % NXCD, xcd = wgid % NXCD, off = wgid / NXCD; wgid = (xcd < r ? xcd * (q + 1) : r * (q + 1) + (xcd - r) * q) + off; }
        const int nig = WGM * nN, gid = wgid / nig, fm = gid * WGM, gsz = (nM - fm) < WGM ? (nM - fm) : WGM;
        u.pm = fm + ((wgid % nig) % gsz); u.pn = (wgid % nig) / gsz;
        int e = 0;
#pragma unroll
        for (int k = 1; k < 8; ++k) e += (u.pm >= ts[k]) ? 1 : 0;
        u.eb = e; u.ks = 0; return true;
    }
    __device__ __forceinline__ void a_ready(const Unit&) const {}
    __device__ __forceinline__ void done(const Unit&) const {}
};

struct SliceOrder {
    int nitems, c, pm0; int ts[9];
    __device__ __forceinline__ bool next(int i, Unit& u) const {
        if (i > 0 || c >= nitems) return false;
        const int unit = c >> 2; u.ks = c & 3; u.pn = unit & 7; u.pm = pm0 + (unit >> 3);
        int e = 0;
#pragma unroll
        for (int k = 1; k < 8; ++k) e += (u.pm >= ts[k]) ? 1 : 0;
        u.eb = e; return true;
    }
    __device__ __forceinline__ void a_ready(const Unit&) const {}
    __device__ __forceinline__ void done(const Unit&) const {}
};
__device__ __forceinline__ unsigned cvt_pk_bf16(float lo, float hi) { unsigned r; asm volatile("v_cvt_pk_bf16_f32 %0, %1, %2" : "=v"(r) : "v"(lo), "v"(hi)); return r; }
typedef float f32x2 __attribute__((ext_vector_type(2)));
__device__ __forceinline__ f32x2 gelu_pk(f32x2 v) {
    const f32x2 av = __builtin_elementwise_abs(v), d = av * 0.2316418882f + 1.0f;
    f32x2 t; t.x = __builtin_amdgcn_rcpf(d.x); t.y = __builtin_amdgcn_rcpf(d.y);
    f32x2 q = t * 0.5307027145f + (-0.7265760135f); q = q * t + 0.7107068705f; q = q * t + (-0.142248368f); q = q * t + 0.127414796f; q = q * t;
    const f32x2 s = (v * v) * (-0.72134752044f);
    f32x2 e; e.x = __builtin_amdgcn_exp2f(s.x); e.y = __builtin_amdgcn_exp2f(s.y);
    const f32x2 m = v * (q * e), r = v - m;
    f32x2 o; o.x = v.x < 0.f ? m.x : r.x; o.y = v.y < 0.f ? m.y : r.y; return o;
}

template <int ACT  > struct EpiBf16 {
    static constexpr bool PERM = true, AFTER_DRAIN = false; static_assert(ACT == 0 || ACT == 1, "EpiBf16: ACT is 0 (none) or 1 (gelu_pk)");
    bf16_t* O; int ldc; const float* bias; int split_cols; size_t split_stride; float scale0;
    __device__ __forceinline__ void operator()(const f32x4 (&acc)[2][2][4][2], const Unit& u, int wr, int wc, int fr, int fq) const {
        const int row0 = u.pm * BM + wr * 64 + fr; int colt = u.pn * BM; bf16_t* base = O;
        float sc = 1.f; if (split_cols) { const int t = colt / split_cols; base += (size_t)t * split_stride; colt -= t * split_cols; if (t == 0) sc = scale0; }
        const int col0 = colt + wc * 32 + 8 * fq, bcol0 = u.pn * BM + wc * 32 + 8 * fq;
        f32x4 bv[2][2];
#pragma unroll
        for (int bj = 0; bj < 2; ++bj)
#pragma unroll
            for (int n = 0; n < 2; ++n) bv[bj][n] = bias ? *(const f32x4*)(bias + bcol0 + bj * HALF + 4 * n) : (f32x4){0.f, 0.f, 0.f, 0.f};
#pragma unroll
        for (int ai = 0; ai < 2; ++ai)
#pragma unroll
            for (int m = 0; m < 4; ++m) { bf16_t* rowp = base + (size_t)(row0 + ai * HALF + m * 16) * ldc + col0;
#pragma unroll
                for (int bj = 0; bj < 2; ++bj) { f32x4 v0 = acc[ai][bj][m][0] + bv[bj][0], v1 = acc[ai][bj][m][1] + bv[bj][1];
                    if (ACT == 1) { f32x2 a = gelu_pk((f32x2){v0[0], v0[1]}), b = gelu_pk((f32x2){v0[2], v0[3]}), c = gelu_pk((f32x2){v1[0], v1[1]}), d = gelu_pk((f32x2){v1[2], v1[3]});
                        v0 = (f32x4){a.x, a.y, b.x, b.y}; v1 = (f32x4){c.x, c.y, d.x, d.y}; }
                    v0 = v0 * sc; v1 = v1 * sc; u32x4 w; w.x = cvt_pk_bf16(v0[0], v0[1]); w.y = cvt_pk_bf16(v0[2], v0[3]); w.z = cvt_pk_bf16(v1[0], v1[1]); w.w = cvt_pk_bf16(v1[2], v1[3]);
                    *(u32x4*)(rowp + bj * HALF) = w; } }
    }
};

__device__ __forceinline__ float sigm(float x) { return __builtin_amdgcn_rcpf(1.0f + __builtin_amdgcn_exp2f(-1.4426950408889634f * x)); }
__device__ __forceinline__ u32x4 pack8(const f32x4 v0, const f32x4 v1) { u32x4 w; w.x = cvt_pk_bf16(v0[0], v0[1]); w.y = cvt_pk_bf16(v0[2], v0[3]); w.z = cvt_pk_bf16(v1[0], v1[1]); w.w = cvt_pk_bf16(v1[2], v1[3]); return w; }
struct EpiIn {
    static constexpr bool PERM = true, AFTER_DRAIN = false;
    bf16_t *Q, *K, *V, *ZP, *CG; const float* rope; float qscale; const float* sa; const float* sw;
    __device__ __forceinline__ void operator()(const i32x4 (&acc)[2][2][4][2], const Unit& u, int wr, int wc, int fr, int fq) const {
        const int row0 = u.pm * BM + wr * 64 + fr, pn = u.pn, cw = wc * 32 + 8 * fq;
        f32x4 swv[2][2];
#pragma unroll
        for (int bj = 0; bj < 2; ++bj)
#pragma unroll
            for (int n = 0; n < 2; ++n) swv[bj][n] = *(const f32x4*)(sw + pn * BM + bj * HALF + cw + 4 * n);
        float srv[2][4];
#pragma unroll
        for (int ai = 0; ai < 2; ++ai)
#pragma unroll
            for (int m = 0; m < 4; ++m) srv[ai][m] = sa[row0 + ai * HALF + m * 16];
#define DQ(ai, bj, m, n) (__builtin_convertvector(acc[ai][bj][m][n], f32x4) * (swv[bj][n] * sr))
        if (pn < 8) {
            bf16_t* base = (pn < 4 ? Q : K) + (pn & 3) * 256 + cw; const float sc = pn < 4 ? qscale : 1.f;
            const bool rl = ((wc & 1) == 0) && (fq < 2);
#pragma unroll
            for (int ai = 0; ai < 2; ++ai)
#pragma unroll
              for (int mp = 0; mp < 4; mp += 2) { f32x4 csv[2], snv[2];
#pragma unroll
                for (int mm = 0; mm < 2; ++mm) { const int r = row0 + ai * HALF + (mp + mm) * 16; csv[mm] = (f32x4){1.f, 1.f, 1.f, 1.f}; snv[mm] = (f32x4){0.f, 0.f, 0.f, 0.f};
                    if (rl) { csv[mm] = *(const f32x4*)(rope + (size_t)r * 16 + 4 * fq); snv[mm] = *(const f32x4*)(rope + (size_t)r * 16 + 8 + 4 * fq); } }
#pragma unroll
                for (int mm = 0; mm < 2; ++mm) { const int m = mp + mm; const int r = row0 + ai * HALF + m * 16; const float sr = srv[ai][m]; const f32x4 cs = csv[mm], sn = snv[mm];
#pragma unroll
                    for (int bj = 0; bj < 2; ++bj) { const f32x4 v0 = DQ(ai, bj, m, 0), v1 = DQ(ai, bj, m, 1); f32x4 w0, w1;
                        w0[0] = v0[0] * cs[0] - v0[1] * sn[0]; w0[1] = v0[1] * cs[0] + v0[0] * sn[0];
                        w0[2] = v0[2] * cs[1] - v0[3] * sn[1]; w0[3] = v0[3] * cs[1] + v0[2] * sn[1];
                        w1[0] = v1[0] * cs[2] - v1[1] * sn[2]; w1[1] = v1[1] * cs[2] + v1[0] * sn[2];
                        w1[2] = v1[2] * cs[3] - v1[3] * sn[3]; w1[3] = v1[3] * cs[3] + v1[2] * sn[3];
                        *(u32x4*)(base + (size_t)r * 1024 + bj * HALF) = pack8(w0 * sc, w1 * sc); } } }
        } else if (pn < 14) {
            const bool isv = pn < 12; const int ld = isv ? 1024 : 512; bf16_t* base = (isv ? V + (pn - 8) * 256 : ZP + (pn - 12) * 256) + cw;
#pragma unroll
            for (int ai = 0; ai < 2; ++ai)
#pragma unroll
                for (int m = 0; m < 4; ++m) { const int r = row0 + ai * HALF + m * 16; const float sr = srv[ai][m];
#pragma unroll
                    for (int bj = 0; bj < 2; ++bj) *(u32x4*)(base + (size_t)r * ld + bj * HALF) = pack8(DQ(ai, bj, m, 0), DQ(ai, bj, m, 1)); }
        } else {
            bf16_t* base = CG + (pn - 14) * 128 + cw;
#pragma unroll
            for (int ai = 0; ai < 2; ++ai)
#pragma unroll
                for (int m = 0; m < 4; ++m) { const int r = row0 + ai * HALF + m * 16; const float sr = srv[ai][m]; f32x4 c[2];
#pragma unroll
                    for (int n = 0; n < 2; ++n) { const f32x4 a = DQ(ai, 0, m, n), b = DQ(ai, 1, m, n);
#pragma unroll
                        for (int j = 0; j < 4; ++j) c[n][j] = a[j] * sigm(b[j]); }
                    *(u32x4*)(base + (size_t)r * 512) = pack8(c[0], c[1]); }
        }
#undef DQ
    }
};
struct EpiRes {
    static constexpr bool PERM = false, AFTER_DRAIN = false;
    const float* base; float* out;
    __device__ __forceinline__ void operator()(const f32x4 (&acc)[2][2][4][2], const Unit& u, int wr, int wc, int fr, int fq) const {
        const int row0 = u.pm * BM + wr * 64 + fr, col0 = u.pn * BM + wc * 32 + 4 * fq;
#pragma unroll
        for (int ai = 0; ai < 2; ++ai)
#pragma unroll
            for (int mp = 0; mp < 4; mp += 2) { f32x4 bs[2][2][2];
#pragma unroll
                for (int mm = 0; mm < 2; ++mm) { const size_t off = (size_t)(row0 + ai * HALF + (mp + mm) * 16) * 2048 + col0;
#pragma unroll
                    for (int bj = 0; bj < 2; ++bj)
#pragma unroll
                        for (int n = 0; n < 2; ++n) bs[mm][bj][n] = *(const f32x4*)(base + off + bj * HALF + n * 16); }
#pragma unroll
                for (int mm = 0; mm < 2; ++mm) { const size_t off = (size_t)(row0 + ai * HALF + (mp + mm) * 16) * 2048 + col0;
#pragma unroll
                    for (int bj = 0; bj < 2; ++bj)
#pragma unroll
                        for (int n = 0; n < 2; ++n) *(f32x4*)(out + off + bj * HALF + n * 16) = bs[mm][bj][n] + acc[ai][bj][mp + mm][n]; } }
    }
};
struct EpiSwiglu {
    static constexpr bool PERM = true, AFTER_DRAIN = false;
    bf16_t* O; int ldc;
    __device__ __forceinline__ void operator()(const f32x4 (&acc)[2][2][4][2], const Unit& u, int wr, int wc, int fr, int fq) const {
        const int row0 = u.pm * BM + wr * 64 + fr; bf16_t* base = O + u.pn * 128 + wc * 32 + 8 * fq;
#pragma unroll
        for (int ai = 0; ai < 2; ++ai)
#pragma unroll
            for (int m = 0; m < 4; ++m) { const int r = row0 + ai * HALF + m * 16; f32x4 c[2];
#pragma unroll
                for (int n = 0; n < 2; ++n) { const f32x4 g = acc[ai][0][m][n], up = acc[ai][1][m][n];
#pragma unroll
                    for (int j = 0; j < 4; ++j) c[n][j] = g[j] * sigm(g[j]) * up[j]; }
                *(u32x4*)(base + (size_t)r * ldc) = pack8(c[0], c[1]); }
    }
};
__device__ __forceinline__ unsigned cvt4_fp8(float a, float b, float c, float d) {
    a = __builtin_fminf(__builtin_fmaxf(a, -448.f), 448.f); b = __builtin_fminf(__builtin_fmaxf(b, -448.f), 448.f); c = __builtin_fminf(__builtin_fmaxf(c, -448.f), 448.f); d = __builtin_fminf(__builtin_fmaxf(d, -448.f), 448.f);
    int w = 0; w = __builtin_amdgcn_cvt_pk_fp8_f32(a, b, w, false); w = __builtin_amdgcn_cvt_pk_fp8_f32(c, d, w, true); return (unsigned)w; }
struct EpiScaleBf16 {
    static constexpr bool PERM = true, AFTER_DRAIN = false;
    bf16_t* O; int ldc; const float* sw; size_t ks_stride;
    __device__ __forceinline__ void operator()(const f32x4 (&acc)[2][2][4][2], const Unit& u, int wr, int wc, int fr, int fq) const {
        const int row0 = u.pm * BM + wr * 64 + fr, col0 = u.pn * BM + wc * 32 + 8 * fq; const float* swp = sw + (size_t)u.eb * 2048 + col0; bf16_t* Ob = O + (size_t)u.ks * ks_stride;
        f32x4 swv[2][2];
#pragma unroll
        for (int bj = 0; bj < 2; ++bj)
#pragma unroll
            for (int n = 0; n < 2; ++n) swv[bj][n] = *(const f32x4*)(swp + bj * HALF + 4 * n);
#pragma unroll
        for (int ai = 0; ai < 2; ++ai)
#pragma unroll
            for (int m = 0; m < 4; ++m) { const int r = row0 + ai * HALF + m * 16;
#pragma unroll
                for (int bj = 0; bj < 2; ++bj) *(u32x4*)(Ob + (size_t)r * ldc + col0 + bj * HALF) = pack8(acc[ai][bj][m][0] * swv[bj][0], acc[ai][bj][m][1] * swv[bj][1]); }
    }
};
template <bool F8OUT> struct EpiSwigluI8 {
    static constexpr bool PERM = true, AFTER_DRAIN = false;
    bf16_t* O; int ldc; const float* sa; const float* sw;
    __device__ __forceinline__ void operator()(const i32x4 (&acc)[2][2][4][2], const Unit& u, int wr, int wc, int fr, int fq) const {
        const int row0 = u.pm * BM + wr * 64 + fr; bf16_t* base = O + u.pn * 128 + wc * 32 + 8 * fq;
        const float* swp = sw + (size_t)u.eb * 14336 + u.pn * 256 + wc * 32 + 8 * fq;
        const f32x4 sg[2] = {*(const f32x4*)(swp) * 1.4426950408889634f, *(const f32x4*)(swp + 4) * 1.4426950408889634f}, su[2] = {*(const f32x4*)(swp + 128) * 0.6931471805599453f, *(const f32x4*)(swp + 132) * 0.6931471805599453f};
        float srv[2][4];
#pragma unroll
        for (int ai = 0; ai < 2; ++ai)
#pragma unroll
            for (int m = 0; m < 4; ++m) srv[ai][m] = sa[row0 + ai * HALF + m * 16];
#pragma unroll
        for (int ai = 0; ai < 2; ++ai)
#pragma unroll
            for (int m = 0; m < 4; ++m) { const int r = row0 + ai * HALF + m * 16; const float sr = srv[ai][m]; f32x4 c[2];
#pragma unroll
                for (int n = 0; n < 2; ++n) { const f32x4 g = __builtin_convertvector(acc[ai][0][m][n], f32x4) * (sg[n] * sr), up = __builtin_convertvector(acc[ai][1][m][n], f32x4) * (su[n] * sr);
                    f32x4 d;
#pragma unroll
                    for (int j = 0; j < 4; ++j) d[j] = __builtin_amdgcn_rcpf(1.0f + __builtin_amdgcn_exp2f(-g[j]));
                    c[n] = (g * d) * up; }
                if constexpr (F8OUT) { typedef unsigned u32x2 __attribute__((ext_vector_type(2))); u32x2 w; w.x = cvt4_fp8(c[0][0], c[0][1], c[0][2], c[0][3]); w.y = cvt4_fp8(c[1][0], c[1][1], c[1][2], c[1][3]);
                    *(u32x2*)((unsigned char*)O + (size_t)r * ldc + u.pn * 128 + wc * 32 + 8 * fq) = w; }
                else *(u32x4*)(base + (size_t)r * ldc) = pack8(c[0], c[1]); }
    }
};
struct EpiDqBf16 {
    static constexpr bool PERM = true, AFTER_DRAIN = false;
    bf16_t* O; int ldc; const float* sa; const float* sw; size_t ks_stride;
    __device__ __forceinline__ void operator()(const i32x4 (&acc)[2][2][4][2], const Unit& u, int wr, int wc, int fr, int fq) const {
        const int row0 = u.pm * BM + wr * 64 + fr, col0 = u.pn * BM + wc * 32 + 8 * fq; const float* swp = sw + (size_t)u.eb * 2048 + col0; bf16_t* Ob = O + (size_t)u.ks * ks_stride;
        f32x4 swv[2][2];
#pragma unroll
        for (int bj = 0; bj < 2; ++bj)
#pragma unroll
            for (int n = 0; n < 2; ++n) swv[bj][n] = *(const f32x4*)(swp + bj * HALF + 4 * n);
#pragma unroll
        for (int ai = 0; ai < 2; ++ai)
#pragma unroll
            for (int m = 0; m < 4; ++m) { const int r = row0 + ai * HALF + m * 16; const float sr = sa[r];
#pragma unroll
                for (int bj = 0; bj < 2; ++bj) *(u32x4*)(Ob + (size_t)r * ldc + col0 + bj * HALF) = pack8(__builtin_convertvector(acc[ai][bj][m][0], f32x4) * (swv[bj][0] * sr), __builtin_convertvector(acc[ai][bj][m][1], f32x4) * (swv[bj][1] * sr)); }
    }
};
struct EpiPle {
    static constexpr bool PERM = false, AFTER_DRAIN = false;
    float* h; const bf16_t* P; const float* sa; const float* sw;
    __device__ __forceinline__ void operator()(const i32x4 (&acc)[2][2][4][2], const Unit& u, int wr, int wc, int fr, int fq) const {
        typedef unsigned u32x2 __attribute__((ext_vector_type(2)));
        const int row0 = u.pm * BM + wr * 64 + fr, col0 = u.pn * BM + wc * 32 + 4 * fq;
        f32x4 swv[2][2];
#pragma unroll
        for (int bj = 0; bj < 2; ++bj)
#pragma unroll
            for (int n = 0; n < 2; ++n) swv[bj][n] = *(const f32x4*)(sw + col0 + bj * HALF + n * 16);
        f32x4 hv[2][2][2]; u32x2 pw[2][2][2]; float srg[2];
#define PLE_LOAD(g, s) do { const int rr = row0 + ((g) >> 2) * HALF + ((g) & 3) * 16; const size_t off = (size_t)rr * 2048 + col0; srg[s] = sa[rr]; \
            _Pragma("unroll") for (int bj = 0; bj < 2; ++bj) _Pragma("unroll") for (int n = 0; n < 2; ++n) { const size_t o2 = off + bj * HALF + n * 16; hv[s][bj][n] = *(const f32x4*)(h + o2); pw[s][bj][n] = *(const u32x2*)(P + o2); } } while (0)
        PLE_LOAD(0, 0);
#pragma unroll
        for (int g = 0; g < 8; ++g) { const int s = g & 1, ai = g >> 2, m = g & 3; const size_t off = (size_t)(row0 + ai * HALF + m * 16) * 2048 + col0;
            if (g + 1 < 8) { if (s == 0) PLE_LOAD(g + 1, 1); else PLE_LOAD(g + 1, 0); }
            f32x4 ov[2][2];
#pragma unroll
            for (int bj = 0; bj < 2; ++bj)
#pragma unroll
                for (int n = 0; n < 2; ++n) { const f32x4 a = __builtin_convertvector(acc[ai][bj][m][n], f32x4) * (swv[bj][n] * srg[s]); const u32x2 pq = pw[s][bj][n]; f32x4 pv;
                    pv[0] = __uint_as_float(pq.x << 16); pv[1] = __uint_as_float(pq.x & 0xffff0000u); pv[2] = __uint_as_float(pq.y << 16); pv[3] = __uint_as_float(pq.y & 0xffff0000u);
#pragma unroll
                    for (int j = 0; j < 4; ++j) ov[bj][n][j] = hv[s][bj][n][j] + pv[j] * sigm(a[j]); }
#pragma unroll
            for (int bj = 0; bj < 2; ++bj)
#pragma unroll
                for (int n = 0; n < 2; ++n) *(f32x4*)(h + off + bj * HALF + n * 16) = ov[bj][n]; }
#undef PLE_LOAD
    }
};

template <class Epi, class Sched, bool ALIGN_EPI = false, bool SP2 = false, int MODE = 0>
__device__ __forceinline__ void gemm_phase(PG8_LAS unsigned char* lds, const Gemm g, const Sched& S, const Epi& E, int tid) {
    asm volatile("" : "+v"(tid));
    const int wid = __builtin_amdgcn_readfirstlane(tid >> 6), lane = tid & 63, wr = wid >> 2, wc = wid & 3, fr = lane & 15, fq = lane >> 4;
    const int K = g.ldk ? g.ldk : g.K, nt = g.K / BK;
    unsigned voffA[2], voffB[2];
#pragma unroll
    for (int i = 0; i < 2; ++i) { int R, C; stage_rc(tid * 16 + i * 8192, R, C); const int Rb = Epi::PERM ? ((R & ~31) + perm32(R & 31)) : R;
        voffA[i] = (unsigned)(R * K + C) * 2u; voffB[i] = (unsigned)(Rb * K + C) * 2u; }
    const size_t kstep = (size_t)(BK * 2);
    const size_t hstep = (size_t)HALF * K * 2;
    const size_t tstep = 2 * hstep;
    const unsigned ldsw = (unsigned)wid * 1024u;
    const int aoff = lds_byte(wr * 64 + fr, fq * 8), boff = lds_byte(wc * 32 + fr, fq * 8);
#define PG8_SA(b, h) (((b) * 2 + (h)) * HTB)
#define PG8_SB(b, h) ((4 + (b) * 2 + (h)) * HTB)
#define PG8_STAGE(bufoff, gbase, voff) do { _Pragma("unroll") for (int _i = 0; _i < 2; ++_i) \
        __builtin_amdgcn_global_load_lds((const unsigned*)((const char*)(gbase) + (voff)[_i]), (PG8_LAS unsigned*)(lds + (bufoff) + ldsw + _i * 8192), 16, 0, 0); } while (0)
#define PG8_LDA(dst, b, h) do { if constexpr (MODE == 2) { _Pragma("unroll") for (int m = 0; m < 4; ++m) { dst##8[m].lo = *(const PG8_LAS i32x4*)(lds + PG8_SA(b, h) + aoff + m * 2048); dst##8[m].hi = *(const PG8_LAS i32x4*)(lds + PG8_SA(b, h) + aoff + m * 2048 + 1024); } } \
        else { _Pragma("unroll") for (int m = 0; m < 4; ++m) _Pragma("unroll") for (int k = 0; k < 2; ++k) dst[m][k] = *(const PG8_LAS bf16x8*)(lds + PG8_SA(b, h) + aoff + m * 2048 + k * 1024); } } while (0)
#define PG8_LDB(dst, b, h) do { if constexpr (MODE == 2) { _Pragma("unroll") for (int n = 0; n < 2; ++n) { dst##8[n].lo = *(const PG8_LAS i32x4*)(lds + PG8_SB(b, h) + boff + n * 2048); dst##8[n].hi = *(const PG8_LAS i32x4*)(lds + PG8_SB(b, h) + boff + n * 2048 + 1024); } } \
        else { _Pragma("unroll") for (int n = 0; n < 2; ++n) _Pragma("unroll") for (int k = 0; k < 2; ++k) dst[n][k] = *(const PG8_LAS bf16x8*)(lds + PG8_SB(b, h) + boff + n * 2048 + k * 1024); } } while (0)
#define PG8_MMA(ai, bj, At, Bt) do { __builtin_amdgcn_s_setprio(3); _Pragma("unroll") for (int m = 0; m < 4; ++m) _Pragma("unroll") for (int n = 0; n < 2; ++n) _Pragma("unroll") for (int k = 0; k < 2; ++k) \
        { if constexpr (MODE == 1) acc[ai][bj][m][n] = __builtin_bit_cast(acc_t, __builtin_amdgcn_mfma_i32_16x16x64_i8(__builtin_bit_cast(i32x4, Bt[n][k]), __builtin_bit_cast(i32x4, At[m][k]), __builtin_bit_cast(i32x4, acc[ai][bj][m][n]), 0, 0, 0)); \
          else if constexpr (MODE == 2) { if (k == 0) asm volatile("v_mfma_scale_f32_16x16x128_f8f6f4 %0, %1, %2, %0, %3, %3 op_sel_hi:[0,0,0]" : "+v"(acc[ai][bj][m][n]) : "v"(Bt##8[n]), "v"(At##8[m]), "v"(f8scale)); } \
          else acc[ai][bj][m][n] = __builtin_bit_cast(acc_t, __builtin_amdgcn_mfma_f32_16x16x32_bf16(Bt[n][k], At[m][k], __builtin_bit_cast(f32x4, acc[ai][bj][m][n]), 0, 0, 0)); } __builtin_amdgcn_s_setprio(0); } while (0)
#define PG8_WAIT_V(n) asm volatile("s_waitcnt vmcnt(" #n ")" ::: "memory")
#define PG8_WAIT_L(n) asm volatile("s_waitcnt lgkmcnt(" #n ")" ::: "memory")
#define PG8_BAR __builtin_amdgcn_s_barrier()
#define PG8_SCHED __builtin_amdgcn_sched_barrier(0)
    Unit cur, nxt; int ui = 0;
    if (!S.next(0, cur)) return;
    typedef typename AccT<MODE>::type acc_t;
    acc_t acc[2][2][4][2];
#pragma unroll
    for (int a = 0; a < 2; ++a)
#pragma unroll
        for (int b = 0; b < 2; ++b)
#pragma unroll
            for (int m = 0; m < 4; ++m)
#pragma unroll
                for (int n = 0; n < 2; ++n) acc[a][b][m][n] = acc_t{};
    const int f8scale = 0x7f7f7f7f;
    bf16x8 At[4][2], B0[2][2], B1[2][2]; i32x8 At8[4], B08[2], B18[2];
    const char* cA = (const char*)g.A + (size_t)cur.pm * tstep + (size_t)cur.ks * g.kslice; const char* cB = (const char*)g.Bt + (size_t)cur.eb * g.bstride + (size_t)cur.pn * tstep + (size_t)cur.ks * g.kslice;
    S.a_ready(cur);
    if constexpr (SP2) {
        PG8_STAGE(PG8_SB(0, 0), cB, voffB); PG8_STAGE(PG8_SB(0, 1), cB + hstep, voffB); PG8_STAGE(PG8_SA(0, 0), cA, voffA); PG8_STAGE(PG8_SA(0, 1), cA + hstep, voffA);
        if (wr == 1) PG8_BAR;
        PG8_WAIT_V(2); PG8_BAR;
        PG8_STAGE(PG8_SB(1, 0), cB + kstep, voffB); PG8_STAGE(PG8_SA(1, 0), cA + kstep, voffA); PG8_STAGE(PG8_SB(1, 1), cB + hstep + kstep, voffB);
        PG8_WAIT_V(6); PG8_BAR;
    } else {
        PG8_STAGE(PG8_SB(0, 0), cB, voffB); PG8_STAGE(PG8_SA(0, 0), cA, voffA); PG8_STAGE(PG8_SB(0, 1), cB + hstep, voffB); PG8_STAGE(PG8_SA(0, 1), cA + hstep, voffA);
        if (wr == 1) PG8_BAR;
        PG8_WAIT_V(4); PG8_BAR;
        PG8_STAGE(PG8_SB(1, 0), cB + kstep, voffB); PG8_STAGE(PG8_SA(1, 0), cA + kstep, voffA); PG8_STAGE(PG8_SB(1, 1), cB + hstep + kstep, voffB);
        PG8_WAIT_V(6); PG8_BAR;
    }
    for (;;) {
        const bool has_next = S.next(ui + 1, nxt);
        const char* nA = has_next ? (const char*)g.A + (size_t)nxt.pm * tstep + (size_t)nxt.ks * g.kslice : cA; const char* nB = has_next ? (const char*)g.Bt + (size_t)nxt.eb * g.bstride + (size_t)nxt.pn * tstep + (size_t)nxt.ks * g.kslice : cB;
        for (int t = 0; t < nt; t += 2) {
            const bool last = (t == nt - 2);
            const char* a1 = cA + (size_t)(t + 1) * kstep;
            const char* a2 = last ? nA : cA + (size_t)(t + 2) * kstep; const char* b2 = last ? nB : cB + (size_t)(t + 2) * kstep;
            const char* a3 = a2 + kstep; const char* b3 = b2 + kstep;
            if (last && has_next) S.a_ready(nxt);
            if constexpr (SP2) {
            PG8_LDB(B0, 0, 0); PG8_LDB(B1, 0, 1); PG8_SCHED; PG8_LDA(At, 0, 0); PG8_STAGE(PG8_SA(1, 1), a1 + hstep, voffA);
            PG8_WAIT_V(8); PG8_WAIT_L(0); PG8_BAR; PG8_MMA(0, 0, At, B0); PG8_MMA(0, 1, At, B1); PG8_BAR; PG8_SCHED;
            PG8_LDA(At, 0, 1); PG8_STAGE(PG8_SB(0, 0), b2, voffB); PG8_STAGE(PG8_SB(0, 1), b2 + hstep, voffB); PG8_STAGE(PG8_SA(0, 0), a2, voffA);
            PG8_WAIT_V(8); PG8_WAIT_L(0); PG8_BAR; PG8_MMA(1, 0, At, B0); PG8_MMA(1, 1, At, B1); PG8_BAR; PG8_SCHED;
            PG8_LDB(B0, 1, 0); PG8_LDB(B1, 1, 1); PG8_SCHED; PG8_LDA(At, 1, 0); PG8_STAGE(PG8_SA(0, 1), a2 + hstep, voffA);
            PG8_WAIT_V(8); PG8_WAIT_L(0); PG8_BAR; PG8_MMA(0, 0, At, B0); PG8_MMA(0, 1, At, B1); PG8_BAR; PG8_SCHED;
            PG8_LDA(At, 1, 1); PG8_STAGE(PG8_SB(1, 0), b3, voffB); PG8_STAGE(PG8_SB(1, 1), b3 + hstep, voffB); PG8_STAGE(PG8_SA(1, 0), a3, voffA);
            PG8_WAIT_V(8); PG8_WAIT_L(0); PG8_BAR; PG8_MMA(1, 0, At, B0); PG8_MMA(1, 1, At, B1); PG8_BAR; PG8_SCHED;
            } else {
            PG8_LDB(B0, 0, 0); PG8_SCHED; PG8_LDA(At, 0, 0); PG8_STAGE(PG8_SA(1, 1), a1 + hstep, voffA);
            PG8_WAIT_L(8); PG8_BAR; PG8_WAIT_L(0); PG8_MMA(0, 0, At, B0); PG8_BAR; PG8_SCHED;
            PG8_LDB(B1, 0, 1); PG8_STAGE(PG8_SB(0, 0), b2, voffB);
            PG8_BAR; PG8_WAIT_L(0); PG8_MMA(0, 1, At, B1); PG8_BAR;
            PG8_LDA(At, 0, 1); PG8_STAGE(PG8_SA(0, 0), a2, voffA);
            PG8_BAR; PG8_WAIT_L(0); PG8_MMA(1, 0, At, B0); PG8_BAR; PG8_SCHED;
            PG8_STAGE(PG8_SB(0, 1), b2 + hstep, voffB);
            PG8_WAIT_V(6); PG8_BAR; PG8_MMA(1, 1, At, B1); PG8_BAR;
            PG8_LDB(B0, 1, 0); PG8_SCHED; PG8_LDA(At, 1, 0); PG8_STAGE(PG8_SA(0, 1), a2 + hstep, voffA);
            PG8_WAIT_L(8); PG8_BAR; PG8_WAIT_L(0); PG8_MMA(0, 0, At, B0); PG8_BAR; PG8_SCHED;
            PG8_LDB(B1, 1, 1); PG8_STAGE(PG8_SB(1, 0), b3, voffB);
            PG8_BAR; PG8_WAIT_L(0); PG8_MMA(0, 1, At, B1); PG8_BAR;
            PG8_LDA(At, 1, 1); PG8_STAGE(PG8_SA(1, 0), a3, voffA);
            PG8_BAR; PG8_WAIT_L(0); PG8_MMA(1, 0, At, B0); PG8_BAR; PG8_SCHED;
            PG8_STAGE(PG8_SB(1, 1), b3 + hstep, voffB);
            PG8_WAIT_V(6); PG8_BAR; PG8_MMA(1, 1, At, B1); PG8_BAR;
            }
        }
        if constexpr (MODE == 2) asm volatile("s_nop 15\n\ts_nop 7" ::: "memory");
        if constexpr (ALIGN_EPI) { if (wr == 0) PG8_BAR; }
        if constexpr (!Epi::AFTER_DRAIN) { E(acc, cur, wr, wc, fr, fq); S.done(cur); }
        if (!has_next) break;
#pragma unroll
        for (int a = 0; a < 2; ++a)
#pragma unroll
            for (int b = 0; b < 2; ++b)
#pragma unroll
                for (int m = 0; m < 4; ++m)
#pragma unroll
                    for (int n = 0; n < 2; ++n) acc[a][b][m][n] = acc_t{};
        cur = nxt; cA = nA; cB = nB; ++ui;
        if constexpr (ALIGN_EPI) { if (wr == 1) PG8_BAR; }
    }
    PG8_WAIT_V(0);
    if constexpr (!ALIGN_EPI) { if (wr == 0) PG8_BAR; }
    PG8_BAR;
    if constexpr (Epi::AFTER_DRAIN) { E.fused(acc, cur, wr, wc, fr, fq, lds, wid, lane); S.done(cur); }
#undef PG8_SA
#undef PG8_SB
#undef PG8_STAGE
#undef PG8_LDA
#undef PG8_LDB
#undef PG8_MMA
#undef PG8_WAIT_V
#undef PG8_WAIT_L
#undef PG8_BAR
#undef PG8_SCHED
}
}

#ifndef PG8_SP2
#define PG8_SP2 true
#endif
#ifndef PG8_ALIGN
#define PG8_ALIGN true
#endif
#include <hip/hip_bf16.h>
#include <cmath>
namespace attn_body {
using bf16=__hip_bfloat16;
using bf16x8=__attribute__((ext_vector_type(8)))short;
using s16x4=__attribute__((ext_vector_type(4)))short;
using f32x16=__attribute__((ext_vector_type(16)))float;
using u32x4=__attribute__((ext_vector_type(4)))unsigned;
constexpr int BATCH=4,SEQ=4096,D=64,DM=1024;
constexpr int NW=8,QBLK=32,QB=QBLK*NW,KVBLK=64,NQB=SEQ/QB;
constexpr int ATTN_PITCH=DM, ATTN_UNIT_ROWS=QB;
__device__ __forceinline__ int crow(int r,int hi){return (r&3)+8*(r>>2)+4*hi;}
#define SBAR() __builtin_amdgcn_sched_barrier(0)
__device__ __forceinline__ void cmask(f32x16&p0,f32x16&p1,int jb,int qrel,int hi){
  const float NEG=-INFINITY; int kb=64*jb+4*hi;
  #pragma unroll
  for(int r=0;r<16;++r){int kv=kb+(r&3)+8*(r>>2); if(kv>qrel)p0[r]=NEG; if(kv+32>qrel)p1[r]=NEG;}
}

constexpr int NSLOT=3, SLOTB=8192;
constexpr int VSLOTB=2*SLOTB;
constexpr int LDS_K=0, LDS_V=NSLOT*SLOTB, LDS_WS=LDS_V+NSLOT*VSLOTB, LDS_OST=LDS_WS+NW*64*4, LDS_BYTES=LDS_OST+NW*4096;
constexpr float C2=0.125f*1.4426950408889634f;
__device__ __forceinline__ void glds16(const void*gsrc,unsigned lds_dst){unsigned keep;
  asm volatile("s_mov_b32 %0, m0\n\ts_mov_b32 m0, %2\n\ts_nop 0\n\tglobal_load_lds_dwordx4 %1, off\n\ts_mov_b32 m0, %0":"=&s"(keep):"v"(gsrc),"s"(lds_dst):"memory");}
__device__ __forceinline__ float max3f(float a,float b,float c){float r;asm("v_max3_f32 %0, %1, %2, %3":"=v"(r):"v"(a),"v"(b),"v"(c));return r;}
__device__ __forceinline__ float max2f(float a,float b){float r;asm("v_max_f32_e32 %0, %1, %2":"=v"(r):"v"(a),"v"(b));return r;}
__device__ __forceinline__ float fadd_s(float a,float b){float r;asm("v_add_f32_e32 %0, %1, %2":"=v"(r):"v"(a),"v"(b));return r;}
__device__ __forceinline__ float fsub_s(float a,float b){float r;asm("v_sub_f32_e32 %0, %1, %2":"=v"(r):"v"(a),"v"(b));return r;}
typedef float f32x2_t __attribute__((ext_vector_type(2))); typedef __bf16 bf16x2_t __attribute__((ext_vector_type(2)));
__device__ __forceinline__ unsigned cvtpk_s(float lo,float hi){f32x2_t v={lo,hi};bf16x2_t b=__builtin_convertvector(v,bf16x2_t);return __builtin_bit_cast(unsigned,b);}
#define WAIT_BAR(N) asm volatile("s_waitcnt vmcnt(" #N ") lgkmcnt(0)\n\ts_barrier":::"memory")

__device__ __forceinline__ void qkt(f32x16&p0,f32x16&p1,const char*Kslot,const bf16x8*qr,const f32x16&negm,int r32,int hi){
  const char*kb=Kslot+hi*1024+r32*16;
  #pragma unroll
  for(int d0=0;d0<4;++d0){
    const bf16x8 b0=*reinterpret_cast<const bf16x8*>(kb+d0*2048);
    const bf16x8 b1=*reinterpret_cast<const bf16x8*>(kb+d0*2048+512);
    if(d0==0){p0=__builtin_amdgcn_mfma_f32_32x32x16_bf16(b0,qr[0],negm,0,0,0);p1=__builtin_amdgcn_mfma_f32_32x32x16_bf16(b1,qr[0],negm,0,0,0);}
    else{p0=__builtin_amdgcn_mfma_f32_32x32x16_bf16(b0,qr[d0],p0,0,0,0);p1=__builtin_amdgcn_mfma_f32_32x32x16_bf16(b1,qr[d0],p1,0,0,0);}}
}
typedef __attribute__((address_space(3))) const char* lds_cptr;
typedef short v4i16_t __attribute__((ext_vector_type(4)));
__device__ __forceinline__ void kload8(bf16x8*kf,lds_cptr kp){
  kf[0]=*(const __attribute__((address_space(3))) bf16x8*)(kp);      kf[1]=*(const __attribute__((address_space(3))) bf16x8*)(kp+512);
  kf[2]=*(const __attribute__((address_space(3))) bf16x8*)(kp+2048); kf[3]=*(const __attribute__((address_space(3))) bf16x8*)(kp+2560);
  kf[4]=*(const __attribute__((address_space(3))) bf16x8*)(kp+4096); kf[5]=*(const __attribute__((address_space(3))) bf16x8*)(kp+4608);
  kf[6]=*(const __attribute__((address_space(3))) bf16x8*)(kp+6144); kf[7]=*(const __attribute__((address_space(3))) bf16x8*)(kp+6656);
}
__device__ __forceinline__ void kload2(bf16x8*kf,lds_cptr kp,int j){ kf[2*j]=*(const __attribute__((address_space(3))) bf16x8*)(kp+j*2048); kf[2*j+1]=*(const __attribute__((address_space(3))) bf16x8*)(kp+j*2048+512); }
__device__ __forceinline__ s16x4 vtr(lds_cptr p){ return __builtin_bit_cast(s16x4,__builtin_amdgcn_ds_read_tr16_b64_v4i16((__attribute__((address_space(3))) v4i16_t*)p)); }
__device__ __forceinline__ float rowmax(const f32x16&p0,const f32x16&p1){
  float a=max3f(p0[0],p0[1],p1[0]),b=max3f(p0[2],p0[3],p1[1]);a=max3f(a,p1[2],p1[3]);
  #pragma unroll
  for(int r=4;r<16;r+=4){a=max3f(a,p0[r],p0[r+1]);b=max3f(b,p0[r+2],p0[r+3]);a=max3f(a,p1[r],p1[r+1]);b=max3f(b,p1[r+2],p1[r+3]);}
  const float m=max2f(a,b);
  auto rr=__builtin_amdgcn_permlane32_swap(__float_as_uint(m),__float_as_uint(m),false,false);
  return max2f(__uint_as_float(rr[0]),__uint_as_float(rr[1]));
}
__device__ __forceinline__ void pv(f32x16*o,int vb,bf16x8 pa0,bf16x8 pa1,bf16x8 pa2,bf16x8 pa3){
  #pragma unroll
  for(int d0=0;d0<4;++d0){s16x4 lo[4],hi[4];
    #pragma unroll
    for(int ks=0;ks<4;++ks){
      asm volatile("ds_read_b64_tr_b16 %0,%1 offset:%c2":"=&v"(lo[ks]):"v"(vb),"i"(d0*4096+ks*1024):"memory");
      asm volatile("ds_read_b64_tr_b16 %0,%1 offset:%c2":"=&v"(hi[ks]):"v"(vb),"i"(d0*4096+ks*1024+512):"memory");}
    asm volatile("s_waitcnt lgkmcnt(0)":::"memory");SBAR();
    #define PK(k) (bf16x8){lo[k][0],lo[k][1],lo[k][2],lo[k][3],hi[k][0],hi[k][1],hi[k][2],hi[k][3]}
    o[d0]=__builtin_amdgcn_mfma_f32_32x32x16_bf16(pa0,PK(0),o[d0],0,0,0);
    o[d0]=__builtin_amdgcn_mfma_f32_32x32x16_bf16(pa1,PK(1),o[d0],0,0,0);
    o[d0]=__builtin_amdgcn_mfma_f32_32x32x16_bf16(pa2,PK(2),o[d0],0,0,0);
    o[d0]=__builtin_amdgcn_mfma_f32_32x32x16_bf16(pa3,PK(3),o[d0],0,0,0);
    #undef PK
  }
}

#ifndef ATTN_STORE16
#define ATTN_STORE16(p,v) (*(u32x4*)(p)=(v))
#endif
template<int THRL> __device__ __forceinline__ void attn_unit(int b,int qcol,int vcol,int qb,const bf16*Q,const bf16*__restrict__ K,const bf16*__restrict__ V,bf16*O,char*shm,int tid){
  asm volatile("":"+v"(tid)); const int lane=tid&63,r32=lane&31,hi=lane>>5; const int wid=__builtin_amdgcn_readfirstlane(tid>>6);
  const long rowbase=(long)b*SEQ; const int q0=qb*QB;
  const bf16*Qw=Q+(rowbase+q0+wid*QBLK)*DM+qcol;
  const bf16*Kh=K+rowbase*DM+qcol,*Vh=V+rowbase*DM+vcol;
  const unsigned lds0=(unsigned)(uintptr_t)shm;
  float*wsf=(float*)(shm+LDS_WS)+wid*64;
  const bf16*ksrc=Kh+(long)lane*DM+wid*8;
  const bf16*vsrc=Vh+(long)(16*(wid&3)+(lane>>2))*DM+(wid>>2)*32+(lane&3)*8;
  const unsigned kdst=lds0+LDS_K+wid*1024, vdst=lds0+LDS_V+wid*1024;
  #define DMA_K(t,slot) glds16(ksrc+(long)(t)*KVBLK*DM,(unsigned)__builtin_amdgcn_readfirstlane(kdst+(slot)))
  #define DMA_V(t,slot) do{ glds16(vsrc+(long)(t)*KVBLK*DM,(unsigned)__builtin_amdgcn_readfirstlane(vdst+2*(slot))); glds16(vsrc+64+(long)(t)*KVBLK*DM,(unsigned)__builtin_amdgcn_readfirstlane(vdst+2*(slot)+8192)); }while(0)
  const int vb0=(int)(lds0+LDS_V)+((lane>>4)&1)*32+(lane&3)*8+(4*hi+((lane&15)>>2))*64;
  const char*Kbase=shm+LDS_K; bf16x8 kf[8];
  const lds_cptr shm3=(lds_cptr)shm; const lds_cptr kp0=shm3+LDS_K+hi*1024+r32*16; const lds_cptr vp0=shm3+LDS_V+((lane>>4)&1)*32+(lane&3)*8+(4*hi+((lane&15)>>2))*64;
  const int NT=(q0+QB)/KVBLK;
  DMA_K(0,0);DMA_V(0,0);DMA_K(1,SLOTB);
  bf16x8 qr[4];
  #pragma unroll
  for(int d0=0;d0<4;++d0)qr[d0]=*reinterpret_cast<const bf16x8*>(&Qw[(long)r32*DM+d0*16+hi*8]);
  float mhat=0.f,l_reg=0.f;f32x16 o[4];o[0]=f32x16{};o[1]=f32x16{};o[2]=f32x16{};o[3]=f32x16{};const f32x16 zero16=f32x16{};
  const int qrel=wid*QBLK+r32;
  #define CMASK(P0,P1,t) do{int jb_=(t)-(NT-4); if(jb_>=0)cmask(P0,P1,jb_,qrel,hi);}while(0)
  bool resc=false;
  #define START(P0,P1) do{ const float rm=rowmax(P0,P1); resc=false; \
    { const float dl=rm; mhat=fadd_s(mhat,dl); \
      _Pragma("unroll") for(int r=0;r<16;++r){P0[r]=fsub_s(P0[r],dl);P1[r]=fsub_s(P1[r],dl);} } \
    _Pragma("unroll") for(int r=0;r<16;++r)P0[r]=__builtin_amdgcn_exp2f(P0[r]); }while(0)
  #define RESC() do{ if(resc){ asm volatile("s_waitcnt lgkmcnt(0)":::"memory"); \
      _Pragma("unroll") for(int d_=0;d_<4;++d_) _Pragma("unroll") for(int r=0;r<16;++r)o[d_][r]*=wsf[crow(r,hi)]; } }while(0)
  f32x16 pA0,pA1,pB0,pB1;
  int sl_prev=0,sl_cur=0,sl_next=SLOTB;
  #define ROT() do{sl_prev=sl_cur;sl_cur=sl_next;sl_next=(sl_next==(NSLOT-1)*SLOTB)?0:sl_next+SLOTB;}while(0)
  DMA_K(2,2*SLOTB);
  WAIT_BAR(4);
  qkt(pA0,pA1,Kbase,qr,zero16,r32,hi);asm volatile("s_nop 15\n\ts_nop 7":"+v"(pA0),"+v"(pA1));CMASK(pA0,pA1,0);
  START(pA0,pA1);
  _Pragma("unroll") for(int r=0;r<16;++r)pA1[r]=__builtin_amdgcn_exp2f(pA1[r]);
  WAIT_BAR(0);
  DMA_K(3,0);DMA_V(1,SLOTB);
  ROT();
  kload8(kf,kp0+sl_cur);
  WAIT_BAR(3);
  s16x4 vlo[16],vhi[16]; u32x4 pw0,pw1,pw2,pw3;
  #define PKW(P,B) cvtpk_s(P[B],P[B+1])
  #define PAF(k) __builtin_bit_cast(bf16x8,pw##k)
  #define VFR(i) (bf16x8){vlo[i][0],vlo[i][1],vlo[i][2],vlo[i][3],vhi[i][0],vhi[i][1],vhi[i][2],vhi[i][3]}
  #define PIN(x) asm volatile("":"+v"(x))
  #define MX3(a,b,c) __builtin_fmaxf(__builtin_fmaxf((a),(b)),(c))
  #define GAPA(MF,A0,A1,A2,A3,W0,W1,PW) do{ MF; sacc+=A0; sacc+=A1; sacc+=A2; sacc+=A3; PIN(sacc); W0; W1; PIN(PW); SBAR(); }while(0)
  #define EX(v) __builtin_amdgcn_exp2f(v)
  #define GAPB(MF,X,B) do{ MF; X[B]=EX(X[B]-mhat); X[B+1]=EX(X[B+1]-mhat); PIN(X); SBAR(); }while(0)
  #define VRD(f) do{ vlo[f]=vtr(vp_+(((f)&3)*4096+((f)>>2)*1024)); vhi[f]=vtr(vp_+(((f)&3)*4096+((f)>>2)*1024+512)); }while(0)
  #define KRD(G,j) do{ if(G){ kload2(kf,kp0+sl_next,j); SBAR(); } }while(0)
  #define STEP(C0,C1,P0,P1,t,GK,GV,GL) do{ SBAR(); \
    const lds_cptr vp_=vp0+2*sl_prev; \
    float sacc=(P0[0]+P0[1]); \
    GAPA(C0=__builtin_amdgcn_mfma_f32_32x32x16_bf16(kf[0],qr[0],zero16,0,0,0), P0[2],P0[3],P0[4],P0[5],     pw0[0]=PKW(P0,0), pw0[1]=PKW(P0,2), pw0); \
    GAPA(C1=__builtin_amdgcn_mfma_f32_32x32x16_bf16(kf[1],qr[0],zero16,0,0,0), P0[6],P0[7],P0[8],P0[9],     pw0[2]=PKW(P0,4), pw0[3]=PKW(P0,6), pw0); \
    GAPA(C0=__builtin_amdgcn_mfma_f32_32x32x16_bf16(kf[2],qr[1],C0,0,0,0),   P0[10],P0[11],P0[12],P0[13], pw1[0]=PKW(P0,8), pw1[1]=PKW(P0,10), pw1); \
    GAPA(C1=__builtin_amdgcn_mfma_f32_32x32x16_bf16(kf[3],qr[1],C1,0,0,0),   P0[14],P0[15],P1[0],P1[1],   pw1[2]=PKW(P0,12),pw1[3]=PKW(P0,14), pw1); \
    VRD(0); SBAR(); GAPA(C0=__builtin_amdgcn_mfma_f32_32x32x16_bf16(kf[4],qr[2],C0,0,0,0),   P1[2],P1[3],P1[4],P1[5],     pw2[0]=PKW(P1,0), pw2[1]=PKW(P1,2), pw2); \
    VRD(1); SBAR(); GAPA(C1=__builtin_amdgcn_mfma_f32_32x32x16_bf16(kf[5],qr[2],C1,0,0,0),   P1[6],P1[7],P1[8],P1[9],     pw2[2]=PKW(P1,4), pw2[3]=PKW(P1,6), pw2); \
    VRD(2); SBAR(); GAPA(C0=__builtin_amdgcn_mfma_f32_32x32x16_bf16(kf[6],qr[3],C0,0,0,0),   P1[10],P1[11],P1[12],P1[13], pw3[0]=PKW(P1,8), pw3[1]=PKW(P1,10), pw3); \
    VRD(3); SBAR(); GAPA(C1=__builtin_amdgcn_mfma_f32_32x32x16_bf16(kf[7],qr[3],C1,0,0,0),   P1[14],P1[15],0.f,0.f,       pw3[2]=PKW(P1,12),pw3[3]=PKW(P1,14), pw3); \
    l_reg+=sacc; \
    if(GK){DMA_K((t)+3,sl_cur);} if(GV){DMA_V((t)+1,sl_next);} \
    CMASK(C0,C1,t); \
    { float a=MX3(C0[0],C0[1],C1[0]),b=MX3(C0[2],C0[3],C1[1]); a=MX3(a,C1[2],C1[3]); \
      _Pragma("unroll") for(int r=4;r<16;r+=4){a=MX3(a,C0[r],C0[r+1]);b=MX3(b,C0[r+2],C0[r+3]);a=MX3(a,C1[r],C1[r+1]);b=MX3(b,C1[r+2],C1[r+3]);} \
      float rm=__builtin_fmaxf(a,b); { auto rr=__builtin_amdgcn_permlane32_swap(__float_as_uint(rm),__float_as_uint(rm),false,false); rm=__builtin_fmaxf(__uint_as_float(rr[0]),__uint_as_float(rr[1])); } \
      rm-=mhat; resc=false;     \
      if(__builtin_expect(__any(rm>(float)THRL),0)){ const float dl=__builtin_fmaxf(rm,0.f); mhat+=dl; \
        const float f=__builtin_amdgcn_exp2f(-dl); l_reg*=f; if(hi==0)wsf[r32]=f; resc=true; } } \
    SBAR(); \
    VRD(4);  SBAR(); GAPB(o[0]=__builtin_amdgcn_mfma_f32_32x32x16_bf16(PAF(0),VFR(0),o[0],0,0,0),  C0,0); \
    VRD(5);  SBAR(); GAPB(o[1]=__builtin_amdgcn_mfma_f32_32x32x16_bf16(PAF(0),VFR(1),o[1],0,0,0),  C0,2); \
    VRD(6);  SBAR(); GAPB(o[2]=__builtin_amdgcn_mfma_f32_32x32x16_bf16(PAF(0),VFR(2),o[2],0,0,0),  C0,4); \
    VRD(7);  SBAR(); GAPB(o[3]=__builtin_amdgcn_mfma_f32_32x32x16_bf16(PAF(0),VFR(3),o[3],0,0,0),  C0,6); \
    VRD(8);  SBAR(); GAPB(o[0]=__builtin_amdgcn_mfma_f32_32x32x16_bf16(PAF(1),VFR(4),o[0],0,0,0),  C0,8); \
    VRD(9);  SBAR(); GAPB(o[1]=__builtin_amdgcn_mfma_f32_32x32x16_bf16(PAF(1),VFR(5),o[1],0,0,0),  C0,10); \
    VRD(10); SBAR(); GAPB(o[2]=__builtin_amdgcn_mfma_f32_32x32x16_bf16(PAF(1),VFR(6),o[2],0,0,0),  C0,12); \
    VRD(11); SBAR(); GAPB(o[3]=__builtin_amdgcn_mfma_f32_32x32x16_bf16(PAF(1),VFR(7),o[3],0,0,0),  C0,14); \
    VRD(12); SBAR(); GAPB(o[0]=__builtin_amdgcn_mfma_f32_32x32x16_bf16(PAF(2),VFR(8),o[0],0,0,0),  C1,0); \
    VRD(13); SBAR(); GAPB(o[1]=__builtin_amdgcn_mfma_f32_32x32x16_bf16(PAF(2),VFR(9),o[1],0,0,0),  C1,2); \
    VRD(14); SBAR(); GAPB(o[2]=__builtin_amdgcn_mfma_f32_32x32x16_bf16(PAF(2),VFR(10),o[2],0,0,0), C1,4); \
    VRD(15); SBAR(); GAPB(o[3]=__builtin_amdgcn_mfma_f32_32x32x16_bf16(PAF(2),VFR(11),o[3],0,0,0), C1,6); \
    KRD(GL,0); GAPB(o[0]=__builtin_amdgcn_mfma_f32_32x32x16_bf16(PAF(3),VFR(12),o[0],0,0,0), C1,8); \
    KRD(GL,1); GAPB(o[1]=__builtin_amdgcn_mfma_f32_32x32x16_bf16(PAF(3),VFR(13),o[1],0,0,0), C1,10); \
    KRD(GL,2); GAPB(o[2]=__builtin_amdgcn_mfma_f32_32x32x16_bf16(PAF(3),VFR(14),o[2],0,0,0), C1,12); \
    KRD(GL,3); GAPB(o[3]=__builtin_amdgcn_mfma_f32_32x32x16_bf16(PAF(3),VFR(15),o[3],0,0,0), C1,14); \
    }while(0)
  int t=1;
  #undef CMASK
  #define CMASK(P0,P1,t) do{}while(0)
  for(;t+5<NT;t+=2){
    STEP(pB0,pB1,pA0,pA1,t,true,true,true);     WAIT_BAR(3); RESC(); ROT();
    STEP(pA0,pA1,pB0,pB1,t+1,true,true,true);   WAIT_BAR(3); RESC(); ROT();
  }
  #undef CMASK
  #define CMASK(P0,P1,t) do{int jb_=(t)-(NT-4); if(jb_>=0)cmask(P0,P1,jb_,qrel,hi);}while(0)
  #define ENDW(tt) do{ if((tt)+3<NT){WAIT_BAR(3);} else if((tt)+2<NT){WAIT_BAR(2);} else {WAIT_BAR(0);} }while(0)
  for(;t+1<NT;t+=2){
    STEP(pB0,pB1,pA0,pA1,t,(t+3<NT),(t+1<NT),(t+1<NT));       ENDW(t);   RESC(); ROT();
    STEP(pA0,pA1,pB0,pB1,t+1,(t+4<NT),(t+2<NT),(t+2<NT));     ENDW(t+1); RESC(); ROT();
  }
  STEP(pB0,pB1,pA0,pA1,NT-1,false,false,false); RESC();
  { float sacc=pB0[0]+pB0[1]; _Pragma("unroll") for(int r=2;r<16;++r)sacc+=pB0[r]; _Pragma("unroll") for(int r=0;r<16;++r)sacc+=pB1[r]; l_reg+=sacc;
    pw0=(u32x4){PKW(pB0,0),PKW(pB0,2),PKW(pB0,4),PKW(pB0,6)};pw1=(u32x4){PKW(pB0,8),PKW(pB0,10),PKW(pB0,12),PKW(pB0,14)};pw2=(u32x4){PKW(pB1,0),PKW(pB1,2),PKW(pB1,4),PKW(pB1,6)};pw3=(u32x4){PKW(pB1,8),PKW(pB1,10),PKW(pB1,12),PKW(pB1,14)};
    SBAR(); pv(o,vb0+2*sl_cur,PAF(0),PAF(1),PAF(2),PAF(3)); }
  #undef PKW
  #undef PAF
  #undef VFR
  #undef PIN
  #undef MX3
  #undef GAPA
  #undef GAPB
  #undef EX
  #undef VRD
  #undef KRD
  #undef STEP
  #undef ENDW
  {auto rr=__builtin_amdgcn_permlane32_swap(__float_as_uint(l_reg),__float_as_uint(l_reg),false,false);l_reg=__uint_as_float(rr[0])+__uint_as_float(rr[1]);}
  if(hi==0)wsf[32+r32]=l_reg;asm volatile("s_waitcnt lgkmcnt(0)":::"memory");
  float rli[16];
  #pragma unroll
  for(int r=0;r<16;++r)rli[r]=__builtin_amdgcn_rcpf(wsf[32+crow(r,hi)]);
  bf16*Ow=O+(rowbase+q0+wid*QBLK)*DM+vcol;
  { bf16*stg=(bf16*)(shm+LDS_OST)+wid*2048;
    #pragma unroll
    for(int h2=0;h2<2;++h2){
      #pragma unroll
      for(int r=0;r<16;++r){const int orow=crow(r,hi);
        #pragma unroll
        for(int d0=0;d0<2;++d0)stg[orow*64+d0*32+r32]=__float2bfloat16(o[2*h2+d0][r]*rli[r]);}
      asm volatile("s_waitcnt lgkmcnt(0)":::"memory");
      #pragma unroll
      for(int i=0;i<4;++i){const int row=i*8+(lane>>3),ch=lane&7; const u32x4 v=*(const u32x4*)(stg+row*64+ch*8); ATTN_STORE16(Ow+(long)row*DM+64*h2+ch*8,v);}
      asm volatile("s_waitcnt lgkmcnt(0)":::"memory"); } }
  asm volatile("s_waitcnt lgkmcnt(0)\n\ts_barrier":::"memory");
  #undef DMA_K
  #undef DMA_V
  #undef CMASK
  #undef START
  #undef RESC
  #undef ROT
}
constexpr int ATTN_LDS_BYTES=LDS_BYTES;
struct AttnTensors { const bf16* Q; const bf16* K; const bf16* V; bf16* O0; bf16* O1; };
template<int THRL=8> __device__ __forceinline__ void attn_phase(char*lds,const AttnTensors&T,int vcu,int G,int tid){
  for(int i=0;;++i){
    int b,hc,qb;
    if(G==256){ if(i>=4)break; const int pr=vcu>>2; b=pr>>4; hc=pr&15; const int s=(vcu&3)+4*(i>>1); qb=(i&1)?15-s:s; }
    else { const int L=i*G+vcu; if(L>=BATCH*16*NQB)break; qb=L%NQB; hc=(L/NQB)&15; b=L/(NQB*16); }
    attn_unit<THRL>(b,hc*64,(hc>>1)*128,qb,T.Q,T.K,T.V,(hc&1)?T.O1:T.O0,lds,tid);
  }
}
#undef SBAR
#undef WAIT_BAR
}
constexpr int NWAVES = 8;
#ifndef MK_N_LAUNCHES
#define MK_N_LAUNCHES 1
#endif
constexpr int N_PHASES = 28;
constexpr bool MOE_DOWN_F8 = true;
constexpr unsigned DOWN_I8 = 3u;
constexpr int N_LAUNCHES = MK_N_LAUNCHES;
static_assert(N_LAUNCHES == 1 || N_LAUNCHES == N_PHASES, "MK_N_LAUNCHES is 1 or 28");

constexpr int DM = 2048, BATCH = 4, SEQ = 4096, M = BATCH * SEQ, DEPTH = 2, INC = 4608, FF = 7168, NEXP = 8, PLED = 256;
constexpr int MAXSLOT = 136 * 256;
constexpr float LAM_INIT0 = 0.2f, LAM_INIT1 = 0.35550906759f;
constexpr size_t MiB = 1u << 20;
constexpr size_t WS_CTL = 0, CTL_ZERO_BYTES = 256 * 1024;
constexpr size_t WS_HIST = 1 * MiB;
constexpr size_t WS_ROPE = 2 * MiB;
constexpr size_t WS_SEL = 3 * MiB;
constexpr size_t WS_SWGU = WS_HIST + 65536;
constexpr size_t WS_SWIN = WS_HIST + 65536 + 524288, WS_SWPG = WS_HIST + 640 * 1024;
constexpr size_t WS_SWD = WS_HIST + 704 * 1024, WS_SAH = WS_HIST + 800 * 1024;
constexpr int CW_DMAX = 32768;
constexpr size_t WS_SATOK = WS_SEL + 640 * 1024, WS_SAS = WS_SEL + 768 * 1024;
constexpr size_t WS_WIN = 4 * MiB, WS_WOUT = 40 * MiB, WS_BD = 56 * MiB, WS_WPG = 60 * MiB, WS_WPP = 76 * MiB, WS_PBF = 78 * MiB;
constexpr size_t WS_WOHI = 68 * MiB;
constexpr size_t WS_WGUD = 94 * MiB, WS_WDD = 122 * MiB, WS_WGUE = 150 * MiB, WS_WDE = 374 * MiB, WS_HPQ = 598 * MiB;
constexpr size_t WS_U = 850 * MiB, WS_PP = 914 * MiB;
constexpr size_t WS_Q = 978 * MiB, WS_K = 1010 * MiB, WS_V = 1042 * MiB, WS_ZP = 1074 * MiB, WS_CG = 1090 * MiB, WS_O0 = 1106 * MiB, WS_O1 = 1138 * MiB, WS_DS = 1170 * MiB, WS_CAT = 1202 * MiB;
constexpr size_t WS_XP = 978 * MiB, WS_Y = 1114 * MiB;
constexpr size_t WS_HP = 1266 * MiB, WS_END = 1742 * MiB;
static_assert(WS_XP + (size_t)MAXSLOT * DM * 2 <= WS_Y && WS_Y + (size_t)MAXSLOT * DM * 2 <= WS_HP && WS_HP + (size_t)MAXSLOT * FF * 2 <= WS_END, "d_ws map");
static_assert(WS_WDE + (size_t)NEXP * DM * FF * 2 <= WS_HPQ && WS_HPQ + (size_t)MAXSLOT * FF <= WS_U && WS_WGUE + (size_t)NEXP * 2 * FF * DM <= WS_WDE && WS_WGUD + (size_t)2 * FF * DM <= WS_WDD && WS_WDD + (size_t)DM * FF * 2 <= WS_WGUE && WS_CAT + (size_t)M * DM * 2 <= WS_HP, "d_ws map");
constexpr int CW_TMO = 0, CW_CODE = 1, CW_BAR = 4096;
constexpr int RING_OFF = 0, RING_BYTES = 131072;
constexpr int LDSCTL_OFF = RING_BYTES, MISC_OFF = LDSCTL_OFF + 320;
constexpr int MOE_OFF = LDSCTL_OFF;
constexpr int PTR_OFF = MISC_OFF + 128;
constexpr int CM_OFF = PTR_OFF + 256;
constexpr int LDS_BYTES = 147456;
static_assert(CM_OFF + 128 <= LDS_BYTES, "LDS map");

#define GAS __attribute__((address_space(1)))
#define LAS __attribute__((address_space(3)))
typedef unsigned short bf16;
typedef unsigned v4u __attribute__((ext_vector_type(4)));
typedef unsigned v2u __attribute__((ext_vector_type(2)));
typedef int v4i __attribute__((ext_vector_type(4)));
typedef float f32x4 __attribute__((ext_vector_type(4)));
typedef short bf16x8 __attribute__((ext_vector_type(8)));
typedef GAS unsigned gu32;
typedef GAS unsigned long long gu64;
#define RLX_AGENT __ATOMIC_RELAXED, __HIP_MEMORY_SCOPE_AGENT
#define LDS_WAIT() asm volatile("s_waitcnt lgkmcnt(0)" ::: "memory")
#define VM_WAIT() asm volatile("s_waitcnt vmcnt(0)" ::: "memory")
__device__ __forceinline__ unsigned f2bf(float f) { unsigned u = __builtin_bit_cast(unsigned, f); return (u + 0x7fffu + ((u >> 16) & 1u)) >> 16; }
__device__ __forceinline__ unsigned pk2(float lo, float hi) { return f2bf(lo) | (f2bf(hi) << 16); }
__device__ __forceinline__ float bflo(unsigned w) { return __uint_as_float(w << 16); }
__device__ __forceinline__ float bfhi(unsigned w) { return __uint_as_float(w & 0xffff0000u); }
__device__ __forceinline__ float sigm(float x) { return __builtin_amdgcn_rcpf(1.0f + __builtin_amdgcn_exp2f(-1.4426950408889634f * x)); }

#define XB_TMO      128
#define XB_XCNT(j)  (256  + 64 * (j))
#define XB_XSUB(j)  (1280 + 64 * (j))
#define XB_XGEN(j)  (2304 + 64 * (j))
#define XB_TOP      3328
#define XB_TOPGEN   3392
#define XCD_BAR_WORDS 3456
#define XB_SPIN_CAP (1u << 18)

__device__ __forceinline__ unsigned xb_ld(unsigned* p)              { return __hip_atomic_load(p, __ATOMIC_RELAXED, __HIP_MEMORY_SCOPE_AGENT); }
__device__ __forceinline__ unsigned xb_add(unsigned* p, unsigned v) { return __hip_atomic_fetch_add(p, v, __ATOMIC_RELAXED, __HIP_MEMORY_SCOPE_AGENT); }
__device__ __forceinline__ unsigned xb_xcc_id() { return (unsigned)__builtin_amdgcn_s_getreg((3 << 11) | 20) & 0xFu; }
#define XB_SPIN(cond, bar) do { unsigned _sp = 0; while (cond) { __builtin_amdgcn_s_sleep(1); \
    if ((++_sp & 255u) == 0u) { if (xb_ld(&(bar)[XB_TMO])) break; if (_sp > XB_SPIN_CAP) { atomicAdd(&(bar)[XB_TMO], 1u); break; } } } } while (0)

struct XcdBarrier {
    unsigned* bar; unsigned x;
    volatile LAS unsigned* st;
};

__device__ __forceinline__ XcdBarrier xcd_barrier_post(unsigned* bar, volatile LAS unsigned* st) {
    XcdBarrier b; b.bar = bar; b.x = xb_xcc_id(); b.st = st;
    if (threadIdx.x == 0) (void)xb_add(&bar[XB_XCNT(b.x)], 1u);
    return b;
}
__device__ __forceinline__ void xcd_barrier_complete(unsigned* bar, unsigned x, unsigned& nloc, unsigned& nx) {
    const unsigned G = gridDim.x * gridDim.y * gridDim.z;
    unsigned sum, cnt, mine, sp = 0u;
    for (;;) {
        sum = 0u; cnt = 0u; mine = 0u;
#pragma unroll
        for (unsigned j = 0; j < 16; ++j) { const unsigned c = xb_ld(&bar[XB_XCNT(j)]); sum += c; cnt += (c > 0u) ? 1u : 0u; mine = (j == x) ? c : mine; }
        if (sum == G) break;
        __builtin_amdgcn_s_sleep(1);
        if ((++sp & 255u) == 0u) { if (xb_ld(&bar[XB_TMO])) break; if (sp > XB_SPIN_CAP) { atomicAdd(&bar[XB_TMO], 1u); break; } }
    }
    nloc = mine > 0u ? mine : 1u; nx = cnt > 0u ? cnt : 1u;
}

__device__ __forceinline__ void xcd_barrier(const XcdBarrier& b, const bool leader  ) {
    asm volatile("s_waitcnt vmcnt(0)" ::: "memory");
    __syncthreads();
    if (leader) {
        unsigned* bar = b.bar;
        __builtin_amdgcn_s_waitcnt(0);
        unsigned nloc = b.st[0], nx = b.st[1];
        if (nloc == 0u) { xcd_barrier_complete(bar, b.x, nloc, nx); b.st[0] = nloc; b.st[1] = nx; }
        const unsigned old = xb_add(&bar[XB_XSUB(b.x)], 1u);
        const unsigned gen = old / nloc;
        if (old + 1u == (gen + 1u) * nloc) {
            __builtin_amdgcn_fence(__ATOMIC_RELEASE, "agent");
            asm volatile("s_waitcnt vmcnt(0)" ::: "memory");
            const unsigned og = xb_add(&bar[XB_TOP], 1u);
            const unsigned tg = og / nx;
            if (og + 1u == (tg + 1u) * nx) xb_add(&bar[XB_TOPGEN], 1u);
            else XB_SPIN(xb_ld(&bar[XB_TOPGEN]) == tg, bar);
            __builtin_amdgcn_fence(__ATOMIC_ACQUIRE, "agent");
            xb_add(&bar[XB_XGEN(b.x)], 1u);
            asm volatile("s_waitcnt vmcnt(0)" ::: "memory");
        } else {
            XB_SPIN(xb_ld(&bar[XB_XGEN(b.x)]) == gen, bar);
            __builtin_amdgcn_fence(__ATOMIC_ACQUIRE, "agent");
            asm volatile("s_waitcnt vmcnt(0)" ::: "memory");
        }
    }
    __syncthreads();
}

struct Frame {
    LAS unsigned char* lds;
    int tid, lane, wave, vcu, G;
    __device__ __forceinline__ const void* ptr(int k) const { const LAS unsigned* t = (const LAS unsigned*)(lds + PTR_OFF) + 2 * k;
        const unsigned lo = (unsigned)__builtin_amdgcn_readfirstlane((int)t[0]), hi = (unsigned)__builtin_amdgcn_readfirstlane((int)t[1]); return (const void*)(const GAS unsigned char*)(((unsigned long long)hi << 32) | lo); }
    __device__ __forceinline__ const float* inf(int k) const { return (const float*)ptr(k); }
    __device__ __forceinline__ float* outp() const { return (float*)ptr(30); }
    __device__ __forceinline__ unsigned char* wsp() const { return (unsigned char*)ptr(31); }
};
__device__ __forceinline__ Frame make_frame(LAS unsigned char* lds, int wave_s) {
    Frame F; int tid = wave_s * 64 + (int)__builtin_amdgcn_mbcnt_hi(~0u, __builtin_amdgcn_mbcnt_lo(~0u, 0u)); asm volatile("" : "+v"(tid)); asm volatile("" ::: "memory");
    { unsigned lb = (unsigned)(unsigned long long)lds; asm volatile("" : "+s"(lb)); F.lds = (LAS unsigned char*)lb; }
    F.tid = tid; F.lane = tid & 63; F.wave = __builtin_amdgcn_readfirstlane(tid >> 6);
    F.G = gridDim.x; { const int bx = blockIdx.x; F.vcu = (F.G % 8 == 0) ? (bx % 8) * (F.G / 8) + bx / 8 : bx; }
    return F;
}
template <int CTRL, int ROWMASK> __device__ __forceinline__ float dpp_mov(float old, float v) { return __int_as_float(__builtin_amdgcn_update_dpp(__float_as_int(old), __float_as_int(v), CTRL, ROWMASK, 0xf, false)); }
__device__ __forceinline__ float row8_sum(float v) {
    v += dpp_mov<0xB1, 0xf>(0.f, v); v += dpp_mov<0x4E, 0xf>(0.f, v); v += dpp_mov<0x141, 0xf>(0.f, v); return v; }
__device__ __forceinline__ float wave_sum(float v) {
    v = row8_sum(v); v += dpp_mov<0x140, 0xf>(0.f, v);
    v += dpp_mov<0x142, 0xa>(0.f, v); v += dpp_mov<0x143, 0xc>(0.f, v);
    return __int_as_float(__builtin_amdgcn_readlane(__float_as_int(v), 63));
}
__device__ __forceinline__ int wave_sum_i(int v) {
#define DPPI(ctrl, rm) __builtin_amdgcn_update_dpp(0, v, ctrl, rm, 0xf, false)
    v += DPPI(0xB1, 0xf); v += DPPI(0x4E, 0xf); v += DPPI(0x141, 0xf); v += DPPI(0x140, 0xf); v += DPPI(0x142, 0xa); v += DPPI(0x143, 0xc);
#undef DPPI
    return __builtin_amdgcn_readlane(v, 63);
}
__device__ __forceinline__ float max_x8_x16(float a) {
    a = fmaxf(a, dpp_mov<0x128, 0xf>(a, a));
    a = fmaxf(a, __int_as_float(__builtin_amdgcn_ds_swizzle(__float_as_int(a), 0x401F)));
    return a;
}
__device__ __forceinline__ float wave_max(float v) {
    v = fmaxf(v, dpp_mov<0xB1, 0xf>(v, v)); v = fmaxf(v, dpp_mov<0x4E, 0xf>(v, v)); v = fmaxf(v, dpp_mov<0x141, 0xf>(v, v)); v = fmaxf(v, dpp_mov<0x140, 0xf>(v, v));
    v = fmaxf(v, dpp_mov<0x142, 0xa>(v, v)); v = fmaxf(v, dpp_mov<0x143, 0xc>(v, v));
    return __int_as_float(__builtin_amdgcn_readlane(__float_as_int(v), 63));
}
enum { MAP_ID = 0, MAP_WIN = 1, MAP_GU0 = 2, MAP_GU1 = 3 };
__device__ __forceinline__ int dst_row(int mode, int n) {
    if (mode == MAP_ID) return n;
    if (mode == MAP_WIN) {
        if (n < 2048) { const int d = n & 63, b = n & ~63; const int p = d < 8 ? 2 * d : (d < 16 ? 2 * (d - 8) + 1 : d); return b + p; }
        if (n < 3584) return n;
        if (n < 4096) { const int ch = n - 3584; return 3584 + 256 * (ch >> 7) + (ch & 127); }
        { const int ch = n - 4096; return 3584 + 256 * (ch >> 7) + 128 + (ch & 127); }
    }
    return 256 * (n >> 7) + (mode == MAP_GU1 ? 128 : 0) + (n & 127);
}
__device__ __forceinline__ void p0_transpose_item(const float* W, int K, int N, bf16* WT, int mode, LAS float* scr, int item, int lane, int ldt = 0) {
    if (ldt == 0) ldt = K;
    const int nblk = N / 32, kb = item / nblk, nb = item % nblk, k0 = 64 * kb, n0 = 32 * nb;
    float tv[32];
#pragma unroll
    for (int i = 0; i < 32; ++i) { const int kk = 2 * i + (lane >> 5); tv[i] = W[(size_t)(k0 + kk) * N + n0 + (lane & 31)]; }
#pragma unroll
    for (int i = 0; i < 32; ++i) { const int kk = 2 * i + (lane >> 5); scr[kk * 33 + (lane & 31)] = tv[i]; }
    LDS_WAIT(); asm volatile("" ::: "memory");
    const int c = lane & 7;
#pragma unroll
    for (int j = 0; j < 4; ++j) { const int n = (lane >> 3) + 8 * j; const LAS float* s = scr + (8 * c) * 33 + n;
        v4u o; o.x = pk2(s[0 * 33], s[1 * 33]); o.y = pk2(s[2 * 33], s[3 * 33]); o.z = pk2(s[4 * 33], s[5 * 33]); o.w = pk2(s[6 * 33], s[7 * 33]);
        *(GAS v4u*)(WT + (size_t)dst_row(mode, n0 + n) * ldt + k0 + 8 * c) = o; }
    LDS_WAIT(); asm volatile("" ::: "memory");
}
__device__ __forceinline__ unsigned q4_i8(float a, float b, float c, float d, float iv) {
    const float MG = 12582912.f;
    const unsigned A = __float_as_uint(__builtin_fmaf(a, iv, MG)), B = __float_as_uint(__builtin_fmaf(b, iv, MG)), C = __float_as_uint(__builtin_fmaf(c, iv, MG)), D = __float_as_uint(__builtin_fmaf(d, iv, MG));
    return __builtin_amdgcn_perm(B, A, 0x0c0c0400u) | __builtin_amdgcn_perm(D, C, 0x04000c0cu);
}
struct StripJob { const float* W; unsigned char* W8; float* sw; int N, n0, mode; };
#define LDS_BAR() asm volatile("s_waitcnt lgkmcnt(0)\n\ts_barrier" ::: "memory")
__device__ __forceinline__ StripJob strip_job(Frame& F, int st0) {
    constexpr int NS_IN = 2 * (INC / 32), NS_PG = 2 * (DM / 32);
    StripJob j;
    if (st0 < NS_IN) { const int L = st0 / (INC / 32), nb = st0 % (INC / 32);
        j.W = (const float*)F.ptr(4) + (size_t)L * DM * INC; j.N = INC; j.n0 = 32 * nb; j.mode = MAP_WIN; j.W8 = (unsigned char*)(F.wsp() + WS_WIN) + (size_t)L * INC * DM; j.sw = (float*)(F.wsp() + WS_SWIN) + L * INC; return j; }
    if (st0 < NS_IN + NS_PG) { const int q2 = st0 - NS_IN, L = q2 / (DM / 32), nb = q2 % (DM / 32);
        j.W = (const float*)F.ptr(27) + (size_t)L * DM * DM; j.N = DM; j.n0 = 32 * nb; j.mode = MAP_ID; j.W8 = (unsigned char*)(F.wsp() + WS_WPG) + (size_t)L * DM * DM; j.sw = (float*)(F.wsp() + WS_SWPG) + L * DM; return j; }
    const int st = st0 - NS_IN - NS_PG, s = st / (2 * (FF / 32)), q = st % (2 * (FF / 32)), which = q / (FF / 32), nb = q % (FF / 32);
    j.W = s == 0 ? (const float*)F.ptr(which ? 20 : 19) : (const float*)F.ptr(which ? 24 : 23) + (size_t)(s - 1) * DM * FF; j.N = FF; j.n0 = 32 * nb; j.mode = which ? MAP_GU1 : MAP_GU0;
    j.W8 = (unsigned char*)(F.wsp() + (s == 0 ? WS_WGUD : WS_WGUE)) + (s == 0 ? (size_t)0 : (size_t)(s - 1) * 2 * FF * DM); j.sw = (float*)(F.wsp() + WS_SWGU) + (size_t)s * 2 * FF; return j;
}
__device__ __forceinline__ void strip_load(Frame& F, const StripJob& j, f32x4 (&v)[8][4]) {
    const int c4 = F.lane & 7, rs = F.lane >> 3;
    const GAS unsigned char* Wb = (const GAS unsigned char*)((const GAS float*)j.W + j.n0); const unsigned toff = (unsigned)((32 * F.wave + 4 * rs) * j.N + 4 * c4) * 4u;
#pragma unroll
    for (int it = 0; it < 8; ++it)
#pragma unroll
        for (int jj = 0; jj < 4; ++jj) v[it][jj] = __builtin_nontemporal_load((const GAS f32x4*)(Wb + (size_t)(256 * it + jj) * (size_t)j.N * 4 + toff));
}
__device__ __forceinline__ void strip_quant(Frame& F, const StripJob& j, f32x4 (&v)[8][4], bool hasn, const StripJob& nj) {
    LAS unsigned* cm = (LAS unsigned*)(F.lds + CM_OFF); LAS unsigned* lq = (LAS unsigned*)(F.lds + RING_OFF);
    const int c4 = F.lane & 7, rs = F.lane >> 3;
    if (F.tid < 32) cm[F.tid] = 0u;
    f32x4 am = (f32x4){0.f, 0.f, 0.f, 0.f};
#pragma unroll
    for (int it = 0; it < 8; ++it)
#pragma unroll
        for (int jj = 0; jj < 4; ++jj)
#pragma unroll
            for (int cc = 0; cc < 4; ++cc) am[cc] = fmaxf(am[cc], fabsf(v[it][jj][cc]));
#pragma unroll
    for (int cc = 0; cc < 4; ++cc) am[cc] = max_x8_x16(am[cc]);
    LDS_BAR();
    if ((F.lane & 31) < 8) {
#pragma unroll
        for (int cc = 0; cc < 4; ++cc) atomicMax((unsigned*)&cm[4 * c4 + cc], __float_as_uint(am[cc])); }
    LDS_BAR();
    float iv[4];
#pragma unroll
    for (int cc = 0; cc < 4; ++cc) { const float mx = __uint_as_float(cm[4 * c4 + cc]); iv[cc] = mx > 0.f ? 127.f / mx : 0.f; }
    const GAS unsigned char* nWb = (const GAS unsigned char*)((const GAS float*)nj.W + nj.n0); const unsigned ntoff = (unsigned)((32 * F.wave + 4 * rs) * nj.N + 4 * c4) * 4u;
    if (F.tid < 32) { const float mx = __uint_as_float(cm[F.tid]); j.sw[dst_row(j.mode, j.n0 + F.tid)] = mx > 0.f ? mx * (1.f / 127.f) : 1.f; }
#pragma unroll
    for (int it = 0; it < 8; ++it) { const int kd = 64 * it + 8 * F.wave + rs;
#pragma unroll
        for (int cc = 0; cc < 4; ++cc) { const int n = 4 * c4 + cc; lq[n * 512 + (kd ^ n)] = q4_i8(v[it][0][cc], v[it][1][cc], v[it][2][cc], v[it][3][cc], iv[cc]); }
        if (hasn) {
#pragma unroll
            for (int jj = 0; jj < 4; ++jj) v[it][jj] = __builtin_nontemporal_load((const GAS f32x4*)(nWb + (size_t)(256 * it + jj) * (size_t)nj.N * 4 + ntoff)); } }
    LDS_BAR();
#pragma unroll
    for (int i = 0; i < 8; ++i) { const int nn = 4 * i + (F.wave >> 1), c = 64 * (F.wave & 1) + F.lane;
        v4u x = ((const LAS v4u*)lq)[nn * 128 + (c ^ (nn >> 2))];
        if (nn & 1) { unsigned t = x.x; x.x = x.y; x.y = t; t = x.z; x.z = x.w; x.w = t; }
        if (nn & 2) { unsigned t = x.x; x.x = x.z; x.z = t; t = x.y; x.y = x.w; x.w = t; }
        *(GAS v4u*)(j.W8 + (size_t)dst_row(j.mode, j.n0 + nn) * 2048 + 16 * c) = x; }
    LDS_BAR();
}
__device__ __forceinline__ bool down_i8_set(int s) { return s == 0 ? (DOWN_I8 & 1u) != 0u : (DOWN_I8 & 2u) != 0u; }
__device__ __forceinline__ void p0_down_amax(Frame& F) {
    const int s = F.vcu % 9, idx = F.vcu / 9;
    if (F.vcu >= 252 || !down_i8_set(s)) return;
    const float* wd = s == 0 ? (const float*)F.ptr(21) : (const float*)F.ptr(25) + (size_t)(s - 1) * FF * DM;
    LAS unsigned* lm = (LAS unsigned*)(F.lds + RING_OFF);
    __syncthreads();
    for (int i = F.tid; i < DM; i += NWAVES * 64) lm[i] = 0u;
    __syncthreads();
    f32x4 mx[8];
#pragma unroll
    for (int j = 0; j < 8; ++j) mx[j] = (f32x4){0.f, 0.f, 0.f, 0.f};
#pragma unroll 2
    for (int r = F.wave; r < 256; r += NWAVES) { const GAS f32x4* p = (const GAS f32x4*)(wd + (size_t)(idx * 256 + r) * DM) + F.lane;
#pragma unroll
        for (int j = 0; j < 8; ++j) { const f32x4 v = p[64 * j]; mx[j].x = fmaxf(mx[j].x, fabsf(v.x)); mx[j].y = fmaxf(mx[j].y, fabsf(v.y)); mx[j].z = fmaxf(mx[j].z, fabsf(v.z)); mx[j].w = fmaxf(mx[j].w, fabsf(v.w)); } }
#pragma unroll
    for (int j = 0; j < 8; ++j) { const int c = 4 * (F.lane + 64 * j); atomicMax((unsigned*)&lm[c], __float_as_uint(mx[j].x)); atomicMax((unsigned*)&lm[c + 1], __float_as_uint(mx[j].y)); atomicMax((unsigned*)&lm[c + 2], __float_as_uint(mx[j].z)); atomicMax((unsigned*)&lm[c + 3], __float_as_uint(mx[j].w)); }
    __syncthreads();
    unsigned* dmax = (unsigned*)(F.wsp() + WS_CTL) + CW_DMAX + s * DM;
    for (int i = F.tid; i < DM; i += NWAVES * 64) atomicMax(dmax + i, lm[i]);
    __syncthreads();
}
struct DqJob { const float* W; unsigned char* W8; float* swd; const unsigned* dmaxp; int kbase, n0; };
__device__ __forceinline__ DqJob dq_job(Frame& F, int st) {
    constexpr int PER_SET = 4 * (DM / 32);
    const int s = st / PER_SET, q = st % PER_SET, kc = q / (DM / 32), nb = q % (DM / 32);
    DqJob j; j.W = s == 0 ? (const float*)F.ptr(21) : (const float*)F.ptr(25) + (size_t)(s - 1) * FF * DM;
    j.W8 = (unsigned char*)(F.wsp() + (s == 0 ? WS_WDD : WS_WDE)) + (s == 0 ? (size_t)0 : (size_t)(s - 1) * DM * FF);
    j.swd = (float*)(F.wsp() + WS_SWD) + s * DM; j.dmaxp = (const unsigned*)(F.wsp() + WS_CTL) + CW_DMAX + s * DM; j.kbase = 1792 * kc; j.n0 = 32 * nb; return j;
}
__device__ __forceinline__ void dq_sample_load(Frame& F, const DqJob& j, f32x4 (&sx)[4]) {
    const int c4 = F.lane & 7, rs = F.lane >> 3;
    const GAS unsigned char* Ws = (const GAS unsigned char*)((const GAS float*)j.W + j.n0) + (unsigned)((32 * (F.wave & 1) + 4 * rs) * DM + 4 * c4) * 4u;
#pragma unroll
    for (int q = 0; q < 4; ++q) sx[q] = *(const GAS f32x4*)(Ws + (size_t)q * DM * 4);
}
__device__ __forceinline__ const GAS unsigned char* dq_base(const DqJob& j) { return (const GAS unsigned char*)((const GAS float*)j.W + j.n0 + (size_t)j.kbase * DM); }
__device__ __forceinline__ void dq_process(Frame& F, const DqJob& j, f32x4 (&v)[7][4], f32x4 (&sx)[4], bool hasn, const DqJob& nj, bool f8) {
    constexpr int NIT = 28;
    LAS unsigned* lq = (LAS unsigned*)(F.lds + RING_OFF); LAS unsigned* cm = (LAS unsigned*)(F.lds + CM_OFF);
    const int c4 = F.lane & 7, rs = F.lane >> 3;
    float qmax = 127.f; float mx[4];
    if (f8) {
        f32x4 sm = (f32x4){0.f, 0.f, 0.f, 0.f};
#pragma unroll
        for (int q = 0; q < 4; ++q)
#pragma unroll
            for (int cc = 0; cc < 4; ++cc) sm[cc] = fmaxf(sm[cc], fabsf(sx[q][cc]));
#pragma unroll
        for (int cc = 0; cc < 4; ++cc) sm[cc] = max_x8_x16(sm[cc]);
        LDS_BAR();
        if (F.tid < 32) cm[F.tid] = 0u;
        LDS_BAR();
        if ((F.lane & 31) < 8) {
#pragma unroll
            for (int cc = 0; cc < 4; ++cc) atomicMax((unsigned*)&cm[4 * c4 + cc], __float_as_uint(sm[cc])); }
        LDS_BAR();
#pragma unroll
        for (int cc = 0; cc < 4; ++cc) mx[cc] = __uint_as_float(cm[4 * c4 + cc]);
        qmax = 28.f;
    } else {
#pragma unroll
        for (int cc = 0; cc < 4; ++cc) mx[cc] = __uint_as_float(j.dmaxp[j.n0 + 4 * c4 + cc]);
        LDS_BAR(); }
    if (hasn && f8) dq_sample_load(F, nj, sx);
    float iv[4];
#pragma unroll
    for (int cc = 0; cc < 4; ++cc) iv[cc] = mx[cc] > 0.f ? qmax / mx[cc] : 0.f;
    if (j.kbase == 0 && F.wave == 0 && rs == 0) {
#pragma unroll
        for (int cc = 0; cc < 4; ++cc) j.swd[j.n0 + 4 * c4 + cc] = mx[cc] > 0.f ? mx[cc] / qmax : 1.f; }
    const GAS unsigned char* nWb = dq_base(nj); const unsigned toff = (unsigned)((32 * F.wave + 4 * rs) * DM + 4 * c4) * 4u;
#pragma unroll
    for (int it = 0; it < 7; ++it) { const int kd = 64 * it + 8 * F.wave + rs;
#pragma unroll
        for (int cc = 0; cc < 4; ++cc) { const int n = 4 * c4 + cc; unsigned w;
            if (f8) w = pg8::cvt4_fp8(v[it][0][cc] * iv[cc], v[it][1][cc] * iv[cc], v[it][2][cc] * iv[cc], v[it][3][cc] * iv[cc]);
            else w = q4_i8(v[it][0][cc], v[it][1][cc], v[it][2][cc], v[it][3][cc], iv[cc]);
            lq[n * (16 * NIT) + (kd ^ n)] = w; }
        if (hasn) {
#pragma unroll
            for (int q = 0; q < 4; ++q) v[it][q] = __builtin_nontemporal_load((const GAS f32x4*)(nWb + (size_t)(256 * it + q) * DM * 4 + toff)); } }
    LDS_BAR();
#pragma unroll
    for (int i = 0; i < 7; ++i) { const int item = i * (NWAVES * 64) + F.tid, nn = item / (4 * NIT), c = item % (4 * NIT);
        const v4u x = ((const LAS v4u*)lq)[nn * (4 * NIT) + (c ^ (nn >> 2))]; const bool s1 = (nn & 1) != 0, s2 = (nn & 2) != 0;
        const unsigned a0 = s1 ? x.y : x.x, a1 = s1 ? x.x : x.y, a2 = s1 ? x.w : x.z, a3 = s1 ? x.z : x.w;
        v4u o; o.x = s2 ? a2 : a0; o.y = s2 ? a3 : a1; o.z = s2 ? a0 : a2; o.w = s2 ? a1 : a3;
        *(GAS v4u*)(j.W8 + (size_t)(j.n0 + nn) * FF + j.kbase + 16 * c) = o; }
}
__device__ __forceinline__ void down_q_items(Frame& F, int set_lo, int set_hi, int xb = 0, int xe = -1) {
    constexpr int PER_SET = 4 * (DM / 32);
    __syncthreads();
    const int slot = (((F.vcu >> 2) & 1) * (F.G >> 1) + (((F.vcu >> 3) << 2) | (F.vcu & 3)));
    const int st0 = xe >= 0 ? xb : set_lo * PER_SET + slot, st1 = xe >= 0 ? xe : set_hi * PER_SET, stp = xe >= 0 ? 1 : F.G;
    f32x4 v[7][4], sx[4]; DqJob cur, nxt; int st = st0; bool has = st < st1;
    if (has) { cur = dq_job(F, st); if (MOE_DOWN_F8) dq_sample_load(F, cur, sx);
        const GAS unsigned char* Wb = dq_base(cur); const unsigned toff = (unsigned)((32 * F.wave + 4 * (F.lane >> 3)) * DM + 4 * (F.lane & 7)) * 4u;
#pragma unroll
        for (int it = 0; it < 7; ++it)
#pragma unroll
            for (int q = 0; q < 4; ++q) v[it][q] = __builtin_nontemporal_load((const GAS f32x4*)(Wb + (size_t)(256 * it + q) * DM * 4 + toff)); }
    while (has) { const int stn = st + stp; const bool hasn = stn < st1; if (hasn) nxt = dq_job(F, stn);
        dq_process(F, cur, v, sx, hasn, nxt, MOE_DOWN_F8);
        cur = nxt; st = stn; has = hasn; }
    __syncthreads();
}
__device__ __forceinline__ void hp_quant(Frame& F, int nrows) {
    const int gw = F.vcu * NWAVES + F.wave, NGW = F.G * NWAVES; unsigned char* wsb = F.wsp();
    const bf16* HP = (const bf16*)(wsb + WS_HP); unsigned char* HQ = wsb + WS_HPQ; float* sah = (float*)(wsb + WS_SAH);
    for (int row = gw; row < nrows; row += NGW) {
        const GAS v4u* src = (const GAS v4u*)(HP + (size_t)row * FF) + F.lane; v4u x[14]; float am = 0.f;
#pragma unroll
        for (int j = 0; j < 14; ++j) x[j] = src[64 * j];
#pragma unroll
        for (int j = 0; j < 14; ++j) { const unsigned a = x[j].x & 0x7fff7fffu, b = x[j].y & 0x7fff7fffu, c = x[j].z & 0x7fff7fffu, d = x[j].w & 0x7fff7fffu;
            am = fmaxf(fmaxf(am, fmaxf(bflo(a), bfhi(a))), fmaxf(fmaxf(bflo(b), bfhi(b)), fmaxf(fmaxf(bflo(c), bfhi(c)), fmaxf(bflo(d), bfhi(d))))); }
        am = wave_max(am); const float iv = am > 0.f ? 127.f / am : 0.f;
        GAS v2u* dst = (GAS v2u*)(HQ + (size_t)row * FF) + F.lane;
#pragma unroll
        for (int j = 0; j < 14; ++j) { const unsigned w[4] = {x[j].x, x[j].y, x[j].z, x[j].w}; unsigned o[2] = {0u, 0u};
#pragma unroll
            for (int q = 0; q < 4; ++q) { const int a = (int)__builtin_rintf(bflo(w[q]) * iv), b = (int)__builtin_rintf(bfhi(w[q]) * iv); o[q >> 1] |= (((unsigned)a & 0xffu) | (((unsigned)b & 0xffu) << 8)) << (16 * (q & 1)); }
            v2u ov; ov.x = o[0]; ov.y = o[1]; dst[64 * j] = ov; }
        if (F.lane == 0) sah[row] = am > 0.f ? am * (1.f / 127.f) : 1.f;
    }
}
constexpr int NS_XHALF = 864 + 1792  , NS_L0IN = INC / 32, NS_PRO = 256  , NS_WIN1 = NS_PRO + 96  , NS_IN_ = 2 * (INC / 32), NS_PG_ = 2 * (DM / 32), NS_P0 = NS_IN_ + NS_PG_ + 2 * (FF / 32), NSTRIP_ALL = NS_IN_ + NS_PG_ + 9 * 2 * (FF / 32);
__device__ __forceinline__ void strip_range(Frame& F, int s0, int s1, int xslot = -1, int xn = 0) {
    __syncthreads();
    const int slot = xn > 0 ? xslot : (s0 > 0 ? (((F.vcu >> 2) & 1) * (F.G >> 1) + (((F.vcu >> 3) << 2) | (F.vcu & 3))) : F.vcu), nsl = xn > 0 ? xn : F.G;
    f32x4 v[8][4]; StripJob cur, nxt; int st = s0 + slot; bool has = st < s1;
    if (has) { cur = strip_job(F, st); strip_load(F, cur, v); }
    while (has) { const int stn = st + nsl; const bool hasn = stn < s1; if (hasn) nxt = strip_job(F, stn);
        strip_quant(F, cur, v, hasn, nxt);
        cur = nxt; st = stn; has = hasn; }
    __syncthreads();
}
__device__ __forceinline__ void p0_prologue(Frame& F) {
    LAS float* scr = (LAS float*)(F.lds + RING_OFF + F.wave * 16384);
    const int gw = F.vcu * NWAVES + F.wave, NGW = F.G * NWAVES;
    constexpr int I_IN = (DM / 64) * (INC / 32), I_SQ = (DM / 64) * (DM / 32), I_PP = (PLED / 64) * (DM / 32), I_GU = (DM / 64) * (FF / 32), I_DN = (FF / 64) * (DM / 32);
    constexpr int IL = I_SQ + I_PP, IFS = I_DN, NITEMS = 2 * IL + 9 * IFS;
    for (int it = gw; it < NITEMS; it += NGW) {
        int r = it;
        if (r < 2 * IL) { const int L = r / IL; r -= L * IL;
            if (r < I_SQ / 2) { p0_transpose_item((const float*)F.ptr(17) + (size_t)L * DM * DM, DM / 2, DM, (bf16*)(F.wsp() + WS_WOUT) + (size_t)L * DM * DM, MAP_ID, scr, r, F.lane, DM); continue; } r -= I_SQ / 2;
            if (r < I_SQ / 2) { p0_transpose_item((const float*)F.ptr(17) + (size_t)L * DM * DM + (size_t)(DM / 2) * DM, DM / 2, DM, (bf16*)(F.wsp() + WS_WOHI) + (size_t)L * DM * (DM / 2), MAP_ID, scr, r, F.lane); continue; } r -= I_SQ / 2;
            p0_transpose_item((const float*)F.ptr(28) + (size_t)L * PLED * DM, PLED, DM, (bf16*)(F.wsp() + WS_WPP) + (size_t)L * DM * PLED, MAP_ID, scr, r, F.lane); continue; }
        r -= 2 * IL;
        const int s = r / IFS; r -= s * IFS;
        if (down_i8_set(s)) continue;
        const float* wd; bf16* dn;
        if (s == 0) { wd = (const float*)F.ptr(21); dn = (bf16*)(F.wsp() + WS_WDD); }
        else { const size_t e = (size_t)(s - 1); wd = (const float*)F.ptr(25) + e * FF * DM; dn = (bf16*)(F.wsp() + WS_WDE) + e * DM * FF; }
        p0_transpose_item(wd, FF, DM, dn, MAP_ID, scr, r, F.lane);
    }
    strip_range(F, 0, NS_PRO, F.vcu, F.G);
    if (!MOE_DOWN_F8) p0_down_amax(F);
    const int gt = F.vcu * (NWAVES * 64) + F.tid, NT = F.G * NWAVES * 64;
    { const GAS f32x4* src = (const GAS f32x4*)F.ptr(1); GAS v2u* dst = (GAS v2u*)(F.wsp() + WS_PBF);
      for (int i0 = gt; i0 < DEPTH * M * PLED / 4; i0 += 8 * NT) { f32x4 v[8];
#pragma unroll
          for (int u = 0; u < 8; ++u) { const int i = i0 + u * NT; v[u] = (f32x4){0.f, 0.f, 0.f, 0.f}; if (i < DEPTH * M * PLED / 4) v[u] = __builtin_nontemporal_load(&src[i]); }
#pragma unroll
          for (int u = 0; u < 8; ++u) { const int i = i0 + u * NT; if (i < DEPTH * M * PLED / 4) { v2u o; o.x = pk2(v[u].x, v[u].y); o.y = pk2(v[u].z, v[u].w); dst[i] = o; } } } }
    { const int* pos = (const int*)F.ptr(2); float* rope = (float*)(F.wsp() + WS_ROPE);
      for (int i = gt; i < M * 8; i += NT) { const int tok = i >> 3, k = i & 7;
          const double inv = k == 0 ? 1.0 : k == 1 ? 0.19388721168191904 : k == 2 ? 0.03759225085361404 : k == 3 ? 0.007288656698743457 : k == 4 ? 0.0014142135623730951 : k == 5 ? 0.0002741979242171174 : k == 6 ? 5.316346907993441e-05 : 1.0307716781164267e-05;
          const double ang = (double)pos[tok] * inv;
          const double qd = __builtin_rint(ang * 0.6366197723675814); const double r = (ang - qd * 1.5707963267948966) - qd * 6.123233995736766e-17; const double r2 = r * r;
          double sp = r2 * (1.0 / 6227020800.0) - (1.0 / 39916800.0); sp = sp * r2 + (1.0 / 362880.0); sp = sp * r2 - (1.0 / 5040.0); sp = sp * r2 + (1.0 / 120.0); sp = sp * r2 - (1.0 / 6.0); const double sr = r + r * r2 * sp;
          double cp = r2 * (1.0 / 479001600.0) - (1.0 / 3628800.0); cp = cp * r2 + (1.0 / 40320.0); cp = cp * r2 - (1.0 / 720.0); cp = cp * r2 + (1.0 / 24.0); cp = cp * r2 - 0.5; const double cr = 1.0 + r2 * cp;
          const int qi = (int)qd & 3; const double cv = qi == 0 ? cr : qi == 1 ? -sr : qi == 2 ? -cr : sr, sv = qi == 0 ? sr : qi == 1 ? cr : qi == 2 ? -sr : -cr;
          rope[tok * 16 + k] = (float)cv; rope[tok * 16 + 8 + k] = (float)sv; } }
    { const float* wpool = (const float*)F.ptr(10); const float* pscale = (const float*)F.ptr(11); const float* wpw = (const float*)F.ptr(16); GAS unsigned* bd = (GAS unsigned*)(F.wsp() + WS_BD);
      for (int i0 = gt; i0 < DEPTH * 1024 * 512; i0 += 8 * NT) { unsigned ov[8];
#pragma unroll
          for (int u = 0; u < 8; ++u) { const int i = i0 + u * NT; const int L = (i >> 19) & 1, kp = (i >> 9) & 1023, j0 = (i & 511) * 2; float v[2];
#pragma unroll
              for (int q = 0; q < 2; ++q) { const int j = j0 + q; float x = 0.f;
                  if (i < DEPTH * 1024 * 512) {
                      if (kp < 512) { const int g = kp >> 7, c = kp & 127; if (j < 512 && (j >> 7) == g) x = wpool[(((size_t)L * 4 + g) * 128 + c) * 128 + (j & 127)] * pscale[L * 512 + j]; }
                      else if (j >= 512) x = wpw[((size_t)L * 512 + (kp - 512)) * 512 + (j - 512)]; }
                  v[q] = x; }
              ov[u] = pk2(v[0], v[1]); }
#pragma unroll
          for (int u = 0; u < 8; ++u) { const int i = i0 + u * NT; if (i < DEPTH * 1024 * 512) bd[i] = ov[u]; } } }
}
__device__ __forceinline__ float quant_row_store(const f32x4 (&y)[8], unsigned char* qrow, int lane) {
    float am = 0.f;
#pragma unroll
    for (int j = 0; j < 8; ++j) am = fmaxf(fmaxf(am, fmaxf(fabsf(y[j].x), fabsf(y[j].y))), fmaxf(fabsf(y[j].z), fabsf(y[j].w)));
    am = wave_max(am); const float iv = am > 0.f ? 127.f / am : 0.f;
    GAS unsigned* o4 = (GAS unsigned*)qrow + lane;
#pragma unroll
    for (int j = 0; j < 8; ++j) o4[64 * j] = q4_i8(y[j].x, y[j].y, y[j].z, y[j].w, iv);
    return am > 0.f ? am * (1.f / 127.f) : 1.f;
}
__device__ __forceinline__ void norm_rows_q(Frame& F, const float* src, const float* gain, unsigned char* Uq, float* sc, int cu = -1, int ncu = 0) {
    const bool contig = ncu == 0 && F.G * NWAVES * 8 == M;
    if (ncu == 0) { cu = F.vcu; ncu = F.G; }
    if (cu < 0) return;
    const int gw = cu * NWAVES + F.wave, NGW = ncu * NWAVES;
    const int m0 = contig ? 8 * gw : gw, mstep = contig ? 1 : NGW, mend = contig ? 8 * gw + 8 : M;
    f32x4 g[8];
#pragma unroll
    for (int j = 0; j < 8; ++j) g[j] = ((const GAS f32x4*)gain)[F.lane + 64 * j];
    f32x4 nv[8];
    if (m0 < mend) { const GAS f32x4* xr = (const GAS f32x4*)(src + (size_t)m0 * DM) + F.lane;
#pragma unroll
        for (int j = 0; j < 8; ++j) nv[j] = xr[64 * j]; }
    for (int m = m0; m < mend; m += mstep) {
        f32x4 v[8]; float s = 0.f;
#pragma unroll
        for (int j = 0; j < 8; ++j) v[j] = nv[j];
        if (m + mstep < mend) { const GAS f32x4* xn = (const GAS f32x4*)(src + (size_t)(m + mstep) * DM) + F.lane;
#pragma unroll
            for (int j = 0; j < 8; ++j) nv[j] = xn[64 * j]; }
#pragma unroll
        for (int j = 0; j < 8; ++j) s += (v[j].x * v[j].x + v[j].y * v[j].y) + (v[j].z * v[j].z + v[j].w * v[j].w);
        const float rstd = 1.f / sqrtf(wave_sum(s) * (1.f / DM) + 1e-6f);
#pragma unroll
        for (int j = 0; j < 8; ++j) v[j] = v[j] * rstd * g[j];
        const float scl = quant_row_store(v, Uq + (size_t)m * DM, F.lane);
        if (F.lane == 0) sc[m] = scl;
    }
}
__device__ __forceinline__ void final_norm(Frame& F, const float* gain) {
    const int gw = F.vcu * NWAVES + F.wave, NGW = F.G * NWAVES; float* outb = F.outp();
    const bool contig = NGW * 8 == M; const int m0 = contig ? 8 * gw : gw, mstep = contig ? 1 : NGW, mend = contig ? 8 * gw + 8 : M;
    f32x4 g[8];
#pragma unroll
    for (int j = 0; j < 8; ++j) g[j] = ((const GAS f32x4*)gain)[F.lane + 64 * j];
    f32x4 nv[8];
    if (m0 < mend) { const GAS f32x4* x0 = (const GAS f32x4*)(outb + (size_t)m0 * DM) + F.lane;
#pragma unroll
        for (int j = 0; j < 8; ++j) nv[j] = x0[64 * j]; }
    for (int m = m0; m < mend; m += mstep) {
        GAS f32x4* xr = (GAS f32x4*)(outb + (size_t)m * DM) + F.lane; f32x4 v[8]; float s = 0.f;
#pragma unroll
        for (int j = 0; j < 8; ++j) v[j] = nv[j];
        if (m + mstep < mend) { const GAS f32x4* xn = (const GAS f32x4*)(outb + (size_t)(m + mstep) * DM) + F.lane;
#pragma unroll
            for (int j = 0; j < 8; ++j) nv[j] = xn[64 * j]; }
#pragma unroll
        for (int j = 0; j < 8; ++j) s += (v[j].x * v[j].x + v[j].y * v[j].y) + (v[j].z * v[j].z + v[j].w * v[j].w);
        const float rstd = 1.f / sqrtf(wave_sum(s) * (1.f / DM) + 1e-6f);
#pragma unroll
        for (int j = 0; j < 8; ++j) xr[64 * j] = v[j] * rstd * g[j];
    }
}
__device__ __forceinline__ void ffn_norm_phase(Frame& F, const float* gain, const float* wrouter, unsigned char* U, bool moe) {
    float* outb = F.outp(); unsigned char* wsb = F.wsp();
    if (!moe) { norm_rows_q(F, outb, gain, U, (float*)(wsb + WS_SAS)); return; }
    LAS float* wl = (LAS float*)(F.lds + RING_OFF);
    LAS int* mo = (LAS int*)(F.lds + MOE_OFF);
    for (int c = F.tid; c < DM; c += NWAVES * 64) { const f32x4 a = ((const GAS f32x4*)wrouter)[2 * c], b = ((const GAS f32x4*)wrouter)[2 * c + 1];
        wl[0 * DM + c] = a.x; wl[1 * DM + c] = a.y; wl[2 * DM + c] = a.z; wl[3 * DM + c] = a.w; wl[4 * DM + c] = b.x; wl[5 * DM + c] = b.y; wl[6 * DM + c] = b.z; wl[7 * DM + c] = b.w; }
    if (F.tid < 8) mo[48 + F.tid] = 0;
    __syncthreads();
    f32x4 g[8];
#pragma unroll
    for (int j = 0; j < 8; ++j) g[j] = ((const GAS f32x4*)gain)[F.lane + 64 * j];
    f32x4 nv[8];
    { const GAS f32x4* x0 = (const GAS f32x4*)(outb + (size_t)(64 * F.vcu + 8 * F.wave) * DM) + F.lane;
#pragma unroll
      for (int j = 0; j < 8; ++j) nv[j] = x0[64 * j]; }
    for (int k = 0; k < 8; ++k) {
        const int m = 64 * F.vcu + 8 * F.wave + k;
        f32x4 v[8]; float s = 0.f;
#pragma unroll
        for (int j = 0; j < 8; ++j) v[j] = nv[j];
        if (k + 1 < 8) { const GAS f32x4* xn = (const GAS f32x4*)(outb + (size_t)(m + 1) * DM) + F.lane;
#pragma unroll
            for (int j = 0; j < 8; ++j) nv[j] = xn[64 * j]; }
#pragma unroll
        for (int j = 0; j < 8; ++j) s += (v[j].x * v[j].x + v[j].y * v[j].y) + (v[j].z * v[j].z + v[j].w * v[j].w);
        const float rstd = 1.f / sqrtf(wave_sum(s) * (1.f / DM) + 1e-6f);
        float lg[8];
#pragma unroll
        for (int e = 0; e < 8; ++e) lg[e] = 0.f;
#pragma unroll
        for (int j = 0; j < 8; ++j) { const f32x4 y = v[j] * rstd * g[j]; v[j] = y;
#pragma unroll
            for (int e = 0; e < 8; ++e) { const f32x4 w = ((const LAS f32x4*)(wl + e * DM))[F.lane + 64 * j]; lg[e] += (y.x * w.x + y.y * w.y) + (y.z * w.z + y.w * w.w); } }
#pragma unroll
        for (int e = 0; e < 8; ++e) lg[e] = wave_sum(lg[e]);
        const float scl = quant_row_store(v, U + (size_t)m * DM, F.lane);
        int i0 = 0; float l0 = lg[0];
#pragma unroll
        for (int e = 1; e < 8; ++e) if (lg[e] > l0) { l0 = lg[e]; i0 = e; }
        int i1 = -1; float l1 = -INFINITY;
#pragma unroll
        for (int e = 0; e < 8; ++e) if (e != i0 && lg[e] > l1) { l1 = lg[e]; i1 = e; }
        const float g0 = 1.f / (1.f + expf(l1 - l0)), g1 = 1.f - g0;
        if (F.lane == 0) { v4u sv; sv.x = (unsigned)i0; sv.y = (unsigned)i1; sv.z = __float_as_uint(g0); sv.w = __float_as_uint(g1); ((GAS v4u*)(wsb + WS_SEL))[m] = sv; ((GAS float*)(wsb + WS_SATOK))[m] = scl;
            atomicAdd((int*)&mo[48 + i0], 1); atomicAdd((int*)&mo[48 + i1], 1); }
    }
    __syncthreads();
    if (F.tid < 8) ((GAS int*)(wsb + WS_HIST))[F.vcu * 8 + F.tid] = mo[48 + F.tid];
}
__device__ __forceinline__ void moe_offsets(Frame& F) {
    LAS int* mo = (LAS int*)(F.lds + MOE_OFF);
    __syncthreads();
    if (F.tid < 48) mo[F.tid] = 0;
    __syncthreads();
    if (F.tid < 256) { const GAS v4i* hp = (const GAS v4i*)(F.wsp() + WS_HIST) + 2 * F.tid; const v4i a = hp[0], b = hp[1]; const int h[8] = {a.x, a.y, a.z, a.w, b.x, b.y, b.z, b.w};
#pragma unroll
        for (int e = 0; e < 8; ++e) { const int t = wave_sum_i(h[e]), p = wave_sum_i(F.tid < F.vcu ? h[e] : 0);
            if (F.lane == 0) { atomicAdd((int*)&mo[32 + e], t); atomicAdd((int*)&mo[16 + e], p); } } }
    __syncthreads();
    if (F.tid == 0) { int t = 0; mo[0] = 0;
#pragma unroll
        for (int e = 0; e < 8; ++e) { t += (mo[32 + e] + 255) >> 8; mo[e + 1] = t; } }
    __syncthreads();
}
__device__ __forceinline__ void moe_permute(Frame& F, const unsigned char* U, unsigned char* XP) {
    moe_offsets(F);
    LAS int* mo = (LAS int*)(F.lds + MOE_OFF);
    LAS int* sl = (LAS int*)(F.lds + RING_OFF);
    unsigned char* wsb = F.wsp();
    if (F.wave == 0) { const int m = 64 * F.vcu + F.lane; const v4u sv = ((const GAS v4u*)(wsb + WS_SEL))[m]; const int e0 = (int)sv.x, e1 = (int)sv.y; int r0 = 0, r1 = 0;
        const unsigned long long lt = (1ull << F.lane) - 1ull;
#pragma unroll
        for (int e = 0; e < 8; ++e) { const unsigned long long both = __ballot(e0 == e) | __ballot(e1 == e); const int before = __popcll(both & lt), base = 256 * mo[e] + mo[16 + e];
            if (e0 == e) r0 = base + before; if (e1 == e) r1 = base + before; }
        sl[2 * F.lane] = r0; sl[2 * F.lane + 1] = r1; ((GAS int*)(wsb + WS_SEL + 512 * 1024))[2 * m] = r0; ((GAS int*)(wsb + WS_SEL + 512 * 1024))[2 * m + 1] = r1; }
    __syncthreads();
    v4u xa[8], xb[8]; float scv[8];
#pragma unroll
    for (int k = 0; k < 8; ++k) { const int m = 64 * F.vcu + 8 * F.wave + k; const GAS v4u* src = (const GAS v4u*)(U + (size_t)m * DM) + F.lane; xa[k] = src[0]; xb[k] = src[64]; scv[k] = ((const GAS float*)(wsb + WS_SATOK))[m]; }
#pragma unroll
    for (int k = 0; k < 8; ++k) { const int t = 8 * F.wave + k; const int s0 = sl[2 * t], s1 = sl[2 * t + 1];
        GAS v4u* d0 = (GAS v4u*)(XP + (size_t)s0 * DM) + F.lane; GAS v4u* d1 = (GAS v4u*)(XP + (size_t)s1 * DM) + F.lane;
        d0[0] = xa[k]; d0[64] = xb[k]; d1[0] = xa[k]; d1[64] = xb[k];
        if (F.lane == 0) { ((GAS float*)(wsb + WS_SAS))[s0] = scv[k]; ((GAS float*)(wsb + WS_SAS))[s1] = scv[k]; } }
}
__device__ __forceinline__ void combine_norm(Frame& F, const bf16* Y, const bf16* YP, const float* gain, unsigned char* U, bool moe, bool sliced) {
    const int gw = F.vcu * NWAVES + F.wave, NGW = F.G * NWAVES; float* outb = F.outp(); unsigned char* wsb = F.wsp();
    f32x4 g[8];
#pragma unroll
    for (int j = 0; j < 8; ++j) g[j] = ((const GAS f32x4*)gain)[F.lane + 64 * j];
    v4u nsv = (v4u){0u, 0u, 0u, 0u}; int ns0 = gw, ns1 = gw;
    if (moe && gw < M) { nsv = ((const GAS v4u*)(wsb + WS_SEL))[gw]; ns0 = ((const GAS int*)(wsb + WS_SEL + 512 * 1024))[2 * gw]; ns1 = ((const GAS int*)(wsb + WS_SEL + 512 * 1024))[2 * gw + 1]; }
    for (int m = gw; m < M; m += NGW) {
        int s0 = m, s1 = m; float g0 = 1.f, g1 = 0.f;
        if (moe) { g0 = __uint_as_float(nsv.z); g1 = __uint_as_float(nsv.w); s0 = ns0; s1 = ns1;
            const int mn = m + NGW; if (mn < M) { nsv = ((const GAS v4u*)(wsb + WS_SEL))[mn]; ns0 = ((const GAS int*)(wsb + WS_SEL + 512 * 1024))[2 * mn]; ns1 = ((const GAS int*)(wsb + WS_SEL + 512 * 1024))[2 * mn + 1]; } }
        GAS f32x4* xr = (GAS f32x4*)(outb + (size_t)m * DM) + F.lane; const GAS v2u* y0 = (const GAS v2u*)(Y + (size_t)s0 * DM) + F.lane; const GAS v2u* y1 = (const GAS v2u*)(Y + (size_t)s1 * DM) + F.lane;
        const bool p0 = sliced && s0 >= 32768, p1 = sliced && s1 >= 32768;
        const GAS v2u* q0 = (const GAS v2u*)(YP + (size_t)(s0 - 32768) * DM) + F.lane; const GAS v2u* q1 = (const GAS v2u*)(YP + (size_t)(s1 - 32768) * DM) + F.lane;
        f32x4 v[8]; v2u ya[8], yb[8]; float s = 0.f;
#pragma unroll
        for (int j = 0; j < 8; ++j) { v[j] = xr[64 * j]; ya[j] = (v2u){0u, 0u}; yb[j] = (v2u){0u, 0u}; }
        if (!p0) {
#pragma unroll
            for (int j = 0; j < 8; ++j) ya[j] = y0[64 * j]; }
        if (moe && !p1) {
#pragma unroll
            for (int j = 0; j < 8; ++j) yb[j] = y1[64 * j]; }
#pragma unroll
        for (int j = 0; j < 8; ++j) { v[j].x += g0 * bflo(ya[j].x); v[j].y += g0 * bfhi(ya[j].x); v[j].z += g0 * bflo(ya[j].y); v[j].w += g0 * bfhi(ya[j].y);
            v[j].x += g1 * bflo(yb[j].x); v[j].y += g1 * bfhi(yb[j].x); v[j].z += g1 * bflo(yb[j].y); v[j].w += g1 * bfhi(yb[j].y); }
        if (p0) {
#pragma unroll
            for (int k = 0; k < 4; ++k)
#pragma unroll
                for (int j = 0; j < 8; ++j) { const v2u a = q0[(size_t)k * (2048 * 2048 / 4) + 64 * j]; v[j].x += g0 * bflo(a.x); v[j].y += g0 * bfhi(a.x); v[j].z += g0 * bflo(a.y); v[j].w += g0 * bfhi(a.y); } }
        if (moe && p1) {
#pragma unroll
            for (int k = 0; k < 4; ++k)
#pragma unroll
                for (int j = 0; j < 8; ++j) { const v2u b = q1[(size_t)k * (2048 * 2048 / 4) + 64 * j]; v[j].x += g1 * bflo(b.x); v[j].y += g1 * bfhi(b.x); v[j].z += g1 * bflo(b.y); v[j].w += g1 * bfhi(b.y); } }
#pragma unroll
        for (int j = 0; j < 8; ++j) { xr[64 * j] = v[j]; s += (v[j].x * v[j].x + v[j].y * v[j].y) + (v[j].z * v[j].z + v[j].w * v[j].w); }
        const float rstd = 1.f / sqrtf(wave_sum(s) * (1.f / DM) + 1e-6f);
#pragma unroll
        for (int j = 0; j < 8; ++j) v[j] = v[j] * rstd * g[j];
        const float scl = quant_row_store(v, U + (size_t)m * DM, F.lane);
        if (F.lane == 0) ((GAS float*)(wsb + WS_SATOK))[m] = scl;
    }
}
__device__ __forceinline__ void unpack8(const v4u x, float (&f)[8]) { f[0] = bflo(x.x); f[1] = bfhi(x.x); f[2] = bflo(x.y); f[3] = bfhi(x.y); f[4] = bflo(x.z); f[5] = bfhi(x.z); f[6] = bflo(x.w); f[7] = bfhi(x.w); }
__device__ __forceinline__ v4u pack8f(const float (&f)[8]) { v4u o; o.x = pk2(f[0], f[1]); o.y = pk2(f[2], f[3]); o.z = pk2(f[4], f[5]); o.w = pk2(f[6], f[7]); return o; }
__device__ __forceinline__ void thin_phase(Frame& F, int L) {
    LAS float* dwl = (LAS float*)(F.lds + RING_OFF);
    { const GAS f32x4* dw = (const GAS f32x4*)((const float*)F.ptr(12) + (size_t)L * 31 * 512); for (int i = F.tid; i < 31 * 512 / 4; i += NWAVES * 64) ((LAS f32x4*)dwl)[i] = dw[i]; }
    const float lam_init = L == 0 ? LAM_INIT0 : LAM_INIT1;
    float lam; { const float a = ((const float*)F.ptr(5))[L * 64 + F.lane] * ((const float*)F.ptr(6))[L * 64 + F.lane], b = ((const float*)F.ptr(7))[L * 64 + F.lane] * ((const float*)F.ptr(8))[L * 64 + F.lane];
        lam = expf(wave_sum(a)) - expf(wave_sum(b)) + lam_init; }
    __syncthreads();
    unsigned char* wsb = F.wsp(); const float* subg = F.inf(9) + L * 128; const float* cbias = F.inf(13) + L * 512; const float* clng = F.inf(14) + L * 512; const float* clnb = F.inf(15) + L * 512;
    const bf16* O0 = (const bf16*)(wsb + WS_O0); const bf16* O1 = (const bf16*)(wsb + WS_O1); const bf16* ZP = (const bf16*)(wsb + WS_ZP); const bf16* CG = (const bf16*)(wsb + WS_CG);
    bf16* CAT = (bf16*)(wsb + WS_CAT);
    const int lane = F.lane;
    for (int task = F.vcu * NWAVES + F.wave; task < M / 8; task += F.G * NWAVES) {
        const int T0 = task * 8, s0 = T0 & (SEQ - 1);
        { const int col = (lane >> 3) * 128 + (lane & 7) * 16; float gn[16];
#pragma unroll
          for (int q = 0; q < 4; ++q) { const f32x4 t = ((const GAS f32x4*)(subg + (lane & 7) * 16))[q]; gn[4 * q] = t.x; gn[4 * q + 1] = t.y; gn[4 * q + 2] = t.z; gn[4 * q + 3] = t.w; }
          v4u A0[8], A1[8], B0[8], B1[8];
#pragma unroll
          for (int tt = 0; tt < 8; ++tt) { const size_t ro = (size_t)(T0 + tt) * 1024 + col; A0[tt] = *(const GAS v4u*)(O0 + ro); A1[tt] = *(const GAS v4u*)(O0 + ro + 8); B0[tt] = *(const GAS v4u*)(O1 + ro); B1[tt] = *(const GAS v4u*)(O1 + ro + 8); }
#pragma unroll
          for (int tt = 0; tt < 8; ++tt) { const v4u a0 = A0[tt], a1 = A1[tt], b0 = B0[tt], b1 = B1[tt];
              float x0[8], x1[8], y0[8], y1[8]; unpack8(a0, x0); unpack8(a1, x1); unpack8(b0, y0); unpack8(b1, y1); float ss = 0.f;
#pragma unroll
              for (int q = 0; q < 8; ++q) { x0[q] -= lam * y0[q]; x1[q] -= lam * y1[q]; ss += x0[q] * x0[q] + x1[q] * x1[q]; }
              ss = row8_sum(ss);
              const float r = (1.f - lam_init) / sqrtf(ss * (1.f / 128.f) + 1e-5f);
#pragma unroll
              for (int q = 0; q < 8; ++q) { x0[q] *= r * gn[q]; x1[q] *= r * gn[8 + q]; }
              GAS v4u* o = (GAS v4u*)(CAT + (size_t)(T0 + tt) * 2048 + col); o[0] = pack8f(x0); o[1] = pack8f(x1); } }
        { const int w = 2 << (lane >> 4); float S[8];
#pragma unroll
          for (int q = 0; q < 8; ++q) S[q] = 0.f;
          v4u pre[15], slf[8], tl[8];
#pragma unroll
          for (int j = 1; j < 16; ++j) { pre[j - 1] = (v4u){0u, 0u, 0u, 0u}; if (j < w && s0 - j >= 0) pre[j - 1] = *(const GAS v4u*)(ZP + (size_t)(T0 - j) * 512 + 8 * lane); }
#pragma unroll
          for (int tt = 0; tt < 8; ++tt) { slf[tt] = *(const GAS v4u*)(ZP + (size_t)(T0 + tt) * 512 + 8 * lane); tl[tt] = (v4u){0u, 0u, 0u, 0u}; if (s0 + tt - w + 1 >= 0) tl[tt] = *(const GAS v4u*)(ZP + (size_t)(T0 + tt - w + 1) * 512 + 8 * lane); }
#pragma unroll
          for (int j = 0; j < 15; ++j) { float f[8]; unpack8(pre[j], f);
#pragma unroll
              for (int q = 0; q < 8; ++q) S[q] += f[q]; }
#pragma unroll
          for (int tt = 0; tt < 8; ++tt) { float self[8], o[8], f[8]; unpack8(slf[tt], self); unpack8(tl[tt], f);
              const int cnt = (s0 + tt + 1) < w ? (s0 + tt + 1) : w; const float ic = 1.f / (float)cnt;
#pragma unroll
              for (int q = 0; q < 8; ++q) { S[q] += self[q]; o[q] = S[q] * ic - self[q]; S[q] -= f[q]; }
              *(GAS v4u*)(CAT + (size_t)(T0 + tt) * 2048 + 1024 + 8 * lane) = pack8f(o); } }
        { f32x4 aA[8], aB[8];
#pragma unroll
          for (int tt = 0; tt < 8; ++tt) { aA[tt] = (f32x4){0.f, 0.f, 0.f, 0.f}; aB[tt] = (f32x4){0.f, 0.f, 0.f, 0.f}; }
          v4u xq[8], xn[8];
#pragma unroll
          for (int q = 0; q < 8; ++q) { xq[q] = (v4u){0u, 0u, 0u, 0u}; if (s0 - 30 + q >= 0) xq[q] = *(const GAS v4u*)(CG + (size_t)(T0 - 30 + q) * 512 + 8 * lane); }
#pragma unroll 1
          for (int c = 0; c < 5; ++c) {
#pragma unroll
              for (int q = 0; q < 8; ++q) { const int rr = 8 * (c + 1) + q; xn[q] = (v4u){0u, 0u, 0u, 0u}; if (rr < 38 && s0 - 30 + rr >= 0) xn[q] = *(const GAS v4u*)(CG + (size_t)(T0 - 30 + rr) * 512 + 8 * lane); }
              f32x4 fa[8], fb[8];
#pragma unroll
              for (int q = 0; q < 8; ++q) { float f[8]; unpack8(xq[q], f); fa[q] = (f32x4){f[0], f[1], f[2], f[3]}; fb[q] = (f32x4){f[4], f[5], f[6], f[7]}; }
#pragma unroll
              for (int dj = -7; dj <= 7; ++dj) { const int j = 8 * c + dj;
                  if (j >= 0 && j <= 30) { const LAS f32x4* wp = (const LAS f32x4*)(dwl + j * 512 + 8 * lane); const f32x4 w0 = wp[0], w1 = wp[1];
#pragma unroll
                      for (int tt = 0; tt < 8; ++tt) { const int q = dj + tt; if (q >= 0 && q < 8) { aA[tt] += w0 * fa[q]; aB[tt] += w1 * fb[q]; } } } }
#pragma unroll
              for (int q = 0; q < 8; ++q) xq[q] = xn[q]; }
          const GAS f32x4* bp = (const GAS f32x4*)(cbias + 8 * lane); const GAS f32x4* gp = (const GAS f32x4*)(clng + 8 * lane); const GAS f32x4* lp = (const GAS f32x4*)(clnb + 8 * lane);
          const f32x4 bA = bp[0], bB = bp[1], gA = gp[0], gB = gp[1], lA = lp[0], lB = lp[1];
#pragma unroll
          for (int tt = 0; tt < 8; ++tt) { f32x4 vA = aA[tt] + bA, vB = aB[tt] + bB;
              const float mean = wave_sum((vA.x + vA.y) + (vA.z + vA.w) + (vB.x + vB.y) + (vB.z + vB.w)) * (1.f / 512.f); vA = vA - mean; vB = vB - mean;
              const float var = wave_sum((vA.x * vA.x + vA.y * vA.y) + (vA.z * vA.z + vA.w * vA.w) + (vB.x * vB.x + vB.y * vB.y) + (vB.z * vB.z + vB.w * vB.w)) * (1.f / 512.f);
              const float rs = 1.f / sqrtf(var + 1e-5f); vA = vA * rs * gA + lA; vB = vB * rs * gB + lB; float o[8] = {vA.x, vA.y, vA.z, vA.w, vB.x, vB.y, vB.z, vB.w};
#pragma unroll
              for (int q = 0; q < 8; ++q) o[q] = o[q] * sigm(o[q]);
              *(GAS v4u*)(CAT + (size_t)(T0 + tt) * 2048 + 1536 + 8 * lane) = pack8f(o); } }
    }
}

struct Args { const void* in[30]; float* out; unsigned char* ws; int ph_lo, ph_hi, li, pad; };
__global__ void __launch_bounds__(NWAVES * 64, 2) mk_fwd(Args args) {
    extern __shared__ __attribute__((aligned(16))) unsigned char lds[];
    LAS unsigned char* const L3 = (LAS unsigned char*)lds;
    const int wave_s = __builtin_amdgcn_readfirstlane((int)threadIdx.x >> 6);
    for (int u = threadIdx.x; u < (LDS_BYTES - LDSCTL_OFF) / 4; u += NWAVES * 64) ((LAS unsigned*)(L3 + LDSCTL_OFF))[u] = 0u;
    __syncthreads();
    if (threadIdx.x == 0) { LAS unsigned long long* t = (LAS unsigned long long*)(L3 + PTR_OFF);
#pragma unroll
        for (int i = 0; i < 30; ++i) t[i] = (unsigned long long)args.in[i];
        t[30] = (unsigned long long)args.out; t[31] = (unsigned long long)args.ws; }
    __syncthreads();
    if (N_LAUNCHES == 1) { const Frame F0 = make_frame(L3, wave_s); (void)xcd_barrier_post((unsigned*)(F0.wsp() + WS_CTL) + CW_BAR, (volatile LAS unsigned*)(L3 + MISC_OFF) + 8); }
#define GRID_BAR() do { if (N_LAUNCHES == 1) { const Frame Fb = make_frame(L3, wave_s); XcdBarrier bar; bar.bar = (unsigned*)(Fb.wsp() + WS_CTL) + CW_BAR; bar.x = xb_xcc_id(); bar.st = (volatile LAS unsigned*)(L3 + MISC_OFF) + 8; xcd_barrier(bar, Fb.tid == 0); } } while (0)
    const int lo = (N_LAUNCHES == 1) ? 0 : args.ph_lo, hi = (N_LAUNCHES == 1) ? N_PHASES : args.ph_hi;
#define IN(k) (lo <= (k) && (k) < hi)
#define F_G_IS(n) ((int)gridDim.x == (n))
#define SEAM(k) do { if (IN(k) && IN((k) + 1)) GRID_BAR(); } while (0)
#ifndef PROBE_DUP
#define PROBE_DUP 0
#endif
#define DUP_BEGIN(b) _Pragma("unroll 1") for (int rep_ = 0; rep_ < (((PROBE_DUP >> (b)) & 1) ? 2 : 1); ++rep_) {
#define DUP_END(b) if (rep_ + 1 < (((PROBE_DUP >> (b)) & 1) ? 2 : 1)) GRID_BAR(); }

    DUP_BEGIN(0) if (IN(0)) { Frame F = make_frame(L3, wave_s); p0_prologue(F); } DUP_END(0)
    SEAM(0);

#pragma unroll 1
    for (int L = 0; L < DEPTH; ++L) {
        const int pb = 1 + 13 * L; const bool moe = (L & 1) != 0; constexpr bool ALL_F8 = (DOWN_I8 == 3u) && MOE_DOWN_F8;
        const bool dq = ALL_F8 ? true : ((DOWN_I8 >> L) & 1u) != 0u; const bool f8 = ALL_F8 ? true : (dq && MOE_DOWN_F8);
        DUP_BEGIN(6) if (IN(pb + 0)) { Frame F = make_frame(L3, wave_s); unsigned char* ws = F.wsp(); if (L == 0 && F.G > 64) norm_rows_q(F, F.inf(0), F.inf(3), (unsigned char*)(ws + WS_U), (float*)(ws + WS_SATOK), (int)blockIdx.x - 64, F.G - 64);
            else norm_rows_q(F, L == 0 ? F.inf(0) : (const float*)F.outp(), F.inf(3) + L * DM, (unsigned char*)(ws + WS_U), (float*)(ws + WS_SATOK)); } DUP_END(6)
        if (IN(pb + 0) && L == 0) { Frame F = make_frame(L3, wave_s); unsigned char* ws = F.wsp();
            pg8::Gemm g{(const bf16*)(ws + WS_WOHI), (const bf16*)(ws + WS_BD), 2 * DM, 1024, 1024, (size_t)1024 * 1024 * 2}; pg8::GOrder S; S.init(16, 4, F.G, (int)blockIdx.x); S.ts[1] = 8;
            pg8::EpiBf16<0> E{(bf16*)(ws + WS_WOUT) + 1024, DM, nullptr, 0, 0, 1.f};
            pg8::gemm_phase<pg8::EpiBf16<0>, pg8::GOrder, PG8_ALIGN, PG8_SP2>(F.lds + RING_OFF, g, S, E, F.tid);
        }
        SEAM(pb + 0);
        DUP_BEGIN(1) if (IN(pb + 1)) { Frame F = make_frame(L3, wave_s); unsigned char* ws = F.wsp();
            pg8::Gemm g{(const bf16*)(ws + WS_U), (const bf16*)(ws + WS_WIN + (size_t)L * INC * DM), M, INC, DM / 2, 0};   pg8::GOrder S; S.init(M / 256, INC / 256, F.G, (int)blockIdx.x);
            pg8::EpiIn E{(bf16*)(ws + WS_Q), (bf16*)(ws + WS_K), (bf16*)(ws + WS_V), (bf16*)(ws + WS_ZP), (bf16*)(ws + WS_CG), (const float*)(ws + WS_ROPE), attn_body::C2, (const float*)(ws + WS_SATOK), (const float*)(ws + WS_SWIN) + L * INC};
            pg8::gemm_phase<pg8::EpiIn, pg8::GOrder, PG8_ALIGN, PG8_SP2, 1>(F.lds + RING_OFF, g, S, E, F.tid);
        } DUP_END(1)
        if (IN(pb + 1)) {
            { Frame F = make_frame(L3, wave_s); unsigned char* ws = F.wsp();
              pg8::Gemm g{(const bf16*)(ws + WS_PBF) + (size_t)L * M * PLED, (const bf16*)(ws + WS_WPP) + (size_t)L * DM * PLED, M, DM, PLED, 0}; pg8::GOrder S; S.init(M / 512, DM / 256, F.G / 2, (int)blockIdx.x - F.G / 2);
              pg8::EpiBf16<0> E{(bf16*)(ws + WS_PP), DM, nullptr, 0, 0, 1.f};
              pg8::gemm_phase<pg8::EpiBf16<0>, pg8::GOrder, PG8_ALIGN, PG8_SP2>(F.lds + RING_OFF, g, S, E, F.tid); }
            if (L == 0 && F_G_IS(256)) { const int j = (int)blockIdx.x - 128;
                if (j >= 0 && j < NS_WIN1 - NS_PRO) { Frame F = make_frame(L3, wave_s); strip_range(F, NS_PRO, NS_WIN1, j, NS_WIN1 - NS_PRO); } }
        }
        SEAM(pb + 1);
        DUP_BEGIN(2) if (IN(pb + 2)) {
#pragma unroll 1
          for (int part = 0; part < 2; ++part) {
            if ((int)((blockIdx.x >> 5) & 1u) == part) { Frame F = make_frame(L3, wave_s);
                if (L == 0) { strip_range(F, NS_WIN1, NS_XHALF); down_q_items(F, 0, 1); }
                else { strip_range(F, NS_XHALF, NSTRIP_ALL); down_q_items(F, 1, 9, 0, -1); } }
            if (part != 0) continue;
            Frame F = make_frame(L3, wave_s); unsigned char* ws = F.wsp();
            const attn_body::AttnTensors AT{(const attn_body::bf16*)(ws + WS_Q), (const attn_body::bf16*)(ws + WS_K), (const attn_body::bf16*)(ws + WS_V), (attn_body::bf16*)(ws + WS_O0), (attn_body::bf16*)(ws + WS_O1)};
            attn_body::attn_phase<8>((char*)(F.lds + RING_OFF), AT, F.vcu, F.G, F.tid);
          }
        } DUP_END(2)
        SEAM(pb + 2);
        DUP_BEGIN(3) if (IN(pb + 3)) { Frame F = make_frame(L3, wave_s); thin_phase(F, L); } DUP_END(3)
        SEAM(pb + 3);
        if (IN(pb + 5)) {
            { Frame F = make_frame(L3, wave_s); unsigned char* ws = F.wsp();
              pg8::Gemm g{(const bf16*)(ws + WS_CAT), (const bf16*)(ws + WS_WOUT) + (size_t)L * DM * DM, M, DM, DM, 0}; pg8::GOrder S; S.init(M / 256, DM / 256, F.G, (int)blockIdx.x);
              pg8::EpiRes E{L == 0 ? F.inf(0) : (const float*)F.outp(), F.outp()};
              pg8::gemm_phase<pg8::EpiRes, pg8::GOrder, PG8_ALIGN, PG8_SP2>(F.lds + RING_OFF, g, S, E, F.tid); }
            { Frame F = make_frame(L3, wave_s); unsigned char* ws = F.wsp();
              pg8::Gemm g{(const bf16*)(ws + WS_PBF) + (size_t)L * M * PLED + (size_t)(M / 2) * PLED, (const bf16*)(ws + WS_WPP) + (size_t)L * DM * PLED, M / 2, DM, PLED, 0}; pg8::GOrder S; S.init(M / 512, DM / 256, F.G, (int)blockIdx.x);
              pg8::EpiBf16<0> E{(bf16*)(ws + WS_PP) + (size_t)(M / 2) * DM, DM, nullptr, 0, 0, 1.f};
              pg8::gemm_phase<pg8::EpiBf16<0>, pg8::GOrder, PG8_ALIGN, PG8_SP2>(F.lds + RING_OFF, g, S, E, F.tid); }
        }
        SEAM(pb + 5);
        DUP_BEGIN(6) if (IN(pb + 6)) { Frame F = make_frame(L3, wave_s); ffn_norm_phase(F, F.inf(18) + L * DM, F.inf(22), (unsigned char*)(F.wsp() + WS_U), moe); } DUP_END(6)
        SEAM(pb + 6);
        DUP_BEGIN(9) if (IN(pb + 7)) { if (moe) { Frame F = make_frame(L3, wave_s); unsigned char* ws = F.wsp(); moe_permute(F, (const unsigned char*)(ws + WS_U), (unsigned char*)(ws + WS_XP)); } } DUP_END(9)
        if (moe) SEAM(pb + 7);
        DUP_BEGIN(4) if (IN(pb + 8)) {
          if (moe && N_LAUNCHES != 1) { Frame F = make_frame(L3, wave_s); moe_offsets(F); }
          const int nseg = 1, grp = (int)((blockIdx.x >> 3) & 1u);
#pragma unroll 1
          for (int seg = 0; seg < 2; ++seg) {
            if (seg == grp) { Frame F = make_frame(L3, wave_s);
                if (false) { }
                }
            if (seg >= nseg) continue;
            Frame F = make_frame(L3, wave_s);
            pg8::GOrder S; pg8::Gemm g;
            if (moe) { unsigned char* ws = F.wsp(); LAS int* mo = (LAS int*)(F.lds + MOE_OFF); S.init(__builtin_amdgcn_readfirstlane(mo[8]), FF / 128, F.G, (int)blockIdx.x);
#pragma unroll
                for (int e = 1; e < 9; ++e) S.ts[e] = __builtin_amdgcn_readfirstlane(mo[e]);
                g = pg8::Gemm{(const bf16*)(ws + WS_XP), (const bf16*)(ws + WS_WGUE), MAXSLOT, 2 * FF, DM / 2, (size_t)2 * FF * DM}; }
            else { unsigned char* ws = F.wsp(); S.init(M / 256, FF / 128, F.G, (int)blockIdx.x); g = pg8::Gemm{(const bf16*)(ws + WS_U), (const bf16*)(ws + WS_WGUD), M, 2 * FF, DM / 2, 0}; }
            { const int R = (S.nwg + F.G - 1) / F.G; S.r0 = seg * R / nseg; if (seg + 1 < nseg) S.r1 = (seg + 1) * R / nseg; }
            unsigned char* ws2 = F.wsp();
            if (f8) { pg8::EpiSwigluI8<true> E{(bf16*)(ws2 + WS_HPQ), FF, (const float*)(ws2 + WS_SAS), (const float*)(ws2 + WS_SWGU) + (moe ? 2 * FF : 0)};
                pg8::gemm_phase<pg8::EpiSwigluI8<true>, pg8::GOrder, PG8_ALIGN, PG8_SP2, 1>(F.lds + RING_OFF, g, S, E, F.tid); }
            else { pg8::EpiSwigluI8<false> E{(bf16*)(ws2 + WS_HP), FF, (const float*)(ws2 + WS_SAS), (const float*)(ws2 + WS_SWGU) + (moe ? 2 * FF : 0)};
                pg8::gemm_phase<pg8::EpiSwigluI8<false>, pg8::GOrder, PG8_ALIGN, PG8_SP2, 1>(F.lds + RING_OFF, g, S, E, F.tid); }
          }
        } DUP_END(4)
        SEAM(pb + 8);
        DUP_BEGIN(10) if (IN(pb + 9)) { if (dq && !f8) { Frame F = make_frame(L3, wave_s); int nrows = M; if (moe) { moe_offsets(F); nrows = 256 * __builtin_amdgcn_readfirstlane(((LAS int*)(F.lds + MOE_OFF))[8]); } hp_quant(F, nrows); } } DUP_END(10)
        if (dq && !f8) SEAM(pb + 9);
        DUP_BEGIN(5) if (IN(pb + 10)) {
          {
            Frame F = make_frame(L3, wave_s);
            pg8::GOrder S; pg8::Gemm g; const size_t kb = dq ? 1 : 2;
            if (moe) { if (N_LAUNCHES != 1) moe_offsets(F); unsigned char* ws = F.wsp(); LAS int* mo = (LAS int*)(F.lds + MOE_OFF); S.init(__builtin_amdgcn_readfirstlane(mo[8]), DM / 256, F.G, (int)blockIdx.x);
#pragma unroll
                for (int e = 1; e < 9; ++e) S.ts[e] = __builtin_amdgcn_readfirstlane(mo[e]);
                g = pg8::Gemm{(const bf16*)(ws + (dq ? WS_HPQ : WS_HP)), (const bf16*)(ws + WS_WDE), MAXSLOT, DM, dq ? FF / 2 : FF, (size_t)DM * FF * kb}; }
            else { unsigned char* ws = F.wsp(); S.init(M / 256, DM / 256, F.G, (int)blockIdx.x); g = pg8::Gemm{(const bf16*)(ws + (dq ? WS_HPQ : WS_HP)), (const bf16*)(ws + WS_WDD), M, DM, dq ? FF / 2 : FF, 0}; }
            unsigned char* ws2 = F.wsp();
            if (f8) { const int nrt = S.nM;
                if (moe && nrt > 128) { S.nM = 128; S.nwg = 128 * S.nN; }
                pg8::EpiScaleBf16 E{(bf16*)(ws2 + WS_Y), DM, (const float*)(ws2 + WS_SWD) + (moe ? DM : 0), 0};
                pg8::gemm_phase<pg8::EpiScaleBf16, pg8::GOrder, PG8_ALIGN, PG8_SP2, 2>(F.lds + RING_OFF, g, S, E, F.tid);
                if (moe && nrt > 128) { pg8::SliceOrder S2; S2.nitems = (nrt - 128) * 32; S2.c = (int)blockIdx.x; S2.pm0 = 128;
#pragma unroll
                    for (int e = 0; e < 9; ++e) S2.ts[e] = S.ts[e];
                    pg8::Gemm g2 = g; g2.K = FF / 8; g2.ldk = FF / 2; g2.kslice = FF / 4;
                    pg8::EpiScaleBf16 E2{(bf16*)(ws2 + WS_HP) - (size_t)32768 * DM, DM, (const float*)(ws2 + WS_SWD) + DM, (size_t)2048 * 2048};
                    pg8::gemm_phase<pg8::EpiScaleBf16, pg8::SliceOrder, PG8_ALIGN, PG8_SP2, 2>(F.lds + RING_OFF, g2, S2, E2, F.tid); } }
            else             if (dq) { const int nrt = S.nM;
                if (moe && nrt > 128) { S.nM = 128; S.nwg = 128 * S.nN; }
                pg8::EpiDqBf16 E{(bf16*)(ws2 + WS_Y), DM, (const float*)(ws2 + WS_SAH), (const float*)(ws2 + WS_SWD) + (moe ? DM : 0), 0};
                pg8::gemm_phase<pg8::EpiDqBf16, pg8::GOrder, PG8_ALIGN, PG8_SP2, 1>(F.lds + RING_OFF, g, S, E, F.tid);
                if (moe && nrt > 128) { pg8::SliceOrder S2; S2.nitems = (nrt - 128) * 32; S2.c = (int)blockIdx.x; S2.pm0 = 128;
#pragma unroll
                    for (int e = 0; e < 9; ++e) S2.ts[e] = S.ts[e];
                    pg8::Gemm g2 = g; g2.K = FF / 8; g2.ldk = FF / 2; g2.kslice = FF / 4;
                    pg8::EpiDqBf16 E2{(bf16*)(ws2 + WS_HP) - (size_t)32768 * DM, DM, (const float*)(ws2 + WS_SAH), (const float*)(ws2 + WS_SWD) + DM, (size_t)2048 * 2048};
                    pg8::gemm_phase<pg8::EpiDqBf16, pg8::SliceOrder, PG8_ALIGN, PG8_SP2, 1>(F.lds + RING_OFF, g2, S2, E2, F.tid); } }
            else { pg8::EpiBf16<0> E{(bf16*)(ws2 + WS_Y), DM, nullptr, 0, 0, 1.f};
                pg8::gemm_phase<pg8::EpiBf16<0>, pg8::GOrder, PG8_ALIGN, PG8_SP2>(F.lds + RING_OFF, g, S, E, F.tid); }
          }
        } DUP_END(5)
        SEAM(pb + 10);
        if (IN(pb + 11)) { Frame F = make_frame(L3, wave_s); unsigned char* ws = F.wsp(); combine_norm(F, (const bf16*)(ws + WS_Y), (const bf16*)(ws + WS_HP), F.inf(26) + L * DM, (unsigned char*)(ws + WS_U), moe, moe && dq); }
        SEAM(pb + 11);
        if (IN(pb + 12)) { Frame F = make_frame(L3, wave_s); unsigned char* ws = F.wsp();
            pg8::Gemm g{(const bf16*)(ws + WS_U), (const bf16*)(ws + WS_WPG + (size_t)L * DM * DM), M, DM, DM / 2, 0};   pg8::GOrder S; S.init(M / 256, DM / 256, F.G, (int)blockIdx.x);
            pg8::EpiPle E{F.outp(), (const bf16*)(ws + WS_PP), (const float*)(ws + WS_SATOK), (const float*)(ws + WS_SWPG) + L * DM};
            pg8::gemm_phase<pg8::EpiPle, pg8::GOrder, PG8_ALIGN, PG8_SP2, 1>(F.lds + RING_OFF, g, S, E, F.tid);
        }
        SEAM(pb + 12);
    }
    if (IN(27)) { Frame F = make_frame(L3, wave_s); final_norm(F, F.inf(29)); }
#undef IN
#undef F_G_IS
#undef SEAM
#undef GRID_BAR
#undef DUP_BEGIN
#undef DUP_END
}

extern "C" void kernel_launch(void* const* d_in, const int* in_sizes, int n_in, void* d_out, int out_size, void* d_ws, size_t ws_size, hipStream_t stream) {
    static int grid = 0;
    if (grid == 0) {
        if (n_in != 30 || in_sizes[0] != M * DM || out_size != M * DM || ws_size < WS_END) { fprintf(stderr, "kernel_launch: shape/workspace mismatch (n_in %d, ws %zu < %zu); nothing launched\n", n_in, ws_size, (size_t)WS_END); grid = -1; return; }
        int dev = 0, cus = 0;
        if (hipGetDevice(&dev) != hipSuccess || hipDeviceGetAttribute(&cus, hipDeviceAttributeMultiprocessorCount, dev) != hipSuccess) { grid = -1; return; }
        if (hipFuncSetAttribute((const void*)mk_fwd, hipFuncAttributeMaxDynamicSharedMemorySize, LDS_BYTES) != hipSuccess) { fprintf(stderr, "kernel_launch: hipFuncSetAttribute failed\n"); grid = -1; return; }
        int per_cu = 0;
        if (hipOccupancyMaxActiveBlocksPerMultiprocessor(&per_cu, (const void*)mk_fwd, NWAVES * 64, LDS_BYTES) != hipSuccess || per_cu < 1) fprintf(stderr, "kernel_launch: note: occupancy query reports %d workgroups per CU\n", per_cu);
        (void)hipGetLastError();
        grid = cus;
        if (grid != 256) { fprintf(stderr, "kernel_launch: this kernel is dealt for 256 CUs, device has %d; nothing launched\n", cus); grid = -1; return; }
    }
    if (grid < 0) return;
    if (hipMemsetAsync((char*)d_ws + WS_CTL, 0, CTL_ZERO_BYTES, stream) != hipSuccess) return;
    Args a{};
    for (int i = 0; i < 30; ++i) a.in[i] = d_in[i];
    a.out = (float*)d_out; a.ws = (unsigned char*)d_ws; a.pad = 0;
    for (int li = 0; li < N_LAUNCHES; ++li) {
        a.ph_lo = (N_LAUNCHES == 1) ? 0 : li; a.ph_hi = (N_LAUNCHES == 1) ? N_PHASES : li + 1; a.li = li;
        hipLaunchKernelGGL(mk_fwd, dim3(grid), dim3(NWAVES * 64), LDS_BYTES, stream, a);
        if (hipPeekAtLastError() != hipSuccess) break;
    }
}
```

```cpp
#include <hip/hip_runtime.h>
#include <cstdio>
#include <cstdint>
namespace pg8 {
#define PG8_LAS __attribute__((address_space(3)))
typedef unsigned short bf16_t;
typedef short bf16x8 __attribute__((ext_vector_type(8)));
typedef float f32x4 __attribute__((ext_vector_type(4)));
typedef unsigned u32x4 __attribute__((ext_vector_type(4)));
typedef int i32x4 __attribute__((ext_vector_type(4)));
typedef int i32x8 __attribute__((ext_vector_type(8)));
template <int MODE> struct AccT { typedef f32x4 type; }; template <> struct AccT<1> { typedef i32x4 type; };
constexpr int BM = 256, BK = 64, HALF = 128, HTB = HALF * BK * 2  , STAGE_BYTES = 8 * HTB, NXCD = 8, WGM = 4;

__host__ __device__ __forceinline__ int lds_byte(int r, int c) { const int st = (r >> 4) * 2 + (c >> 5), rr = r & 15, cc = c & 31, ob = rr * 64 + cc * 2; return st * 1024 + (ob ^ (((ob >> 9) & 1) << 5)); }
__host__ __device__ __forceinline__ void stage_rc(int b, int& R, int& C) { const int st = b / 1024, sb = b % 1024, swz = sb ^ (((sb >> 9) & 1) << 5); R = (st >> 1) * 16 + swz / 64; C = (st & 1) * 32 + (swz % 64) / 2; }
__host__ __device__ __forceinline__ int perm32(int rho) { const int n = rho >> 4, i = rho & 15; return 8 * (i >> 2) + 4 * n + (i & 3); }

struct Unit { int pm, pn, eb, ks; };
struct Gemm { const bf16_t* A; const bf16_t* Bt; int M, N, K; size_t bstride; int ldk; size_t kslice; };

struct GOrder {
    int nM, nN, nwg, G, c; int ts[9]; int r0, r1;
    __device__ __forceinline__ void init(int nM_, int nN_, int G_, int c_) { nM = nM_; nN = nN_; nwg = nM * nN; G = G_; c = c_; ts[0] = 0; r0 = 0; r1 = 0x3fffffff;
#pragma unroll
        for (int e = 1; e < 9; ++e) ts[e] = nM_; }
    __device__ __forceinline__ bool next(int i, Unit& u) const {
        if (i + r0 >= r1) return false;
        const long L = (long)(i + r0) * G + c; if (c < 0 || L >= nwg) return false;
        int wgid = (int)L; { const int q = nwg / NXCD, r = nwg % NXCD, xcd = wgid % NXCD, off = wgid / NXCD; wgid = (xcd < r ? xcd * (q + 1) : r * (q + 1) + (xcd - r) * q) + off; }
        const int nig = WGM * nN, gid = wgid / nig, fm = gid * WGM, gsz = (nM - fm) < WGM ? (nM - fm) : WGM;
        u.pm = fm + ((wgid % nig) % gsz); u.pn = (wgid % nig) / gsz;
        int e = 0;
#pragma unroll
        for (int k = 1; k < 8; ++k) e += (u.pm >= ts[k]) ? 1 : 0;
        u.eb = e; u.ks = 0; return true;
    }
    __device__ __forceinline__ void a_ready(const Unit&) const {}
    __device__ __forceinline__ void done(const Unit&) const {}
};

struct SliceOrder {
    int nitems, c, pm0; int ts[9];
    __device__ __forceinline__ bool next(int i, Unit& u) const {
        if (i > 0 || c >= nitems) return false;
        const int unit = c >> 2; u.ks = c & 3; u.pn = unit & 7; u.pm = pm0 + (unit >> 3);
        int e = 0;
#pragma unroll
        for (int k = 1; k < 8; ++k) e += (u.pm >= ts[k]) ? 1 : 0;
        u.eb = e; return true;
    }
    __device__ __forceinline__ void a_ready(const Unit&) const {}
    __device__ __forceinline__ void done(const Unit&) const {}
};
__device__ __forceinline__ unsigned cvt_pk_bf16(float lo, float hi) { unsigned r; asm volatile("v_cvt_pk_bf16_f32 %0, %1, %2" : "=v"(r) : "v"(lo), "v"(hi)); return r; }
typedef float f32x2 __attribute__((ext_vector_type(2)));
__device__ __forceinline__ f32x2 gelu_pk(f32x2 v) {
    const f32x2 av = __builtin_elementwise_abs(v), d = av * 0.2316418882f + 1.0f;
    f32x2 t; t.x = __builtin_amdgcn_rcpf(d.x); t.y = __builtin_amdgcn_rcpf(d.y);
    f32x2 q = t * 0.5307027145f + (-0.7265760135f); q = q * t + 0.7107068705f; q = q * t + (-0.142248368f); q = q * t + 0.127414796f; q = q * t;
    const f32x2 s = (v * v) * (-0.72134752044f);
    f32x2 e; e.x = __builtin_amdgcn_exp2f(s.x); e.y = __builtin_amdgcn_exp2f(s.y);
    const f32x2 m = v * (q * e), r = v - m;
    f32x2 o; o.x = v.x < 0.f ? m.x : r.x; o.y = v.y < 0.f ? m.y : r.y; return o;
}

template <int ACT  > struct EpiBf16 {
    static constexpr bool PERM = true, AFTER_DRAIN = false; static_assert(ACT == 0 || ACT == 1, "EpiBf16: ACT is 0 (none) or 1 (gelu_pk)");
    bf16_t* O; int ldc; const float* bias; int split_cols; size_t split_stride; float scale0;
    __device__ __forceinline__ void operator()(const f32x4 (&acc)[2][2][4][2], const Unit& u, int wr, int wc, int fr, int fq) const {
        const int row0 = u.pm * BM + wr * 64 + fr; int colt = u.pn * BM; bf16_t* base = O;
        float sc = 1.f; if (split_cols) { const int t = colt / split_cols; base += (size_t)t * split_stride; colt -= t * split_cols; if (t == 0) sc = scale0; }
        const int col0 = colt + wc * 32 + 8 * fq, bcol0 = u.pn * BM + wc * 32 + 8 * fq;
        f32x4 bv[2][2];
#pragma unroll
        for (int bj = 0; bj < 2; ++bj)
#pragma unroll
            for (int n = 0; n < 2; ++n) bv[bj][n] = bias ? *(const f32x4*)(bias + bcol0 + bj * HALF + 4 * n) : (f32x4){0.f, 0.f, 0.f, 0.f};
#pragma unroll
        for (int ai = 0; ai < 2; ++ai)
#pragma unroll
            for (int m = 0; m < 4; ++m) { bf16_t* rowp = base + (size_t)(row0 + ai * HALF + m * 16) * ldc + col0;
#pragma unroll
                for (int bj = 0; bj < 2; ++bj) { f32x4 v0 = acc[ai][bj][m][0] + bv[bj][0], v1 = acc[ai][bj][m][1] + bv[bj][1];
                    if (ACT == 1) { f32x2 a = gelu_pk((f32x2){v0[0], v0[1]}), b = gelu_pk((f32x2){v0[2], v0[3]}), c = gelu_pk((f32x2){v1[0], v1[1]}), d = gelu_pk((f32x2){v1[2], v1[3]});
                        v0 = (f32x4){a.x, a.y, b.x, b.y}; v1 = (f32x4){c.x, c.y, d.x, d.y}; }
                    v0 = v0 * sc; v1 = v1 * sc; u32x4 w; w.x = cvt_pk_bf16(v0[0], v0[1]); w.y = cvt_pk_bf16(v0[2], v0[3]); w.z = cvt_pk_bf16(v1[0], v1[1]); w.w = cvt_pk_bf16(v1[2], v1[3]);
                    *(u32x4*)(rowp + bj * HALF) = w; } }
    }
};

__device__ __forceinline__ float sigm(float x) { return __builtin_amdgcn_rcpf(1.0f + __builtin_amdgcn_exp2f(-1.4426950408889634f * x)); }
__device__ __forceinline__ u32x4 pack8(const f32x4 v0, const f32x4 v1) { u32x4 w; w.x = cvt_pk_bf16(v0[0], v0[1]); w.y = cvt_pk_bf16(v0[2], v0[3]); w.z = cvt_pk_bf16(v1[0], v1[1]); w.w = cvt_pk_bf16(v1[2], v1[3]); return w; }
struct EpiIn {
    static constexpr bool PERM = true, AFTER_DRAIN = false;
    bf16_t *Q, *K, *V, *ZP, *CG; const float* rope; float qscale; const float* sa; const float* sw;
    __device__ __forceinline__ void operator()(const i32x4 (&acc)[2][2][4][2], const Unit& u, int wr, int wc, int fr, int fq) const {
        const int row0 = u.pm * BM + wr * 64 + fr, pn = u.pn, cw = wc * 32 + 8 * fq;
        f32x4 swv[2][2];
#pragma unroll
        for (int bj = 0; bj < 2; ++bj)
#pragma unroll
            for (int n = 0; n < 2; ++n) swv[bj][n] = *(const f32x4*)(sw + pn * BM + bj * HALF + cw + 4 * n);
        float srv[2][4];
#pragma unroll
        for (int ai = 0; ai < 2; ++ai)
#pragma unroll
            for (int m = 0; m < 4; ++m) srv[ai][m] = sa[row0 + ai * HALF + m * 16];
#define DQ(ai, bj, m, n) (__builtin_convertvector(acc[ai][bj][m][n], f32x4) * (swv[bj][n] * sr))
        if (pn < 8) {
            bf16_t* base = (pn < 4 ? Q : K) + (pn & 3) * 256 + cw; const float sc = pn < 4 ? qscale : 1.f;
            const bool rl = ((wc & 1) == 0) && (fq < 2);
#pragma unroll
            for (int ai = 0; ai < 2; ++ai)
#pragma unroll
              for (int mp = 0; mp < 4; mp += 2) { f32x4 csv[2], snv[2];
#pragma unroll
                for (int mm = 0; mm < 2; ++mm) { const int r = row0 + ai * HALF + (mp + mm) * 16; csv[mm] = (f32x4){1.f, 1.f, 1.f, 1.f}; snv[mm] = (f32x4){0.f, 0.f, 0.f, 0.f};
                    if (rl) { csv[mm] = *(const f32x4*)(rope + (size_t)r * 16 + 4 * fq); snv[mm] = *(const f32x4*)(rope + (size_t)r * 16 + 8 + 4 * fq); } }
#pragma unroll
                for (int mm = 0; mm < 2; ++mm) { const int m = mp + mm; const int r = row0 + ai * HALF + m * 16; const float sr = srv[ai][m]; const f32x4 cs = csv[mm], sn = snv[mm];
#pragma unroll
                    for (int bj = 0; bj < 2; ++bj) { const f32x4 v0 = DQ(ai, bj, m, 0), v1 = DQ(ai, bj, m, 1); f32x4 w0, w1;
                        w0[0] = v0[0] * cs[0] - v0[1] * sn[0]; w0[1] = v0[1] * cs[0] + v0[0] * sn[0];
                        w0[2] = v0[2] * cs[1] - v0[3] * sn[1]; w0[3] = v0[3] * cs[1] + v0[2] * sn[1];
                        w1[0] = v1[0] * cs[2] - v1[1] * sn[2]; w1[1] = v1[1] * cs[2] + v1[0] * sn[2];
                        w1[2] = v1[2] * cs[3] - v1[3] * sn[3]; w1[3] = v1[3] * cs[3] + v1[2] * sn[3];
                        *(u32x4*)(base + (size_t)r * 1024 + bj * HALF) = pack8(w0 * sc, w1 * sc); } } }
        } else if (pn < 14) {
            const bool isv = pn < 12; const int ld = isv ? 1024 : 512; bf16_t* base = (isv ? V + (pn - 8) * 256 : ZP + (pn - 12) * 256) + cw;
#pragma unroll
            for (int ai = 0; ai < 2; ++ai)
#pragma unroll
                for (int m = 0; m < 4; ++m) { const int r = row0 + ai * HALF + m * 16; const float sr = srv[ai][m];
#pragma unroll
                    for (int bj = 0; bj < 2; ++bj) *(u32x4*)(base + (size_t)r * ld + bj * HALF) = pack8(DQ(ai, bj, m, 0), DQ(ai, bj, m, 1)); }
        } else {
            bf16_t* base = CG + (pn - 14) * 128 + cw;
#pragma unroll
            for (int ai = 0; ai < 2; ++ai)
#pragma unroll
                for (int m = 0; m < 4; ++m) { const int r = row0 + ai * HALF + m * 16; const float sr = srv[ai][m]; f32x4 c[2];
#pragma unroll
                    for (int n = 0; n < 2; ++n) { const f32x4 a = DQ(ai, 0, m, n), b = DQ(ai, 1, m, n);
#pragma unroll
                        for (int j = 0; j < 4; ++j) c[n][j] = a[j] * sigm(b[j]); }
                    *(u32x4*)(base + (size_t)r * 512) = pack8(c[0], c[1]); }
        }
#undef DQ
    }
};
struct EpiRes {
    static constexpr bool PERM = false, AFTER_DRAIN = false;
    const float* base; float* out;
    __device__ __forceinline__ void operator()(const f32x4 (&acc)[2][2][4][2], const Unit& u, int wr, int wc, int fr, int fq) const {
        const int row0 = u.pm * BM + wr * 64 + fr, col0 = u.pn * BM + wc * 32 + 4 * fq;
#pragma unroll
        for (int ai = 0; ai < 2; ++ai)
#pragma unroll
            for (int mp = 0; mp < 4; mp += 2) { f32x4 bs[2][2][2];
#pragma unroll
                for (int mm = 0; mm < 2; ++mm) { const size_t off = (size_t)(row0 + ai * HALF + (mp + mm) * 16) * 2048 + col0;
#pragma unroll
                    for (int bj = 0; bj < 2; ++bj)
#pragma unroll
                        for (int n = 0; n < 2; ++n) bs[mm][bj][n] = *(const f32x4*)(base + off + bj * HALF + n * 16); }
#pragma unroll
                for (int mm = 0; mm < 2; ++mm) { const size_t off = (size_t)(row0 + ai * HALF + (mp + mm) * 16) * 2048 + col0;
#pragma unroll
                    for (int bj = 0; bj < 2; ++bj)
#pragma unroll
                        for (int n = 0; n < 2; ++n) *(f32x4*)(out + off + bj * HALF + n * 16) = bs[mm][bj][n] + acc[ai][bj][mp + mm][n]; } }
    }
};
struct EpiSwiglu {
    static constexpr bool PERM = true, AFTER_DRAIN = false;
    bf16_t* O; int ldc;
    __device__ __forceinline__ void operator()(const f32x4 (&acc)[2][2][4][2], const Unit& u, int wr, int wc, int fr, int fq) const {
        const int row0 = u.pm * BM + wr * 64 + fr; bf16_t* base = O + u.pn * 128 + wc * 32 + 8 * fq;
#pragma unroll
        for (int ai = 0; ai < 2; ++ai)
#pragma unroll
            for (int m = 0; m < 4; ++m) { const int r = row0 + ai * HALF + m * 16; f32x4 c[2];
#pragma unroll
                for (int n = 0; n < 2; ++n) { const f32x4 g = acc[ai][0][m][n], up = acc[ai][1][m][n];
#pragma unroll
                    for (int j = 0; j < 4; ++j) c[n][j] = g[j] * sigm(g[j]) * up[j]; }
                *(u32x4*)(base + (size_t)r * ldc) = pack8(c[0], c[1]); }
    }
};
__device__ __forceinline__ unsigned cvt4_fp8(float a, float b, float c, float d) {
    a = __builtin_fminf(__builtin_fmaxf(a, -448.f), 448.f); b = __builtin_fminf(__builtin_fmaxf(b, -448.f), 448.f); c = __builtin_fminf(__builtin_fmaxf(c, -448.f), 448.f); d = __builtin_fminf(__builtin_fmaxf(d, -448.f), 448.f);
    int w = 0; w = __builtin_amdgcn_cvt_pk_fp8_f32(a, b, w, false); w = __builtin_amdgcn_cvt_pk_fp8_f32(c, d, w, true); return (unsigned)w; }
struct EpiScaleBf16 {
    static constexpr bool PERM = true, AFTER_DRAIN = false;
    bf16_t* O; int ldc; const float* sw; size_t ks_stride;
    __device__ __forceinline__ void operator()(const f32x4 (&acc)[2][2][4][2], const Unit& u, int wr, int wc, int fr, int fq) const {
        const int row0 = u.pm * BM + wr * 64 + fr, col0 = u.pn * BM + wc * 32 + 8 * fq; const float* swp = sw + (size_t)u.eb * 2048 + col0; bf16_t* Ob = O + (size_t)u.ks * ks_stride;
        f32x4 swv[2][2];
#pragma unroll
        for (int bj = 0; bj < 2; ++bj)
#pragma unroll
            for (int n = 0; n < 2; ++n) swv[bj][n] = *(const f32x4*)(swp + bj * HALF + 4 * n);
#pragma unroll
        for (int ai = 0; ai < 2; ++ai)
#pragma unroll
            for (int m = 0; m < 4; ++m) { const int r = row0 + ai * HALF + m * 16;
#pragma unroll
                for (int bj = 0; bj < 2; ++bj) *(u32x4*)(Ob + (size_t)r * ldc + col0 + bj * HALF) = pack8(acc[ai][bj][m][0] * swv[bj][0], acc[ai][bj][m][1] * swv[bj][1]); }
    }
};
template <bool F8OUT> struct EpiSwigluI8 {
    static constexpr bool PERM = true, AFTER_DRAIN = false;
    bf16_t* O; int ldc; const float* sa; const float* sw;
    __device__ __forceinline__ void operator()(const i32x4 (&acc)[2][2][4][2], const Unit& u, int wr, int wc, int fr, int fq) const {
        const int row0 = u.pm * BM + wr * 64 + fr; bf16_t* base = O + u.pn * 128 + wc * 32 + 8 * fq;
        const float* swp = sw + (size_t)u.eb * 14336 + u.pn * 256 + wc * 32 + 8 * fq;
        const f32x4 sg[2] = {*(const f32x4*)(swp) * 1.4426950408889634f, *(const f32x4*)(swp + 4) * 1.4426950408889634f}, su[2] = {*(const f32x4*)(swp + 128) * 0.6931471805599453f, *(const f32x4*)(swp + 132) * 0.6931471805599453f};
        float srv[2][4];
#pragma unroll
        for (int ai = 0; ai < 2; ++ai)
#pragma unroll
            for (int m = 0; m < 4; ++m) srv[ai][m] = sa[row0 + ai * HALF + m * 16];
#pragma unroll
        for (int ai = 0; ai < 2; ++ai)
#pragma unroll
            for (int m = 0; m < 4; ++m) { const int r = row0 + ai * HALF + m * 16; const float sr = srv[ai][m]; f32x4 c[2];
#pragma unroll
                for (int n = 0; n < 2; ++n) { const f32x4 g = __builtin_convertvector(acc[ai][0][m][n], f32x4) * (sg[n] * sr), up = __builtin_convertvector(acc[ai][1][m][n], f32x4) * (su[n] * sr);
                    f32x4 d;
#pragma unroll
                    for (int j = 0; j < 4; ++j) d[j] = __builtin_amdgcn_rcpf(1.0f + __builtin_amdgcn_exp2f(-g[j]));
                    c[n] = (g * d) * up; }
                if constexpr (F8OUT) { typedef unsigned u32x2 __attribute__((ext_vector_type(2))); u32x2 w; w.x = cvt4_fp8(c[0][0], c[0][1], c[0][2], c[0][3]); w.y = cvt4_fp8(c[1][0], c[1][1], c[1][2], c[1][3]);
                    *(u32x2*)((unsigned char*)O + (size_t)r * ldc + u.pn * 128 + wc * 32 + 8 * fq) = w; }
                else *(u32x4*)(base + (size_t)r * ldc) = pack8(c[0], c[1]); }
    }
};
struct EpiDqBf16 {
    static constexpr bool PERM = true, AFTER_DRAIN = false;
    bf16_t* O; int ldc; const float* sa; const float* sw; size_t ks_stride;
    __device__ __forceinline__ void operator()(const i32x4 (&acc)[2][2][4][2], const Unit& u, int wr, int wc, int fr, int fq) const {
        const int row0 = u.pm * BM + wr * 64 + fr, col0 = u.pn * BM + wc * 32 + 8 * fq; const float* swp = sw + (size_t)u.eb * 2048 + col0; bf16_t* Ob = O + (size_t)u.ks * ks_stride;
        f32x4 swv[2][2];
#pragma unroll
        for (int bj = 0; bj < 2; ++bj)
#pragma unroll
            for (int n = 0; n < 2; ++n) swv[bj][n] = *(const f32x4*)(swp + bj * HALF + 4 * n);
#pragma unroll
        for (int ai = 0; ai < 2; ++ai)
#pragma unroll
            for (int m = 0; m < 4; ++m) { const int r = row0 + ai * HALF + m * 16; const float sr = sa[r];
#pragma unroll
                for (int bj = 0; bj < 2; ++bj) *(u32x4*)(Ob + (size_t)r * ldc + col0 + bj * HALF) = pack8(__builtin_convertvector(acc[ai][bj][m][0], f32x4) * (swv[bj][0] * sr), __builtin_convertvector(acc[ai][bj][m][1], f32x4) * (swv[bj][1] * sr)); }
    }
};
struct EpiPle {
    static constexpr bool PERM = false, AFTER_DRAIN = false;
    float* h; const bf16_t* P; const float* sa; const float* sw;
    __device__ __forceinline__ void operator()(const i32x4 (&acc)[2][2][4][2], const Unit& u, int wr, int wc, int fr, int fq) const {
        typedef unsigned u32x2 __attribute__((ext_vector_type(2)));
        const int row0 = u.pm * BM + wr * 64 + fr, col0 = u.pn * BM + wc * 32 + 4 * fq;
        f32x4 swv[2][2];
#pragma unroll
        for (int bj = 0; bj < 2; ++bj)
#pragma unroll
            for (int n = 0; n < 2; ++n) swv[bj][n] = *(const f32x4*)(sw + col0 + bj * HALF + n * 16);
        f32x4 hv[2][2][2]; u32x2 pw[2][2][2]; float srg[2];
#define PLE_LOAD(g, s) do { const int rr = row0 + ((g) >> 2) * HALF + ((g) & 3) * 16; const size_t off = (size_t)rr * 2048 + col0; srg[s] = sa[rr]; \
            _Pragma("unroll") for (int bj = 0; bj < 2; ++bj) _Pragma("unroll") for (int n = 0; n < 2; ++n) { const size_t o2 = off + bj * HALF + n * 16; hv[s][bj][n] = *(const f32x4*)(h + o2); pw[s][bj][n] = *(const u32x2*)(P + o2); } } while (0)
        PLE_LOAD(0, 0);
#pragma unroll
        for (int g = 0; g < 8; ++g) { const int s = g & 1, ai = g >> 2, m = g & 3; const size_t off = (size_t)(row0 + ai * HALF + m * 16) * 2048 + col0;
            if (g + 1 < 8) { if (s == 0) PLE_LOAD(g + 1, 1); else PLE_LOAD(g + 1, 0); }
            f32x4 ov[2][2];
#pragma unroll
            for (int bj = 0; bj < 2; ++bj)
#pragma unroll
                for (int n = 0; n < 2; ++n) { const f32x4 a = __builtin_convertvector(acc[ai][bj][m][n], f32x4) * (swv[bj][n] * srg[s]); const u32x2 pq = pw[s][bj][n]; f32x4 pv;
                    pv[0] = __uint_as_float(pq.x << 16); pv[1] = __uint_as_float(pq.x & 0xffff0000u); pv[2] = __uint_as_float(pq.y << 16); pv[3] = __uint_as_float(pq.y & 0xffff0000u);
#pragma unroll
                    for (int j = 0; j < 4; ++j) ov[bj][n][j] = hv[s][bj][n][j] + pv[j] * sigm(a[j]); }
#pragma unroll
            for (int bj = 0; bj < 2; ++bj)
#pragma unroll
                for (int n = 0; n < 2; ++n) *(f32x4*)(h + off + bj * HALF + n * 16) = ov[bj][n]; }
#undef PLE_LOAD
    }
};

template <class Epi, class Sched, bool ALIGN_EPI = false, bool SP2 = false, int MODE = 0>
__device__ __forceinline__ void gemm_phase(PG8_LAS unsigned char* lds, const Gemm g, const Sched& S, const Epi& E, int tid) {
    asm volatile("" : "+v"(tid));
    const int wid = __builtin_amdgcn_readfirstlane(tid >> 6), lane = tid & 63, wr = wid >> 2, wc = wid & 3, fr = lane & 15, fq = lane >> 4;
    const int K = g.ldk ? g.ldk : g.K, nt = g.K / BK;
    unsigned voffA[2], voffB[2];
#pragma unroll
    for (int i = 0; i < 2; ++i) { int R, C; stage_rc(tid * 16 + i * 8192, R, C); const int Rb = Epi::PERM ? ((R & ~31) + perm32(R & 31)) : R;
        voffA[i] = (unsigned)(R * K + C) * 2u; voffB[i] = (unsigned)(Rb * K + C) * 2u; }
    const size_t kstep = (size_t)(BK * 2);
    const size_t hstep = (size_t)HALF * K * 2;
    const size_t tstep = 2 * hstep;
    const unsigned ldsw = (unsigned)wid * 1024u;
    const int aoff = lds_byte(wr * 64 + fr, fq * 8), boff = lds_byte(wc * 32 + fr, fq * 8);
#define PG8_SA(b, h) (((b) * 2 + (h)) * HTB)
#define PG8_SB(b, h) ((4 + (b) * 2 + (h)) * HTB)
#define PG8_STAGE(bufoff, gbase, voff) do { _Pragma("unroll") for (int _i = 0; _i < 2; ++_i) \
        __builtin_amdgcn_global_load_lds((const unsigned*)((const char*)(gbase) + (voff)[_i]), (PG8_LAS unsigned*)(lds + (bufoff) + ldsw + _i * 8192), 16, 0, 0); } while (0)
#define PG8_LDA(dst, b, h) do { if constexpr (MODE == 2) { _Pragma("unroll") for (int m = 0; m < 4; ++m) { dst##8[m].lo = *(const PG8_LAS i32x4*)(lds + PG8_SA(b, h) + aoff + m * 2048); dst##8[m].hi = *(const PG8_LAS i32x4*)(lds + PG8_SA(b, h) + aoff + m * 2048 + 1024); } } \
        else { _Pragma("unroll") for (int m = 0; m < 4; ++m) _Pragma("unroll") for (int k = 0; k < 2; ++k) dst[m][k] = *(const PG8_LAS bf16x8*)(lds + PG8_SA(b, h) + aoff + m * 2048 + k * 1024); } } while (0)
#define PG8_LDB(dst, b, h) do { if constexpr (MODE == 2) { _Pragma("unroll") for (int n = 0; n < 2; ++n) { dst##8[n].lo = *(const PG8_LAS i32x4*)(lds + PG8_SB(b, h) + boff + n * 2048); dst##8[n].hi = *(const PG8_LAS i32x4*)(lds + PG8_SB(b, h) + boff + n * 2048 + 1024); } } \
        else { _Pragma("unroll") for (int n = 0; n < 2; ++n) _Pragma("unroll") for (int k = 0; k < 2; ++k) dst[n][k] = *(const PG8_LAS bf16x8*)(lds + PG8_SB(b, h) + boff + n * 2048 + k * 1024); } } while (0)
#define PG8_MMA(ai, bj, At, Bt) do { __builtin_amdgcn_s_setprio(3); _Pragma("unroll") for (int m = 0; m < 4; ++m) _Pragma("unroll") for (int n = 0; n < 2; ++n) _Pragma("unroll") for (int k = 0; k < 2; ++k) \
        { if constexpr (MODE == 1) acc[ai][bj][m][n] = __builtin_bit_cast(acc_t, __builtin_amdgcn_mfma_i32_16x16x64_i8(__builtin_bit_cast(i32x4, Bt[n][k]), __builtin_bit_cast(i32x4, At[m][k]), __builtin_bit_cast(i32x4, acc[ai][bj][m][n]), 0, 0, 0)); \
          else if constexpr (MODE == 2) { if (k == 0) asm volatile("v_mfma_scale_f32_16x16x128_f8f6f4 %0, %1, %2, %0, %3, %3 op_sel_hi:[0,0,0]" : "+v"(acc[ai][bj][m][n]) : "v"(Bt##8[n]), "v"(At##8[m]), "v"(f8scale)); } \
          else acc[ai][bj][m][n] = __builtin_bit_cast(acc_t, __builtin_amdgcn_mfma_f32_16x16x32_bf16(Bt[n][k], At[m][k], __builtin_bit_cast(f32x4, acc[ai][bj][m][n]), 0, 0, 0)); } __builtin_amdgcn_s_setprio(0); } while (0)
#define PG8_WAIT_V(n) asm volatile("s_waitcnt vmcnt(" #n ")" ::: "memory")
#define PG8_WAIT_L(n) asm volatile("s_waitcnt lgkmcnt(" #n ")" ::: "memory")
#define PG8_BAR __builtin_amdgcn_s_barrier()
#define PG8_SCHED __builtin_amdgcn_sched_barrier(0)
    Unit cur, nxt; int ui = 0;
    if (!S.next(0, cur)) return;
    typedef typename AccT<MODE>::type acc_t;
    acc_t acc[2][2][4][2];
#pragma unroll
    for (int a = 0; a < 2; ++a)
#pragma unroll
        for (int b = 0; b < 2; ++b)
#pragma unroll
            for (int m = 0; m < 4; ++m)
#pragma unroll
                for (int n = 0; n < 2; ++n) acc[a][b][m][n] = acc_t{};
    const int f8scale = 0x7f7f7f7f;
    bf16x8 At[4][2], B0[2][2], B1[2][2]; i32x8 At8[4], B08[2], B18[2];
    const char* cA = (const char*)g.A + (size_t)cur.pm * tstep + (size_t)cur.ks * g.kslice; const char* cB = (const char*)g.Bt + (size_t)cur.eb * g.bstride + (size_t)cur.pn * tstep + (size_t)cur.ks * g.kslice;
    S.a_ready(cur);
    if constexpr (SP2) {
        PG8_STAGE(PG8_SB(0, 0), cB, voffB); PG8_STAGE(PG8_SB(0, 1), cB + hstep, voffB); PG8_STAGE(PG8_SA(0, 0), cA, voffA); PG8_STAGE(PG8_SA(0, 1), cA + hstep, voffA);
        if (wr == 1) PG8_BAR;
        PG8_WAIT_V(2); PG8_BAR;
        PG8_STAGE(PG8_SB(1, 0), cB + kstep, voffB); PG8_STAGE(PG8_SA(1, 0), cA + kstep, voffA); PG8_STAGE(PG8_SB(1, 1), cB + hstep + kstep, voffB);
        PG8_WAIT_V(6); PG8_BAR;
    } else {
        PG8_STAGE(PG8_SB(0, 0), cB, voffB); PG8_STAGE(PG8_SA(0, 0), cA, voffA); PG8_STAGE(PG8_SB(0, 1), cB + hstep, voffB); PG8_STAGE(PG8_SA(0, 1), cA + hstep, voffA);
        if (wr == 1) PG8_BAR;
        PG8_WAIT_V(4); PG8_BAR;
        PG8_STAGE(PG8_SB(1, 0), cB + kstep, voffB); PG8_STAGE(PG8_SA(1, 0), cA + kstep, voffA); PG8_STAGE(PG8_SB(1, 1), cB + hstep + kstep, voffB);
        PG8_WAIT_V(6); PG8_BAR;
    }
    for (;;) {
        const bool has_next = S.next(ui + 1, nxt);
        const char* nA = has_next ? (const char*)g.A + (size_t)nxt.pm * tstep + (size_t)nxt.ks * g.kslice : cA; const char* nB = has_next ? (const char*)g.Bt + (size_t)nxt.eb * g.bstride + (size_t)nxt.pn * tstep + (size_t)nxt.ks * g.kslice : cB;
        for (int t = 0; t < nt; t += 2) {
            const bool last = (t == nt - 2);
            const char* a1 = cA + (size_t)(t + 1) * kstep;
            const char* a2 = last ? nA : cA + (size_t)(t + 2) * kstep; const char* b2 = last ? nB : cB + (size_t)(t + 2) * kstep;
            const char* a3 = a2 + kstep; const char* b3 = b2 + kstep;
            if (last && has_next) S.a_ready(nxt);
            if constexpr (SP2) {
            PG8_LDB(B0, 0, 0); PG8_LDB(B1, 0, 1); PG8_SCHED; PG8_LDA(At, 0, 0); PG8_STAGE(PG8_SA(1, 1), a1 + hstep, voffA);
            PG8_WAIT_V(8); PG8_WAIT_L(0); PG8_BAR; PG8_MMA(0, 0, At, B0); PG8_MMA(0, 1, At, B1); PG8_BAR; PG8_SCHED;
            PG8_LDA(At, 0, 1); PG8_STAGE(PG8_SB(0, 0), b2, voffB); PG8_STAGE(PG8_SB(0, 1), b2 + hstep, voffB); PG8_STAGE(PG8_SA(0, 0), a2, voffA);
            PG8_WAIT_V(8); PG8_WAIT_L(0); PG8_BAR; PG8_MMA(1, 0, At, B0); PG8_MMA(1, 1, At, B1); PG8_BAR; PG8_SCHED;
            PG8_LDB(B0, 1, 0); PG8_LDB(B1, 1, 1); PG8_SCHED; PG8_LDA(At, 1, 0); PG8_STAGE(PG8_SA(0, 1), a2 + hstep, voffA);
            PG8_WAIT_V(8); PG8_WAIT_L(0); PG8_BAR; PG8_MMA(0, 0, At, B0); PG8_MMA(0, 1, At, B1); PG8_BAR; PG8_SCHED;
            PG8_LDA(At, 1, 1); PG8_STAGE(PG8_SB(1, 0), b3, voffB); PG8_STAGE(PG8_SB(1, 1), b3 + hstep, voffB); PG8_STAGE(PG8_SA(1, 0), a3, voffA);
            PG8_WAIT_V(8); PG8_WAIT_L(0); PG8_BAR; PG8_MMA(1, 0, At, B0); PG8_MMA(1, 1, At, B1); PG8_BAR; PG8_SCHED;
            } else {
            PG8_LDB(B0, 0, 0); PG8_SCHED; PG8_LDA(At, 0, 0); PG8_STAGE(PG8_SA(1, 1), a1 + hstep, voffA);
            PG8_WAIT_L(8); PG8_BAR; PG8_WAIT_L(0); PG8_MMA(0, 0, At, B0); PG8_BAR; PG8_SCHED;
            PG8_LDB(B1, 0, 1); PG8_STAGE(PG8_SB(0, 0), b2, voffB);
            PG8_BAR; PG8_WAIT_L(0); PG8_MMA(0, 1, At, B1); PG8_BAR;
            PG8_LDA(At, 0, 1); PG8_STAGE(PG8_SA(0, 0), a2, voffA);
            PG8_BAR; PG8_WAIT_L(0); PG8_MMA(1, 0, At, B0); PG8_BAR; PG8_SCHED;
            PG8_STAGE(PG8_SB(0, 1), b2 + hstep, voffB);
            PG8_WAIT_V(6); PG8_BAR; PG8_MMA(1, 1, At, B1); PG8_BAR;
            PG8_LDB(B0, 1, 0); PG8_SCHED; PG8_LDA(At, 1, 0); PG8_STAGE(PG8_SA(0, 1), a2 + hstep, voffA);
            PG8_WAIT_L(8); PG8_BAR; PG8_WAIT_L(0); PG8_MMA(0, 0, At, B0); PG8_BAR; PG8_SCHED;
            PG8_LDB(B1, 1, 1); PG8_STAGE(PG8_SB(1, 0), b3, voffB);
            PG8_BAR; PG8_WAIT_L(0); PG8_MMA(0, 1, At, B1); PG8_BAR;
            PG8_LDA(At, 1, 1); PG8_STAGE(PG8_SA(1, 0), a3, voffA);
            PG8_BAR; PG8_WAIT_L(0); PG8_MMA(1, 0, At, B0); PG8_BAR; PG8_SCHED;
            PG8_STAGE(PG8_SB(1, 1), b3 + hstep, voffB);
            PG8_WAIT_V(6); PG8_BAR; PG8_MMA(1, 1, At, B1); PG8_BAR;
            }
        }
        if constexpr (MODE == 2) asm volatile("s_nop 15\n\ts_nop 7" ::: "memory");
        if constexpr (ALIGN_EPI) { if (wr == 0) PG8_BAR; }
        if constexpr (!Epi::AFTER_DRAIN) { E(acc, cur, wr, wc, fr, fq); S.done(cur); }
        if (!has_next) break;
#pragma unroll
        for (int a = 0; a < 2; ++a)
#pragma unroll
            for (int b = 0; b < 2; ++b)
#pragma unroll
                for (int m = 0; m < 4; ++m)
#pragma unroll
                    for (int n = 0; n < 2; ++n) acc[a][b][m][n] = acc_t{};
        cur = nxt; cA = nA; cB = nB; ++ui;
        if constexpr (ALIGN_EPI) { if (wr == 1) PG8_BAR; }
    }
    PG8_WAIT_V(0);
    if constexpr (!ALIGN_EPI) { if (wr == 0) PG8_BAR; }
    PG8_BAR;
    if constexpr (Epi::AFTER_DRAIN) { E.fused(acc, cur, wr, wc, fr, fq, lds, wid, lane); S.done(cur); }
#undef PG8_SA
#undef PG8_SB
#undef PG8_STAGE
#undef PG8_LDA
#undef PG8_LDB
#undef PG8_MMA
#undef PG8_WAIT_V
#undef PG8_WAIT_L
#undef PG8_BAR
#undef PG8_SCHED
}
}

#ifndef PG8_SP2
#define PG8_SP2 true
#endif
#ifndef PG8_ALIGN
#define PG8_ALIGN true
#endif
#include <hip/hip_bf16.h>
#include <cmath>
namespace attn_body {
using bf16=__hip_bfloat16;
using bf16x8=__attribute__((ext_vector_type(8)))short;
using s16x4=__attribute__((ext_vector_type(4)))short;
using f32x16=__attribute__((ext_vector_type(16)))float;
using u32x4=__attribute__((ext_vector_type(4)))unsigned;
constexpr int BATCH=4,SEQ=4096,D=64,DM=1024;
constexpr int NW=8,QBLK=32,QB=QBLK*NW,KVBLK=64,NQB=SEQ/QB;
constexpr int ATTN_PITCH=DM, ATTN_UNIT_ROWS=QB;
__device__ __forceinline__ int crow(int r,int hi){return (r&3)+8*(r>>2)+4*hi;}
#define SBAR() __builtin_amdgcn_sched_barrier(0)
__device__ __forceinline__ void cmask(f32x16&p0,f32x16&p1,int jb,int qrel,int hi){
  const float NEG=-INFINITY; int kb=64*jb+4*hi;
  #pragma unroll
  for(int r=0;r<16;++r){int kv=kb+(r&3)+8*(r>>2); if(kv>qrel)p0[r]=NEG; if(kv+32>qrel)p1[r]=NEG;}
}

constexpr int NSLOT=3, SLOTB=8192;
constexpr int VSLOTB=2*SLOTB;
constexpr int LDS_K=0, LDS_V=NSLOT*SLOTB, LDS_WS=LDS_V+NSLOT*VSLOTB, LDS_OST=LDS_WS+NW*64*4, LDS_BYTES=LDS_OST+NW*4096;
constexpr float C2=0.125f*1.4426950408889634f;
__device__ __forceinline__ void glds16(const void*gsrc,unsigned lds_dst){unsigned keep;
  asm volatile("s_mov_b32 %0, m0\n\ts_mov_b32 m0, %2\n\ts_nop 0\n\tglobal_load_lds_dwordx4 %1, off\n\ts_mov_b32 m0, %0":"=&s"(keep):"v"(gsrc),"s"(lds_dst):"memory");}
__device__ __forceinline__ float max3f(float a,float b,float c){float r;asm("v_max3_f32 %0, %1, %2, %3":"=v"(r):"v"(a),"v"(b),"v"(c));return r;}
__device__ __forceinline__ float max2f(float a,float b){float r;asm("v_max_f32_e32 %0, %1, %2":"=v"(r):"v"(a),"v"(b));return r;}
__device__ __forceinline__ float fadd_s(float a,float b){float r;asm("v_add_f32_e32 %0, %1, %2":"=v"(r):"v"(a),"v"(b));return r;}
__device__ __forceinline__ float fsub_s(float a,float b){float r;asm("v_sub_f32_e32 %0, %1, %2":"=v"(r):"v"(a),"v"(b));return r;}
typedef float f32x2_t __attribute__((ext_vector_type(2))); typedef __bf16 bf16x2_t __attribute__((ext_vector_type(2)));
__device__ __forceinline__ unsigned cvtpk_s(float lo,float hi){f32x2_t v={lo,hi};bf16x2_t b=__builtin_convertvector(v,bf16x2_t);return __builtin_bit_cast(unsigned,b);}
#define WAIT_BAR(N) asm volatile("s_waitcnt vmcnt(" #N ") lgkmcnt(0)\n\ts_barrier":::"memory")

__device__ __forceinline__ void qkt(f32x16&p0,f32x16&p1,const char*Kslot,const bf16x8*qr,const f32x16&negm,int r32,int hi){
  const char*kb=Kslot+hi*1024+r32*16;
  #pragma unroll
  for(int d0=0;d0<4;++d0){
    const bf16x8 b0=*reinterpret_cast<const bf16x8*>(kb+d0*2048);
    const bf16x8 b1=*reinterpret_cast<const bf16x8*>(kb+d0*2048+512);
    if(d0==0){p0=__builtin_amdgcn_mfma_f32_32x32x16_bf16(b0,qr[0],negm,0,0,0);p1=__builtin_amdgcn_mfma_f32_32x32x16_bf16(b1,qr[0],negm,0,0,0);}
    else{p0=__builtin_amdgcn_mfma_f32_32x32x16_bf16(b0,qr[d0],p0,0,0,0);p1=__builtin_amdgcn_mfma_f32_32x32x16_bf16(b1,qr[d0],p1,0,0,0);}}
}
typedef __attribute__((address_space(3))) const char* lds_cptr;
typedef short v4i16_t __attribute__((ext_vector_type(4)));
__device__ __forceinline__ void kload8(bf16x8*kf,lds_cptr kp){
  kf[0]=*(const __attribute__((address_space(3))) bf16x8*)(kp);      kf[1]=*(const __attribute__((address_space(3))) bf16x8*)(kp+512);
  kf[2]=*(const __attribute__((address_space(3))) bf16x8*)(kp+2048); kf[3]=*(const __attribute__((address_space(3))) bf16x8*)(kp+2560);
  kf[4]=*(const __attribute__((address_space(3))) bf16x8*)(kp+4096); kf[5]=*(const __attribute__((address_space(3))) bf16x8*)(kp+4608);
  kf[6]=*(const __attribute__((address_space(3))) bf16x8*)(kp+6144); kf[7]=*(const __attribute__((address_space(3))) bf16x8*)(kp+6656);
}
__device__ __forceinline__ void kload2(bf16x8*kf,lds_cptr kp,int j){ kf[2*j]=*(const __attribute__((address_space(3))) bf16x8*)(kp+j*2048); kf[2*j+1]=*(const __attribute__((address_space(3))) bf16x8*)(kp+j*2048+512); }
__device__ __forceinline__ s16x4 vtr(lds_cptr p){ return __builtin_bit_cast(s16x4,__builtin_amdgcn_ds_read_tr16_b64_v4i16((__attribute__((address_space(3))) v4i16_t*)p)); }
__device__ __forceinline__ float rowmax(const f32x16&p0,const f32x16&p1){
  float a=max3f(p0[0],p0[1],p1[0]),b=max3f(p0[2],p0[3],p1[1]);a=max3f(a,p1[2],p1[3]);
  #pragma unroll
  for(int r=4;r<16;r+=4){a=max3f(a,p0[r],p0[r+1]);b=max3f(b,p0[r+2],p0[r+3]);a=max3f(a,p1[r],p1[r+1]);b=max3f(b,p1[r+2],p1[r+3]);}
  const float m=max2f(a,b);
  auto rr=__builtin_amdgcn_permlane32_swap(__float_as_uint(m),__float_as_uint(m),false,false);
  return max2f(__uint_as_float(rr[0]),__uint_as_float(rr[1]));
}
__device__ __forceinline__ void pv(f32x16*o,int vb,bf16x8 pa0,bf16x8 pa1,bf16x8 pa2,bf16x8 pa3){
  #pragma unroll
  for(int d0=0;d0<4;++d0){s16x4 lo[4],hi[4];
    #pragma unroll
    for(int ks=0;ks<4;++ks){
      asm volatile("ds_read_b64_tr_b16 %0,%1 offset:%c2":"=&v"(lo[ks]):"v"(vb),"i"(d0*4096+ks*1024):"memory");
      asm volatile("ds_read_b64_tr_b16 %0,%1 offset:%c2":"=&v"(hi[ks]):"v"(vb),"i"(d0*4096+ks*1024+512):"memory");}
    asm volatile("s_waitcnt lgkmcnt(0)":::"memory");SBAR();
    #define PK(k) (bf16x8){lo[k][0],lo[k][1],lo[k][2],lo[k][3],hi[k][0],hi[k][1],hi[k][2],hi[k][3]}
    o[d0]=__builtin_amdgcn_mfma_f32_32x32x16_bf16(pa0,PK(0),o[d0],0,0,0);
    o[d0]=__builtin_amdgcn_mfma_f32_32x32x16_bf16(pa1,PK(1),o[d0],0,0,0);
    o[d0]=__builtin_amdgcn_mfma_f32_32x32x16_bf16(pa2,PK(2),o[d0],0,0,0);
    o[d0]=__builtin_amdgcn_mfma_f32_32x32x16_bf16(pa3,PK(3),o[d0],0,0,0);
    #undef PK
  }
}

#ifndef ATTN_STORE16
#define ATTN_STORE16(p,v) (*(u32x4*)(p)=(v))
#endif
template<int THRL> __device__ __forceinline__ void attn_unit(int b,int qcol,int vcol,int qb,const bf16*Q,const bf16*__restrict__ K,const bf16*__restrict__ V,bf16*O,char*shm,int tid){
  asm volatile("":"+v"(tid)); const int lane=tid&63,r32=lane&31,hi=lane>>5; const int wid=__builtin_amdgcn_readfirstlane(tid>>6);
  const long rowbase=(long)b*SEQ; const int q0=qb*QB;
  const bf16*Qw=Q+(rowbase+q0+wid*QBLK)*DM+qcol;
  const bf16*Kh=K+rowbase*DM+qcol,*Vh=V+rowbase*DM+vcol;
  const unsigned lds0=(unsigned)(uintptr_t)shm;
  float*wsf=(float*)(shm+LDS_WS)+wid*64;
  const bf16*ksrc=Kh+(long)lane*DM+wid*8;
  const bf16*vsrc=Vh+(long)(16*(wid&3)+(lane>>2))*DM+(wid>>2)*32+(lane&3)*8;
  const unsigned kdst=lds0+LDS_K+wid*1024, vdst=lds0+LDS_V+wid*1024;
  #define DMA_K(t,slot) glds16(ksrc+(long)(t)*KVBLK*DM,(unsigned)__builtin_amdgcn_readfirstlane(kdst+(slot)))
  #define DMA_V(t,slot) do{ glds16(vsrc+(long)(t)*KVBLK*DM,(unsigned)__builtin_amdgcn_readfirstlane(vdst+2*(slot))); glds16(vsrc+64+(long)(t)*KVBLK*DM,(unsigned)__builtin_amdgcn_readfirstlane(vdst+2*(slot)+8192)); }while(0)
  const int vb0=(int)(lds0+LDS_V)+((lane>>4)&1)*32+(lane&3)*8+(4*hi+((lane&15)>>2))*64;
  const char*Kbase=shm+LDS_K; bf16x8 kf[8];
  const lds_cptr shm3=(lds_cptr)shm; const lds_cptr kp0=shm3+LDS_K+hi*1024+r32*16; const lds_cptr vp0=shm3+LDS_V+((lane>>4)&1)*32+(lane&3)*8+(4*hi+((lane&15)>>2))*64;
  const int NT=(q0+QB)/KVBLK;
  DMA_K(0,0);DMA_V(0,0);DMA_K(1,SLOTB);
  bf16x8 qr[4];
  #pragma unroll
  for(int d0=0;d0<4;++d0)qr[d0]=*reinterpret_cast<const bf16x8*>(&Qw[(long)r32*DM+d0*16+hi*8]);
  float mhat=0.f,l_reg=0.f;f32x16 o[4];o[0]=f32x16{};o[1]=f32x16{};o[2]=f32x16{};o[3]=f32x16{};const f32x16 zero16=f32x16{};
  const int qrel=wid*QBLK+r32;
  #define CMASK(P0,P1,t) do{int jb_=(t)-(NT-4); if(jb_>=0)cmask(P0,P1,jb_,qrel,hi);}while(0)
  bool resc=false;
  #define START(P0,P1) do{ const float rm=rowmax(P0,P1); resc=false; \
    { const float dl=rm; mhat=fadd_s(mhat,dl); \
      _Pragma("unroll") for(int r=0;r<16;++r){P0[r]=fsub_s(P0[r],dl);P1[r]=fsub_s(P1[r],dl);} } \
    _Pragma("unroll") for(int r=0;r<16;++r)P0[r]=__builtin_amdgcn_exp2f(P0[r]); }while(0)
  #define RESC() do{ if(resc){ asm volatile("s_waitcnt lgkmcnt(0)":::"memory"); \
      _Pragma("unroll") for(int d_=0;d_<4;++d_) _Pragma("unroll") for(int r=0;r<16;++r)o[d_][r]*=wsf[crow(r,hi)]; } }while(0)
  f32x16 pA0,pA1,pB0,pB1;
  int sl_prev=0,sl_cur=0,sl_next=SLOTB;
  #define ROT() do{sl_prev=sl_cur;sl_cur=sl_next;sl_next=(sl_next==(NSLOT-1)*SLOTB)?0:sl_next+SLOTB;}while(0)
  DMA_K(2,2*SLOTB);
  WAIT_BAR(4);
  qkt(pA0,pA1,Kbase,qr,zero16,r32,hi);asm volatile("s_nop 15\n\ts_nop 7":"+v"(pA0),"+v"(pA1));CMASK(pA0,pA1,0);
  START(pA0,pA1);
  _Pragma("unroll") for(int r=0;r<16;++r)pA1[r]=__builtin_amdgcn_exp2f(pA1[r]);
  WAIT_BAR(0);
  DMA_K(3,0);DMA_V(1,SLOTB);
  ROT();
  kload8(kf,kp0+sl_cur);
  WAIT_BAR(3);
  s16x4 vlo[16],vhi[16]; u32x4 pw0,pw1,pw2,pw3;
  #define PKW(P,B) cvtpk_s(P[B],P[B+1])
  #define PAF(k) __builtin_bit_cast(bf16x8,pw##k)
  #define VFR(i) (bf16x8){vlo[i][0],vlo[i][1],vlo[i][2],vlo[i][3],vhi[i][0],vhi[i][1],vhi[i][2],vhi[i][3]}
  #define PIN(x) asm volatile("":"+v"(x))
  #define MX3(a,b,c) __builtin_fmaxf(__builtin_fmaxf((a),(b)),(c))
  #define GAPA(MF,A0,A1,A2,A3,W0,W1,PW) do{ MF; sacc+=A0; sacc+=A1; sacc+=A2; sacc+=A3; PIN(sacc); W0; W1; PIN(PW); SBAR(); }while(0)
  #define EX(v) __builtin_amdgcn_exp2f(v)
  #define GAPB(MF,X,B) do{ MF; X[B]=EX(X[B]-mhat); X[B+1]=EX(X[B+1]-mhat); PIN(X); SBAR(); }while(0)
  #define VRD(f) do{ vlo[f]=vtr(vp_+(((f)&3)*4096+((f)>>2)*1024)); vhi[f]=vtr(vp_+(((f)&3)*4096+((f)>>2)*1024+512)); }while(0)
  #define KRD(G,j) do{ if(G){ kload2(kf,kp0+sl_next,j); SBAR(); } }while(0)
  #define STEP(C0,C1,P0,P1,t,GK,GV,GL) do{ SBAR(); \
    const lds_cptr vp_=vp0+2*sl_prev; \
    float sacc=(P0[0]+P0[1]); \
    GAPA(C0=__builtin_amdgcn_mfma_f32_32x32x16_bf16(kf[0],qr[0],zero16,0,0,0), P0[2],P0[3],P0[4],P0[5],     pw0[0]=PKW(P0,0), pw0[1]=PKW(P0,2), pw0); \
    GAPA(C1=__builtin_amdgcn_mfma_f32_32x32x16_bf16(kf[1],qr[0],zero16,0,0,0), P0[6],P0[7],P0[8],P0[9],     pw0[2]=PKW(P0,4), pw0[3]=PKW(P0,6), pw0); \
    GAPA(C0=__builtin_amdgcn_mfma_f32_32x32x16_bf16(kf[2],qr[1],C0,0,0,0),   P0[10],P0[11],P0[12],P0[13], pw1[0]=PKW(P0,8), pw1[1]=PKW(P0,10), pw1); \
    GAPA(C1=__builtin_amdgcn_mfma_f32_32x32x16_bf16(kf[3],qr[1],C1,0,0,0),   P0[14],P0[15],P1[0],P1[1],   pw1[2]=PKW(P0,12),pw1[3]=PKW(P0,14), pw1); \
    VRD(0); SBAR(); GAPA(C0=__builtin_amdgcn_mfma_f32_32x32x16_bf16(kf[4],qr[2],C0,0,0,0),   P1[2],P1[3],P1[4],P1[5],     pw2[0]=PKW(P1,0), pw2[1]=PKW(P1,2), pw2); \
    VRD(1); SBAR(); GAPA(C1=__builtin_amdgcn_mfma_f32_32x32x16_bf16(kf[5],qr[2],C1,0,0,0),   P1[6],P1[7],P1[8],P1[9],     pw2[2]=PKW(P1,4), pw2[3]=PKW(P1,6), pw2); \
    VRD(2); SBAR(); GAPA(C0=__builtin_amdgcn_mfma_f32_32x32x16_bf16(kf[6],qr[3],C0,0,0,0),   P1[10],P1[11],P1[12],P1[13], pw3[0]=PKW(P1,8), pw3[1]=PKW(P1,10), pw3); \
    VRD(3); SBAR(); GAPA(C1=__builtin_amdgcn_mfma_f32_32x32x16_bf16(kf[7],qr[3],C1,0,0,0),   P1[14],P1[15],0.f,0.f,       pw3[2]=PKW(P1,12),pw3[3]=PKW(P1,14), pw3); \
    l_reg+=sacc; \
    if(GK){DMA_K((t)+3,sl_cur);} if(GV){DMA_V((t)+1,sl_next);} \
    CMASK(C0,C1,t); \
    { float a=MX3(C0[0],C0[1],C1[0]),b=MX3(C0[2],C0[3],C1[1]); a=MX3(a,C1[2],C1[3]); \
      _Pragma("unroll") for(int r=4;r<16;r+=4){a=MX3(a,C0[r],C0[r+1]);b=MX3(b,C0[r+2],C0[r+3]);a=MX3(a,C1[r],C1[r+1]);b=MX3(b,C1[r+2],C1[r+3]);} \
      float rm=__builtin_fmaxf(a,b); { auto rr=__builtin_amdgcn_permlane32_swap(__float_as_uint(rm),__float_as_uint(rm),false,false); rm=__builtin_fmaxf(__uint_as_float(rr[0]),__uint_as_float(rr[1])); } \
      rm-=mhat; resc=false;     \
      if(__builtin_expect(__any(rm>(float)THRL),0)){ const float dl=__builtin_fmaxf(rm,0.f); mhat+=dl; \
        const float f=__builtin_amdgcn_exp2f(-dl); l_reg*=f; if(hi==0)wsf[r32]=f; resc=true; } } \
    SBAR(); \
    VRD(4);  SBAR(); GAPB(o[0]=__builtin_amdgcn_mfma_f32_32x32x16_bf16(PAF(0),VFR(0),o[0],0,0,0),  C0,0); \
    VRD(5);  SBAR(); GAPB(o[1]=__builtin_amdgcn_mfma_f32_32x32x16_bf16(PAF(0),VFR(1),o[1],0,0,0),  C0,2); \
    VRD(6);  SBAR(); GAPB(o[2]=__builtin_amdgcn_mfma_f32_32x32x16_bf16(PAF(0),VFR(2),o[2],0,0,0),  C0,4); \
    VRD(7);  SBAR(); GAPB(o[3]=__builtin_amdgcn_mfma_f32_32x32x16_bf16(PAF(0),VFR(3),o[3],0,0,0),  C0,6); \
    VRD(8);  SBAR(); GAPB(o[0]=__builtin_amdgcn_mfma_f32_32x32x16_bf16(PAF(1),VFR(4),o[0],0,0,0),  C0,8); \
    VRD(9);  SBAR(); GAPB(o[1]=__builtin_amdgcn_mfma_f32_32x32x16_bf16(PAF(1),VFR(5),o[1],0,0,0),  C0,10); \
    VRD(10); SBAR(); GAPB(o[2]=__builtin_amdgcn_mfma_f32_32x32x16_bf16(PAF(1),VFR(6),o[2],0,0,0),  C0,12); \
    VRD(11); SBAR(); GAPB(o[3]=__builtin_amdgcn_mfma_f32_32x32x16_bf16(PAF(1),VFR(7),o[3],0,0,0),  C0,14); \
    VRD(12); SBAR(); GAPB(o[0]=__builtin_amdgcn_mfma_f32_32x32x16_bf16(PAF(2),VFR(8),o[0],0,0,0),  C1,0); \
    VRD(13); SBAR(); GAPB(o[1]=__builtin_amdgcn_mfma_f32_32x32x16_bf16(PAF(2),VFR(9),o[1],0,0,0),  C1,2); \
    VRD(14); SBAR(); GAPB(o[2]=__builtin_amdgcn_mfma_f32_32x32x16_bf16(PAF(2),VFR(10),o[2],0,0,0), C1,4); \
    VRD(15); SBAR(); GAPB(o[3]=__builtin_amdgcn_mfma_f32_32x32x16_bf16(PAF(2),VFR(11),o[3],0,0,0), C1,6); \
    KRD(GL,0); GAPB(o[0]=__builtin_amdgcn_mfma_f32_32x32x16_bf16(PAF(3),VFR(12),o[0],0,0,0), C1,8); \
    KRD(GL,1); GAPB(o[1]=__builtin_amdgcn_mfma_f32_32x32x16_bf16(PAF(3),VFR(13),o[1],0,0,0), C1,10); \
    KRD(GL,2); GAPB(o[2]=__builtin_amdgcn_mfma_f32_32x32x16_bf16(PAF(3),VFR(14),o[2],0,0,0), C1,12); \
    KRD(GL,3); GAPB(o[3]=__builtin_amdgcn_mfma_f32_32x32x16_bf16(PAF(3),VFR(15),o[3],0,0,0), C1,14); \
    }while(0)
  int t=1;
  #undef CMASK
  #define CMASK(P0,P1,t) do{}while(0)
  for(;t+5<NT;t+=2){
    STEP(pB0,pB1,pA0,pA1,t,true,true,true);     WAIT_BAR(3); RESC(); ROT();
    STEP(pA0,pA1,pB0,pB1,t+1,true,true,true);   WAIT_BAR(3); RESC(); ROT();
  }
  #undef CMASK
  #define CMASK(P0,P1,t) do{int jb_=(t)-(NT-4); if(jb_>=0)cmask(P0,P1,jb_,qrel,hi);}while(0)
  #define ENDW(tt) do{ if((tt)+3<NT){WAIT_BAR(3);} else if((tt)+2<NT){WAIT_BAR(2);} else {WAIT_BAR(0);} }while(0)
  for(;t+1<NT;t+=2){
    STEP(pB0,pB1,pA0,pA1,t,(t+3<NT),(t+1<NT),(t+1<NT));       ENDW(t);   RESC(); ROT();
    STEP(pA0,pA1,pB0,pB1,t+1,(t+4<NT),(t+2<NT),(t+2<NT));     ENDW(t+1); RESC(); ROT();
  }
  STEP(pB0,pB1,pA0,pA1,NT-1,false,false,false); RESC();
  { float sacc=pB0[0]+pB0[1]; _Pragma("unroll") for(int r=2;r<16;++r)sacc+=pB0[r]; _Pragma("unroll") for(int r=0;r<16;++r)sacc+=pB1[r]; l_reg+=sacc;
    pw0=(u32x4){PKW(pB0,0),PKW(pB0,2),PKW(pB0,4),PKW(pB0,6)};pw1=(u32x4){PKW(pB0,8),PKW(pB0,10),PKW(pB0,12),PKW(pB0,14)};pw2=(u32x4){PKW(pB1,0),PKW(pB1,2),PKW(pB1,4),PKW(pB1,6)};pw3=(u32x4){PKW(pB1,8),PKW(pB1,10),PKW(pB1,12),PKW(pB1,14)};
    SBAR(); pv(o,vb0+2*sl_cur,PAF(0),PAF(1),PAF(2),PAF(3)); }
  #undef PKW
  #undef PAF
  #undef VFR
  #undef PIN
  #undef MX3
  #undef GAPA
  #undef GAPB
  #undef EX
  #undef VRD
  #undef KRD
  #undef STEP
  #undef ENDW
  {auto rr=__builtin_amdgcn_permlane32_swap(__float_as_uint(l_reg),__float_as_uint(l_reg),false,false);l_reg=__uint_as_float(rr[0])+__uint_as_float(rr[1]);}
  if(hi==0)wsf[32+r32]=l_reg;asm volatile("s_waitcnt lgkmcnt(0)":::"memory");
  float rli[16];
  #pragma unroll
  for(int r=0;r<16;++r)rli[r]=__builtin_amdgcn_rcpf(wsf[32+crow(r,hi)]);
  bf16*Ow=O+(rowbase+q0+wid*QBLK)*DM+vcol;
  { bf16*stg=(bf16*)(shm+LDS_OST)+wid*2048;
    #pragma unroll
    for(int h2=0;h2<2;++h2){
      #pragma unroll
      for(int r=0;r<16;++r){const int orow=crow(r,hi);
        #pragma unroll
        for(int d0=0;d0<2;++d0)stg[orow*64+d0*32+r32]=__float2bfloat16(o[2*h2+d0][r]*rli[r]);}
      asm volatile("s_waitcnt lgkmcnt(0)":::"memory");
      #pragma unroll
      for(int i=0;i<4;++i){const int row=i*8+(lane>>3),ch=lane&7; const u32x4 v=*(const u32x4*)(stg+row*64+ch*8); ATTN_STORE16(Ow+(long)row*DM+64*h2+ch*8,v);}
      asm volatile("s_waitcnt lgkmcnt(0)":::"memory"); } }
  asm volatile("s_waitcnt lgkmcnt(0)\n\ts_barrier":::"memory");
  #undef DMA_K
  #undef DMA_V
  #undef CMASK
  #undef START
  #undef RESC
  #undef ROT
}
constexpr int ATTN_LDS_BYTES=LDS_BYTES;
struct AttnTensors { const bf16* Q; const bf16* K; const bf16* V; bf16* O0; bf16* O1; };
template<int THRL=8> __device__ __forceinline__ void attn_phase(char*lds,const AttnTensors&T,int vcu,int G,int tid,int i0=0,int i1=1<<30){
  for(int i=i0;i<i1;++i){
    int b,hc,qb;
    if(G==256){ if(i>=4)break; const int pr=vcu>>2; b=pr>>4; hc=pr&15; const int s=(vcu&3)+4*(i>>1); qb=(i&1)?15-s:s; }
    else { const int L=i*G+vcu; if(L>=BATCH*16*NQB)break; qb=L%NQB; hc=(L/NQB)&15; b=L/(NQB*16); }
    attn_unit<THRL>(b,hc*64,(hc>>1)*128,qb,T.Q,T.K,T.V,(hc&1)?T.O1:T.O0,lds,tid);
  }
}
#undef SBAR
#undef WAIT_BAR
}
constexpr int NWAVES = 8;
#ifndef MK_N_LAUNCHES
#define MK_N_LAUNCHES 1
#endif
constexpr int N_PHASES = 28;
constexpr bool MOE_DOWN_F8 = true;
constexpr unsigned DOWN_I8 = 3u;
constexpr int N_LAUNCHES = MK_N_LAUNCHES;
static_assert(N_LAUNCHES == 1 || N_LAUNCHES == N_PHASES, "MK_N_LAUNCHES is 1 or 28");

constexpr int DM = 2048, BATCH = 4, SEQ = 4096, M = BATCH * SEQ, DEPTH = 2, INC = 4608, FF = 7168, NEXP = 8, PLED = 256;
constexpr int MAXSLOT = 136 * 256;
constexpr float LAM_INIT0 = 0.2f, LAM_INIT1 = 0.35550906759f;
constexpr size_t MiB = 1u << 20;
constexpr size_t WS_CTL = 0, CTL_ZERO_BYTES = 256 * 1024;
constexpr size_t WS_HIST = 1 * MiB;
constexpr size_t WS_ROPE = 2 * MiB;
constexpr size_t WS_SEL = 3 * MiB;
constexpr size_t WS_SWGU = WS_HIST + 65536;
constexpr size_t WS_SWIN = WS_HIST + 65536 + 524288, WS_SWPG = WS_HIST + 640 * 1024;
constexpr size_t WS_SWD = WS_HIST + 704 * 1024, WS_SAH = WS_HIST + 800 * 1024;
constexpr int CW_DMAX = 32768;
constexpr size_t WS_SATOK = WS_SEL + 640 * 1024, WS_SAS = WS_SEL + 768 * 1024;
constexpr size_t WS_WIN = 4 * MiB, WS_WOUT = 40 * MiB, WS_BD = 56 * MiB, WS_WPG = 60 * MiB, WS_WPP = 76 * MiB, WS_PBF = 78 * MiB;
constexpr size_t WS_WOHI = 68 * MiB;
constexpr size_t WS_WGUD = 94 * MiB, WS_WDD = 122 * MiB, WS_WGUE = 150 * MiB, WS_WDE = 374 * MiB, WS_HPQ = 598 * MiB;
constexpr size_t WS_U = 850 * MiB, WS_PP = 914 * MiB;
constexpr size_t WS_Q = 978 * MiB, WS_K = 1010 * MiB, WS_V = 1042 * MiB, WS_ZP = 1074 * MiB, WS_CG = 1090 * MiB, WS_O0 = 1106 * MiB, WS_O1 = 1138 * MiB, WS_DS = 1170 * MiB, WS_CAT = 1202 * MiB;
constexpr size_t WS_XP = 978 * MiB, WS_Y = 1114 * MiB;
constexpr size_t WS_HP = 1266 * MiB, WS_END = 1742 * MiB;
static_assert(WS_XP + (size_t)MAXSLOT * DM * 2 <= WS_Y && WS_Y + (size_t)MAXSLOT * DM * 2 <= WS_HP && WS_HP + (size_t)MAXSLOT * FF * 2 <= WS_END, "d_ws map");
static_assert(WS_WDE + (size_t)NEXP * DM * FF * 2 <= WS_HPQ && WS_HPQ + (size_t)MAXSLOT * FF <= WS_U && WS_WGUE + (size_t)NEXP * 2 * FF * DM <= WS_WDE && WS_WGUD + (size_t)2 * FF * DM <= WS_WDD && WS_WDD + (size_t)DM * FF * 2 <= WS_WGUE && WS_CAT + (size_t)M * DM * 2 <= WS_HP, "d_ws map");
constexpr int CW_TMO = 0, CW_CODE = 1, CW_BAR = 4096;
constexpr int RING_OFF = 0, RING_BYTES = 131072;
constexpr int LDSCTL_OFF = RING_BYTES, MISC_OFF = LDSCTL_OFF + 320;
constexpr int MOE_OFF = LDSCTL_OFF;
constexpr int PTR_OFF = MISC_OFF + 128;
constexpr int CM_OFF = PTR_OFF + 256;
constexpr int LDS_BYTES = 147456;
static_assert(CM_OFF + 128 <= LDS_BYTES, "LDS map");

#define GAS __attribute__((address_space(1)))
#define LAS __attribute__((address_space(3)))
typedef unsigned short bf16;
typedef unsigned v4u __attribute__((ext_vector_type(4)));
typedef unsigned v2u __attribute__((ext_vector_type(2)));
typedef int v4i __attribute__((ext_vector_type(4)));
typedef float f32x4 __attribute__((ext_vector_type(4)));
typedef short bf16x8 __attribute__((ext_vector_type(8)));
typedef GAS unsigned gu32;
typedef GAS unsigned long long gu64;
#define RLX_AGENT __ATOMIC_RELAXED, __HIP_MEMORY_SCOPE_AGENT
#define LDS_WAIT() asm volatile("s_waitcnt lgkmcnt(0)" ::: "memory")
#define VM_WAIT() asm volatile("s_waitcnt vmcnt(0)" ::: "memory")
__device__ __forceinline__ unsigned f2bf(float f) { unsigned u = __builtin_bit_cast(unsigned, f); return (u + 0x7fffu + ((u >> 16) & 1u)) >> 16; }
__device__ __forceinline__ unsigned pk2(float lo, float hi) { return f2bf(lo) | (f2bf(hi) << 16); }
__device__ __forceinline__ float bflo(unsigned w) { return __uint_as_float(w << 16); }
__device__ __forceinline__ float bfhi(unsigned w) { return __uint_as_float(w & 0xffff0000u); }
__device__ __forceinline__ float sigm(float x) { return __builtin_amdgcn_rcpf(1.0f + __builtin_amdgcn_exp2f(-1.4426950408889634f * x)); }

#define XB_TMO      128
#define XB_XCNT(j)  (256  + 64 * (j))
#define XB_XSUB(j)  (1280 + 64 * (j))
#define XB_XGEN(j)  (2304 + 64 * (j))
#define XB_TOP      3328
#define XB_TOPGEN   3392
#define XCD_BAR_WORDS 3456
#define XB_SPIN_CAP (1u << 18)

__device__ __forceinline__ unsigned xb_ld(unsigned* p)              { return __hip_atomic_load(p, __ATOMIC_RELAXED, __HIP_MEMORY_SCOPE_AGENT); }
__device__ __forceinline__ unsigned xb_add(unsigned* p, unsigned v) { return __hip_atomic_fetch_add(p, v, __ATOMIC_RELAXED, __HIP_MEMORY_SCOPE_AGENT); }
__device__ __forceinline__ unsigned xb_xcc_id() { return (unsigned)__builtin_amdgcn_s_getreg((3 << 11) | 20) & 0xFu; }
#define XB_SPIN(cond, bar) do { unsigned _sp = 0; while (cond) { __builtin_amdgcn_s_sleep(1); \
    if ((++_sp & 255u) == 0u) { if (xb_ld(&(bar)[XB_TMO])) break; if (_sp > XB_SPIN_CAP) { atomicAdd(&(bar)[XB_TMO], 1u); break; } } } } while (0)

struct XcdBarrier {
    unsigned* bar; unsigned x;
    volatile LAS unsigned* st;
};

__device__ __forceinline__ XcdBarrier xcd_barrier_post(unsigned* bar, volatile LAS unsigned* st) {
    XcdBarrier b; b.bar = bar; b.x = xb_xcc_id(); b.st = st;
    if (threadIdx.x == 0) (void)xb_add(&bar[XB_XCNT(b.x)], 1u);
    return b;
}
__device__ __forceinline__ void xcd_barrier_complete(unsigned* bar, unsigned x, unsigned& nloc, unsigned& nx) {
    const unsigned G = gridDim.x * gridDim.y * gridDim.z;
    unsigned sum, cnt, mine, sp = 0u;
    for (;;) {
        sum = 0u; cnt = 0u; mine = 0u;
#pragma unroll
        for (unsigned j = 0; j < 16; ++j) { const unsigned c = xb_ld(&bar[XB_XCNT(j)]); sum += c; cnt += (c > 0u) ? 1u : 0u; mine = (j == x) ? c : mine; }
        if (sum == G) break;
        __builtin_amdgcn_s_sleep(1);
        if ((++sp & 255u) == 0u) { if (xb_ld(&bar[XB_TMO])) break; if (sp > XB_SPIN_CAP) { atomicAdd(&bar[XB_TMO], 1u); break; } }
    }
    nloc = mine > 0u ? mine : 1u; nx = cnt > 0u ? cnt : 1u;
}

__device__ __forceinline__ void xcd_barrier(const XcdBarrier& b, const bool leader  ) {
    asm volatile("s_waitcnt vmcnt(0)" ::: "memory");
    __syncthreads();
    if (leader) {
        unsigned* bar = b.bar;
        __builtin_amdgcn_s_waitcnt(0);
        unsigned nloc = b.st[0], nx = b.st[1];
        if (nloc == 0u) { xcd_barrier_complete(bar, b.x, nloc, nx); b.st[0] = nloc; b.st[1] = nx; }
        const unsigned old = xb_add(&bar[XB_XSUB(b.x)], 1u);
        const unsigned gen = old / nloc;
        if (old + 1u == (gen + 1u) * nloc) {
            __builtin_amdgcn_fence(__ATOMIC_RELEASE, "agent");
            asm volatile("s_waitcnt vmcnt(0)" ::: "memory");
            const unsigned og = xb_add(&bar[XB_TOP], 1u);
            const unsigned tg = og / nx;
            if (og + 1u == (tg + 1u) * nx) xb_add(&bar[XB_TOPGEN], 1u);
            else XB_SPIN(xb_ld(&bar[XB_TOPGEN]) == tg, bar);
            __builtin_amdgcn_fence(__ATOMIC_ACQUIRE, "agent");
            xb_add(&bar[XB_XGEN(b.x)], 1u);
            asm volatile("s_waitcnt vmcnt(0)" ::: "memory");
        } else {
            XB_SPIN(xb_ld(&bar[XB_XGEN(b.x)]) == gen, bar);
            __builtin_amdgcn_fence(__ATOMIC_ACQUIRE, "agent");
            asm volatile("s_waitcnt vmcnt(0)" ::: "memory");
        }
    }
    __syncthreads();
}

struct Frame {
    LAS unsigned char* lds;
    int tid, lane, wave, vcu, G;
    __device__ __forceinline__ const void* ptr(int k) const { const LAS unsigned* t = (const LAS unsigned*)(lds + PTR_OFF) + 2 * k;
        const unsigned lo = (unsigned)__builtin_amdgcn_readfirstlane((int)t[0]), hi = (unsigned)__builtin_amdgcn_readfirstlane((int)t[1]); return (const void*)(const GAS unsigned char*)(((unsigned long long)hi << 32) | lo); }
    __device__ __forceinline__ const float* inf(int k) const { return (const float*)ptr(k); }
    __device__ __forceinline__ float* outp() const { return (float*)ptr(30); }
    __device__ __forceinline__ unsigned char* wsp() const { return (unsigned char*)ptr(31); }
};
__device__ __forceinline__ Frame make_frame(LAS unsigned char* lds, int wave_s) {
    Frame F; int tid = wave_s * 64 + (int)__builtin_amdgcn_mbcnt_hi(~0u, __builtin_amdgcn_mbcnt_lo(~0u, 0u)); asm volatile("" : "+v"(tid)); asm volatile("" ::: "memory");
    { unsigned lb = (unsigned)(unsigned long long)lds; asm volatile("" : "+s"(lb)); F.lds = (LAS unsigned char*)lb; }
    F.tid = tid; F.lane = tid & 63; F.wave = __builtin_amdgcn_readfirstlane(tid >> 6);
    F.G = gridDim.x; { const int bx = blockIdx.x; F.vcu = (F.G % 8 == 0) ? (bx % 8) * (F.G / 8) + bx / 8 : bx; }
    return F;
}
template <int CTRL, int ROWMASK> __device__ __forceinline__ float dpp_mov(float old, float v) { return __int_as_float(__builtin_amdgcn_update_dpp(__float_as_int(old), __float_as_int(v), CTRL, ROWMASK, 0xf, false)); }
__device__ __forceinline__ float row8_sum(float v) {
    v += dpp_mov<0xB1, 0xf>(0.f, v); v += dpp_mov<0x4E, 0xf>(0.f, v); v += dpp_mov<0x141, 0xf>(0.f, v); return v; }
__device__ __forceinline__ float wave_sum(float v) {
    v = row8_sum(v); v += dpp_mov<0x140, 0xf>(0.f, v);
    v += dpp_mov<0x142, 0xa>(0.f, v); v += dpp_mov<0x143, 0xc>(0.f, v);
    return __int_as_float(__builtin_amdgcn_readlane(__float_as_int(v), 63));
}
__device__ __forceinline__ int wave_sum_i(int v) {
#define DPPI(ctrl, rm) __builtin_amdgcn_update_dpp(0, v, ctrl, rm, 0xf, false)
    v += DPPI(0xB1, 0xf); v += DPPI(0x4E, 0xf); v += DPPI(0x141, 0xf); v += DPPI(0x140, 0xf); v += DPPI(0x142, 0xa); v += DPPI(0x143, 0xc);
#undef DPPI
    return __builtin_amdgcn_readlane(v, 63);
}
__device__ __forceinline__ float max_x8_x16(float a) {
    a = fmaxf(a, dpp_mov<0x128, 0xf>(a, a));
    a = fmaxf(a, __int_as_float(__builtin_amdgcn_ds_swizzle(__float_as_int(a), 0x401F)));
    return a;
}
__device__ __forceinline__ float wave_max(float v) {
    v = fmaxf(v, dpp_mov<0xB1, 0xf>(v, v)); v = fmaxf(v, dpp_mov<0x4E, 0xf>(v, v)); v = fmaxf(v, dpp_mov<0x141, 0xf>(v, v)); v = fmaxf(v, dpp_mov<0x140, 0xf>(v, v));
    v = fmaxf(v, dpp_mov<0x142, 0xa>(v, v)); v = fmaxf(v, dpp_mov<0x143, 0xc>(v, v));
    return __int_as_float(__builtin_amdgcn_readlane(__float_as_int(v), 63));
}
enum { MAP_ID = 0, MAP_WIN = 1, MAP_GU0 = 2, MAP_GU1 = 3 };
__device__ __forceinline__ int dst_row(int mode, int n) {
    if (mode == MAP_ID) return n;
    if (mode == MAP_WIN) {
        if (n < 2048) { const int d = n & 63, b = n & ~63; const int p = d < 8 ? 2 * d : (d < 16 ? 2 * (d - 8) + 1 : d); return b + p; }
        if (n < 3584) return n;
        if (n < 4096) { const int ch = n - 3584; return 3584 + 256 * (ch >> 7) + (ch & 127); }
        { const int ch = n - 4096; return 3584 + 256 * (ch >> 7) + 128 + (ch & 127); }
    }
    return 256 * (n >> 7) + (mode == MAP_GU1 ? 128 : 0) + (n & 127);
}
__device__ __forceinline__ void p0_transpose_item(const float* W, int K, int N, bf16* WT, int mode, LAS float* scr, int item, int lane, int ldt = 0) {
    if (ldt == 0) ldt = K;
    const int nblk = N / 32, kb = item / nblk, nb = item % nblk, k0 = 64 * kb, n0 = 32 * nb;
    float tv[32];
#pragma unroll
    for (int i = 0; i < 32; ++i) { const int kk = 2 * i + (lane >> 5); tv[i] = W[(size_t)(k0 + kk) * N + n0 + (lane & 31)]; }
#pragma unroll
    for (int i = 0; i < 32; ++i) { const int kk = 2 * i + (lane >> 5); scr[kk * 33 + (lane & 31)] = tv[i]; }
    LDS_WAIT(); asm volatile("" ::: "memory");
    const int c = lane & 7;
#pragma unroll
    for (int j = 0; j < 4; ++j) { const int n = (lane >> 3) + 8 * j; const LAS float* s = scr + (8 * c) * 33 + n;
        v4u o; o.x = pk2(s[0 * 33], s[1 * 33]); o.y = pk2(s[2 * 33], s[3 * 33]); o.z = pk2(s[4 * 33], s[5 * 33]); o.w = pk2(s[6 * 33], s[7 * 33]);
        *(GAS v4u*)(WT + (size_t)dst_row(mode, n0 + n) * ldt + k0 + 8 * c) = o; }
    LDS_WAIT(); asm volatile("" ::: "memory");
}
__device__ __forceinline__ unsigned q4_i8(float a, float b, float c, float d, float iv) {
    const float MG = 12582912.f;
    const unsigned A = __float_as_uint(__builtin_fmaf(a, iv, MG)), B = __float_as_uint(__builtin_fmaf(b, iv, MG)), C = __float_as_uint(__builtin_fmaf(c, iv, MG)), D = __float_as_uint(__builtin_fmaf(d, iv, MG));
    return __builtin_amdgcn_perm(B, A, 0x0c0c0400u) | __builtin_amdgcn_perm(D, C, 0x04000c0cu);
}
struct StripJob { const float* W; unsigned char* W8; float* sw; int N, n0, mode; };
#define LDS_BAR() asm volatile("s_waitcnt lgkmcnt(0)\n\ts_barrier" ::: "memory")
__device__ __forceinline__ StripJob strip_job(Frame& F, int st0) {
    constexpr int NS_IN = 2 * (INC / 32), NS_PG = 2 * (DM / 32);
    StripJob j;
    if (st0 < NS_IN) { const int L = st0 / (INC / 32), nb = st0 % (INC / 32);
        j.W = (const float*)F.ptr(4) + (size_t)L * DM * INC; j.N = INC; j.n0 = 32 * nb; j.mode = MAP_WIN; j.W8 = (unsigned char*)(F.wsp() + WS_WIN) + (size_t)L * INC * DM; j.sw = (float*)(F.wsp() + WS_SWIN) + L * INC; return j; }
    if (st0 < NS_IN + NS_PG) { const int q2 = st0 - NS_IN, L = q2 / (DM / 32), nb = q2 % (DM / 32);
        j.W = (const float*)F.ptr(27) + (size_t)L * DM * DM; j.N = DM; j.n0 = 32 * nb; j.mode = MAP_ID; j.W8 = (unsigned char*)(F.wsp() + WS_WPG) + (size_t)L * DM * DM; j.sw = (float*)(F.wsp() + WS_SWPG) + L * DM; return j; }
    const int st = st0 - NS_IN - NS_PG, s = st / (2 * (FF / 32)), q = st % (2 * (FF / 32)), which = q / (FF / 32), nb = q % (FF / 32);
    j.W = s == 0 ? (const float*)F.ptr(which ? 20 : 19) : (const float*)F.ptr(which ? 24 : 23) + (size_t)(s - 1) * DM * FF; j.N = FF; j.n0 = 32 * nb; j.mode = which ? MAP_GU1 : MAP_GU0;
    j.W8 = (unsigned char*)(F.wsp() + (s == 0 ? WS_WGUD : WS_WGUE)) + (s == 0 ? (size_t)0 : (size_t)(s - 1) * 2 * FF * DM); j.sw = (float*)(F.wsp() + WS_SWGU) + (size_t)s * 2 * FF; return j;
}
__device__ __forceinline__ void strip_load(Frame& F, const StripJob& j, f32x4 (&v)[8][4]) {
    const int c4 = F.lane & 7, rs = F.lane >> 3;
    const GAS unsigned char* Wb = (const GAS unsigned char*)((const GAS float*)j.W + j.n0); const unsigned toff = (unsigned)((32 * F.wave + 4 * rs) * j.N + 4 * c4) * 4u;
#pragma unroll
    for (int it = 0; it < 8; ++it)
#pragma unroll
        for (int jj = 0; jj < 4; ++jj) v[it][jj] = __builtin_nontemporal_load((const GAS f32x4*)(Wb + (size_t)(256 * it + jj) * (size_t)j.N * 4 + toff));
}
__device__ __forceinline__ void strip_quant(Frame& F, const StripJob& j, f32x4 (&v)[8][4], bool hasn, const StripJob& nj) {
    LAS unsigned* cm = (LAS unsigned*)(F.lds + CM_OFF); LAS unsigned* lq = (LAS unsigned*)(F.lds + RING_OFF);
    const int c4 = F.lane & 7, rs = F.lane >> 3;
    if (F.tid < 32) cm[F.tid] = 0u;
    f32x4 am = (f32x4){0.f, 0.f, 0.f, 0.f};
#pragma unroll
    for (int it = 0; it < 8; ++it)
#pragma unroll
        for (int jj = 0; jj < 4; ++jj)
#pragma unroll
            for (int cc = 0; cc < 4; ++cc) am[cc] = fmaxf(am[cc], fabsf(v[it][jj][cc]));
#pragma unroll
    for (int cc = 0; cc < 4; ++cc) am[cc] = max_x8_x16(am[cc]);
    LDS_BAR();
    if ((F.lane & 31) < 8) {
#pragma unroll
        for (int cc = 0; cc < 4; ++cc) atomicMax((unsigned*)&cm[4 * c4 + cc], __float_as_uint(am[cc])); }
    LDS_BAR();
    float iv[4];
#pragma unroll
    for (int cc = 0; cc < 4; ++cc) { const float mx = __uint_as_float(cm[4 * c4 + cc]); iv[cc] = mx > 0.f ? 127.f / mx : 0.f; }
    const GAS unsigned char* nWb = (const GAS unsigned char*)((const GAS float*)nj.W + nj.n0); const unsigned ntoff = (unsigned)((32 * F.wave + 4 * rs) * nj.N + 4 * c4) * 4u;
    if (F.tid < 32) { const float mx = __uint_as_float(cm[F.tid]); j.sw[dst_row(j.mode, j.n0 + F.tid)] = mx > 0.f ? mx * (1.f / 127.f) : 1.f; }
#pragma unroll
    for (int it = 0; it < 8; ++it) { const int kd = 64 * it + 8 * F.wave + rs;
#pragma unroll
        for (int cc = 0; cc < 4; ++cc) { const int n = 4 * c4 + cc; lq[n * 512 + (kd ^ n)] = q4_i8(v[it][0][cc], v[it][1][cc], v[it][2][cc], v[it][3][cc], iv[cc]); }
        if (hasn) {
#pragma unroll
            for (int jj = 0; jj < 4; ++jj) v[it][jj] = __builtin_nontemporal_load((const GAS f32x4*)(nWb + (size_t)(256 * it + jj) * (size_t)nj.N * 4 + ntoff)); } }
    LDS_BAR();
#pragma unroll
    for (int i = 0; i < 8; ++i) { const int nn = 4 * i + (F.wave >> 1), c = 64 * (F.wave & 1) + F.lane;
        v4u x = ((const LAS v4u*)lq)[nn * 128 + (c ^ (nn >> 2))];
        if (nn & 1) { unsigned t = x.x; x.x = x.y; x.y = t; t = x.z; x.z = x.w; x.w = t; }
        if (nn & 2) { unsigned t = x.x; x.x = x.z; x.z = t; t = x.y; x.y = x.w; x.w = t; }
        *(GAS v4u*)(j.W8 + (size_t)dst_row(j.mode, j.n0 + nn) * 2048 + 16 * c) = x; }
    LDS_BAR();
}
__device__ __forceinline__ bool down_i8_set(int s) { return s == 0 ? (DOWN_I8 & 1u) != 0u : (DOWN_I8 & 2u) != 0u; }
__device__ __forceinline__ void p0_down_amax(Frame& F) {
    const int s = F.vcu % 9, idx = F.vcu / 9;
    if (F.vcu >= 252 || !down_i8_set(s)) return;
    const float* wd = s == 0 ? (const float*)F.ptr(21) : (const float*)F.ptr(25) + (size_t)(s - 1) * FF * DM;
    LAS unsigned* lm = (LAS unsigned*)(F.lds + RING_OFF);
    __syncthreads();
    for (int i = F.tid; i < DM; i += NWAVES * 64) lm[i] = 0u;
    __syncthreads();
    f32x4 mx[8];
#pragma unroll
    for (int j = 0; j < 8; ++j) mx[j] = (f32x4){0.f, 0.f, 0.f, 0.f};
#pragma unroll 2
    for (int r = F.wave; r < 256; r += NWAVES) { const GAS f32x4* p = (const GAS f32x4*)(wd + (size_t)(idx * 256 + r) * DM) + F.lane;
#pragma unroll
        for (int j = 0; j < 8; ++j) { const f32x4 v = p[64 * j]; mx[j].x = fmaxf(mx[j].x, fabsf(v.x)); mx[j].y = fmaxf(mx[j].y, fabsf(v.y)); mx[j].z = fmaxf(mx[j].z, fabsf(v.z)); mx[j].w = fmaxf(mx[j].w, fabsf(v.w)); } }
#pragma unroll
    for (int j = 0; j < 8; ++j) { const int c = 4 * (F.lane + 64 * j); atomicMax((unsigned*)&lm[c], __float_as_uint(mx[j].x)); atomicMax((unsigned*)&lm[c + 1], __float_as_uint(mx[j].y)); atomicMax((unsigned*)&lm[c + 2], __float_as_uint(mx[j].z)); atomicMax((unsigned*)&lm[c + 3], __float_as_uint(mx[j].w)); }
    __syncthreads();
    unsigned* dmax = (unsigned*)(F.wsp() + WS_CTL) + CW_DMAX + s * DM;
    for (int i = F.tid; i < DM; i += NWAVES * 64) atomicMax(dmax + i, lm[i]);
    __syncthreads();
}
struct DqJob { const float* W; unsigned char* W8; float* swd; const unsigned* dmaxp; int kbase, n0; };
__device__ __forceinline__ DqJob dq_job(Frame& F, int st) {
    constexpr int PER_SET = 4 * (DM / 32);
    const int s = st / PER_SET, q = st % PER_SET, kc = q / (DM / 32), nb = q % (DM / 32);
    DqJob j; j.W = s == 0 ? (const float*)F.ptr(21) : (const float*)F.ptr(25) + (size_t)(s - 1) * FF * DM;
    j.W8 = (unsigned char*)(F.wsp() + (s == 0 ? WS_WDD : WS_WDE)) + (s == 0 ? (size_t)0 : (size_t)(s - 1) * DM * FF);
    j.swd = (float*)(F.wsp() + WS_SWD) + s * DM; j.dmaxp = (const unsigned*)(F.wsp() + WS_CTL) + CW_DMAX + s * DM; j.kbase = 1792 * kc; j.n0 = 32 * nb; return j;
}
__device__ __forceinline__ void dq_sample_load(Frame& F, const DqJob& j, f32x4 (&sx)[4]) {
    const int c4 = F.lane & 7, rs = F.lane >> 3;
    const GAS unsigned char* Ws = (const GAS unsigned char*)((const GAS float*)j.W + j.n0) + (unsigned)((32 * (F.wave & 1) + 4 * rs) * DM + 4 * c4) * 4u;
#pragma unroll
    for (int q = 0; q < 4; ++q) sx[q] = *(const GAS f32x4*)(Ws + (size_t)q * DM * 4);
}
__device__ __forceinline__ const GAS unsigned char* dq_base(const DqJob& j) { return (const GAS unsigned char*)((const GAS float*)j.W + j.n0 + (size_t)j.kbase * DM); }
__device__ __forceinline__ void dq_process(Frame& F, const DqJob& j, f32x4 (&v)[7][4], f32x4 (&sx)[4], bool hasn, const DqJob& nj, bool f8) {
    constexpr int NIT = 28;
    LAS unsigned* lq = (LAS unsigned*)(F.lds + RING_OFF); LAS unsigned* cm = (LAS unsigned*)(F.lds + CM_OFF);
    const int c4 = F.lane & 7, rs = F.lane >> 3;
    float qmax = 127.f; float mx[4];
    if (f8) {
        f32x4 sm = (f32x4){0.f, 0.f, 0.f, 0.f};
#pragma unroll
        for (int q = 0; q < 4; ++q)
#pragma unroll
            for (int cc = 0; cc < 4; ++cc) sm[cc] = fmaxf(sm[cc], fabsf(sx[q][cc]));
#pragma unroll
        for (int cc = 0; cc < 4; ++cc) sm[cc] = max_x8_x16(sm[cc]);
        LDS_BAR();
        if (F.tid < 32) cm[F.tid] = 0u;
        LDS_BAR();
        if ((F.lane & 31) < 8) {
#pragma unroll
            for (int cc = 0; cc < 4; ++cc) atomicMax((unsigned*)&cm[4 * c4 + cc], __float_as_uint(sm[cc])); }
        LDS_BAR();
#pragma unroll
        for (int cc = 0; cc < 4; ++cc) mx[cc] = __uint_as_float(cm[4 * c4 + cc]);
        qmax = 28.f;
    } else {
#pragma unroll
        for (int cc = 0; cc < 4; ++cc) mx[cc] = __uint_as_float(j.dmaxp[j.n0 + 4 * c4 + cc]);
        LDS_BAR(); }
    if (hasn && f8) dq_sample_load(F, nj, sx);
    float iv[4];
#pragma unroll
    for (int cc = 0; cc < 4; ++cc) iv[cc] = mx[cc] > 0.f ? qmax / mx[cc] : 0.f;
    if (j.kbase == 0 && F.wave == 0 && rs == 0) {
#pragma unroll
        for (int cc = 0; cc < 4; ++cc) j.swd[j.n0 + 4 * c4 + cc] = mx[cc] > 0.f ? mx[cc] / qmax : 1.f; }
    const GAS unsigned char* nWb = dq_base(nj); const unsigned toff = (unsigned)((32 * F.wave + 4 * rs) * DM + 4 * c4) * 4u;
#pragma unroll
    for (int it = 0; it < 7; ++it) { const int kd = 64 * it + 8 * F.wave + rs;
#pragma unroll
        for (int cc = 0; cc < 4; ++cc) { const int n = 4 * c4 + cc; unsigned w;
            if (f8) w = pg8::cvt4_fp8(v[it][0][cc] * iv[cc], v[it][1][cc] * iv[cc], v[it][2][cc] * iv[cc], v[it][3][cc] * iv[cc]);
            else w = q4_i8(v[it][0][cc], v[it][1][cc], v[it][2][cc], v[it][3][cc], iv[cc]);
            lq[n * (16 * NIT) + (kd ^ n)] = w; }
        if (hasn) {
#pragma unroll
            for (int q = 0; q < 4; ++q) v[it][q] = __builtin_nontemporal_load((const GAS f32x4*)(nWb + (size_t)(256 * it + q) * DM * 4 + toff)); } }
    LDS_BAR();
#pragma unroll
    for (int i = 0; i < 7; ++i) { const int item = i * (NWAVES * 64) + F.tid, nn = item / (4 * NIT), c = item % (4 * NIT);
        const v4u x = ((const LAS v4u*)lq)[nn * (4 * NIT) + (c ^ (nn >> 2))]; const bool s1 = (nn & 1) != 0, s2 = (nn & 2) != 0;
        const unsigned a0 = s1 ? x.y : x.x, a1 = s1 ? x.x : x.y, a2 = s1 ? x.w : x.z, a3 = s1 ? x.z : x.w;
        v4u o; o.x = s2 ? a2 : a0; o.y = s2 ? a3 : a1; o.z = s2 ? a0 : a2; o.w = s2 ? a1 : a3;
        *(GAS v4u*)(j.W8 + (size_t)(j.n0 + nn) * FF + j.kbase + 16 * c) = o; }
}
__device__ __forceinline__ void down_q_items(Frame& F, int set_lo, int set_hi, int xb = 0, int xe = -1) {
    constexpr int PER_SET = 4 * (DM / 32);
    __syncthreads();
    const int slot = (((F.vcu >> 2) & 3) * (F.G >> 2) + (((F.vcu >> 4) << 2) | (F.vcu & 3)));
    const int st0 = xe >= 0 ? xb : set_lo * PER_SET + slot, st1 = xe >= 0 ? xe : set_hi * PER_SET, stp = xe >= 0 ? 1 : F.G;
    f32x4 v[7][4], sx[4]; DqJob cur, nxt; int st = st0; bool has = st < st1;
    if (has) { cur = dq_job(F, st); if (MOE_DOWN_F8) dq_sample_load(F, cur, sx);
        const GAS unsigned char* Wb = dq_base(cur); const unsigned toff = (unsigned)((32 * F.wave + 4 * (F.lane >> 3)) * DM + 4 * (F.lane & 7)) * 4u;
#pragma unroll
        for (int it = 0; it < 7; ++it)
#pragma unroll
            for (int q = 0; q < 4; ++q) v[it][q] = __builtin_nontemporal_load((const GAS f32x4*)(Wb + (size_t)(256 * it + q) * DM * 4 + toff)); }
    while (has) { const int stn = st + stp; const bool hasn = stn < st1; if (hasn) nxt = dq_job(F, stn);
        dq_process(F, cur, v, sx, hasn, nxt, MOE_DOWN_F8);
        cur = nxt; st = stn; has = hasn; }
    __syncthreads();
}
__device__ __forceinline__ void hp_quant(Frame& F, int nrows) {
    const int gw = F.vcu * NWAVES + F.wave, NGW = F.G * NWAVES; unsigned char* wsb = F.wsp();
    const bf16* HP = (const bf16*)(wsb + WS_HP); unsigned char* HQ = wsb + WS_HPQ; float* sah = (float*)(wsb + WS_SAH);
    for (int row = gw; row < nrows; row += NGW) {
        const GAS v4u* src = (const GAS v4u*)(HP + (size_t)row * FF) + F.lane; v4u x[14]; float am = 0.f;
#pragma unroll
        for (int j = 0; j < 14; ++j) x[j] = src[64 * j];
#pragma unroll
        for (int j = 0; j < 14; ++j) { const unsigned a = x[j].x & 0x7fff7fffu, b = x[j].y & 0x7fff7fffu, c = x[j].z & 0x7fff7fffu, d = x[j].w & 0x7fff7fffu;
            am = fmaxf(fmaxf(am, fmaxf(bflo(a), bfhi(a))), fmaxf(fmaxf(bflo(b), bfhi(b)), fmaxf(fmaxf(bflo(c), bfhi(c)), fmaxf(bflo(d), bfhi(d))))); }
        am = wave_max(am); const float iv = am > 0.f ? 127.f / am : 0.f;
        GAS v2u* dst = (GAS v2u*)(HQ + (size_t)row * FF) + F.lane;
#pragma unroll
        for (int j = 0; j < 14; ++j) { const unsigned w[4] = {x[j].x, x[j].y, x[j].z, x[j].w}; unsigned o[2] = {0u, 0u};
#pragma unroll
            for (int q = 0; q < 4; ++q) { const int a = (int)__builtin_rintf(bflo(w[q]) * iv), b = (int)__builtin_rintf(bfhi(w[q]) * iv); o[q >> 1] |= (((unsigned)a & 0xffu) | (((unsigned)b & 0xffu) << 8)) << (16 * (q & 1)); }
            v2u ov; ov.x = o[0]; ov.y = o[1]; dst[64 * j] = ov; }
        if (F.lane == 0) sah[row] = am > 0.f ? am * (1.f / 127.f) : 1.f;
    }
}
constexpr int NS_XHALF = 864 + 1792  , NS_L0IN = INC / 32, NS_PRO = 256  , NS_WIN1 = NS_PRO + 96  , NS_IN_ = 2 * (INC / 32), NS_PG_ = 2 * (DM / 32), NS_P0 = NS_IN_ + NS_PG_ + 2 * (FF / 32), NSTRIP_ALL = NS_IN_ + NS_PG_ + 9 * 2 * (FF / 32);
__device__ __forceinline__ void strip_range(Frame& F, int s0, int s1, int xslot = -1, int xn = 0) {
    __syncthreads();
    const int slot = xn > 0 ? xslot : (s0 > 0 ? (((F.vcu >> 2) & 3) * (F.G >> 2) + (((F.vcu >> 4) << 2) | (F.vcu & 3))) : F.vcu), nsl = xn > 0 ? xn : F.G;
    f32x4 v[8][4]; StripJob cur, nxt; int st = s0 + slot; bool has = st < s1;
    if (has) { cur = strip_job(F, st); strip_load(F, cur, v); }
    while (has) { const int stn = st + nsl; const bool hasn = stn < s1; if (hasn) nxt = strip_job(F, stn);
        strip_quant(F, cur, v, hasn, nxt);
        cur = nxt; st = stn; has = hasn; }
    __syncthreads();
}
__device__ __forceinline__ void p0_prologue(Frame& F) {
    LAS float* scr = (LAS float*)(F.lds + RING_OFF + F.wave * 16384);
    const int gw = F.vcu * NWAVES + F.wave, NGW = F.G * NWAVES;
    constexpr int I_IN = (DM / 64) * (INC / 32), I_SQ = (DM / 64) * (DM / 32), I_PP = (PLED / 64) * (DM / 32), I_GU = (DM / 64) * (FF / 32), I_DN = (FF / 64) * (DM / 32);
    constexpr int IL = I_SQ + I_PP, IFS = I_DN, NITEMS = 2 * IL + 9 * IFS;
    for (int it = gw; it < NITEMS; it += NGW) {
        int r = it;
        if (r < 2 * IL) { const int L = r / IL; r -= L * IL;
            if (r < I_SQ / 2) { p0_transpose_item((const float*)F.ptr(17) + (size_t)L * DM * DM, DM / 2, DM, (bf16*)(F.wsp() + WS_WOUT) + (size_t)L * DM * DM, MAP_ID, scr, r, F.lane, DM); continue; } r -= I_SQ / 2;
            if (r < I_SQ / 2) { p0_transpose_item((const float*)F.ptr(17) + (size_t)L * DM * DM + (size_t)(DM / 2) * DM, DM / 2, DM, (bf16*)(F.wsp() + WS_WOHI) + (size_t)L * DM * (DM / 2), MAP_ID, scr, r, F.lane); continue; } r -= I_SQ / 2;
            p0_transpose_item((const float*)F.ptr(28) + (size_t)L * PLED * DM, PLED, DM, (bf16*)(F.wsp() + WS_WPP) + (size_t)L * DM * PLED, MAP_ID, scr, r, F.lane); continue; }
        r -= 2 * IL;
        const int s = r / IFS; r -= s * IFS;
        if (down_i8_set(s)) continue;
        const float* wd; bf16* dn;
        if (s == 0) { wd = (const float*)F.ptr(21); dn = (bf16*)(F.wsp() + WS_WDD); }
        else { const size_t e = (size_t)(s - 1); wd = (const float*)F.ptr(25) + e * FF * DM; dn = (bf16*)(F.wsp() + WS_WDE) + e * DM * FF; }
        p0_transpose_item(wd, FF, DM, dn, MAP_ID, scr, r, F.lane);
    }
    strip_range(F, 0, NS_PRO, F.vcu, F.G);
    if (!MOE_DOWN_F8) p0_down_amax(F);
    const int gt = F.vcu * (NWAVES * 64) + F.tid, NT = F.G * NWAVES * 64;
    { const GAS f32x4* src = (const GAS f32x4*)F.ptr(1); GAS v2u* dst = (GAS v2u*)(F.wsp() + WS_PBF);
      for (int i0 = gt; i0 < DEPTH * M * PLED / 4; i0 += 8 * NT) { f32x4 v[8];
#pragma unroll
          for (int u = 0; u < 8; ++u) { const int i = i0 + u * NT; v[u] = (f32x4){0.f, 0.f, 0.f, 0.f}; if (i < DEPTH * M * PLED / 4) v[u] = __builtin_nontemporal_load(&src[i]); }
#pragma unroll
          for (int u = 0; u < 8; ++u) { const int i = i0 + u * NT; if (i < DEPTH * M * PLED / 4) { v2u o; o.x = pk2(v[u].x, v[u].y); o.y = pk2(v[u].z, v[u].w); dst[i] = o; } } } }
    { const int* pos = (const int*)F.ptr(2); float* rope = (float*)(F.wsp() + WS_ROPE);
      for (int i = gt; i < M * 8; i += NT) { const int tok = i >> 3, k = i & 7;
          const double inv = k == 0 ? 1.0 : k == 1 ? 0.19388721168191904 : k == 2 ? 0.03759225085361404 : k == 3 ? 0.007288656698743457 : k == 4 ? 0.0014142135623730951 : k == 5 ? 0.0002741979242171174 : k == 6 ? 5.316346907993441e-05 : 1.0307716781164267e-05;
          const double ang = (double)pos[tok] * inv;
          const double qd = __builtin_rint(ang * 0.6366197723675814); const double r = (ang - qd * 1.5707963267948966) - qd * 6.123233995736766e-17; const double r2 = r * r;
          double sp = r2 * (1.0 / 6227020800.0) - (1.0 / 39916800.0); sp = sp * r2 + (1.0 / 362880.0); sp = sp * r2 - (1.0 / 5040.0); sp = sp * r2 + (1.0 / 120.0); sp = sp * r2 - (1.0 / 6.0); const double sr = r + r * r2 * sp;
          double cp = r2 * (1.0 / 479001600.0) - (1.0 / 3628800.0); cp = cp * r2 + (1.0 / 40320.0); cp = cp * r2 - (1.0 / 720.0); cp = cp * r2 + (1.0 / 24.0); cp = cp * r2 - 0.5; const double cr = 1.0 + r2 * cp;
          const int qi = (int)qd & 3; const double cv = qi == 0 ? cr : qi == 1 ? -sr : qi == 2 ? -cr : sr, sv = qi == 0 ? sr : qi == 1 ? cr : qi == 2 ? -sr : -cr;
          rope[tok * 16 + k] = (float)cv; rope[tok * 16 + 8 + k] = (float)sv; } }
    { const float* wpool = (const float*)F.ptr(10); const float* pscale = (const float*)F.ptr(11); const float* wpw = (const float*)F.ptr(16); GAS unsigned* bd = (GAS unsigned*)(F.wsp() + WS_BD);
      for (int i0 = gt; i0 < DEPTH * 1024 * 512; i0 += 8 * NT) { unsigned ov[8];
#pragma unroll
          for (int u = 0; u < 8; ++u) { const int i = i0 + u * NT; const int L = (i >> 19) & 1, kp = (i >> 9) & 1023, j0 = (i & 511) * 2; float v[2];
#pragma unroll
              for (int q = 0; q < 2; ++q) { const int j = j0 + q; float x = 0.f;
                  if (i < DEPTH * 1024 * 512) {
                      if (kp < 512) { const int g = kp >> 7, c = kp & 127; if (j < 512 && (j >> 7) == g) x = wpool[(((size_t)L * 4 + g) * 128 + c) * 128 + (j & 127)] * pscale[L * 512 + j]; }
                      else if (j >= 512) x = wpw[((size_t)L * 512 + (kp - 512)) * 512 + (j - 512)]; }
                  v[q] = x; }
              ov[u] = pk2(v[0], v[1]); }
#pragma unroll
          for (int u = 0; u < 8; ++u) { const int i = i0 + u * NT; if (i < DEPTH * 1024 * 512) bd[i] = ov[u]; } } }
}
__device__ __forceinline__ float quant_row_store(const f32x4 (&y)[8], unsigned char* qrow, int lane) {
    float am = 0.f;
#pragma unroll
    for (int j = 0; j < 8; ++j) am = fmaxf(fmaxf(am, fmaxf(fabsf(y[j].x), fabsf(y[j].y))), fmaxf(fabsf(y[j].z), fabsf(y[j].w)));
    am = wave_max(am); const float iv = am > 0.f ? 127.f / am : 0.f;
    GAS unsigned* o4 = (GAS unsigned*)qrow + lane;
#pragma unroll
    for (int j = 0; j < 8; ++j) o4[64 * j] = q4_i8(y[j].x, y[j].y, y[j].z, y[j].w, iv);
    return am > 0.f ? am * (1.f / 127.f) : 1.f;
}
__device__ __forceinline__ void norm_rows_q(Frame& F, const float* src, const float* gain, unsigned char* Uq, float* sc, int cu = -1, int ncu = 0) {
    const bool contig = ncu == 0 && F.G * NWAVES * 8 == M;
    if (ncu == 0) { cu = F.vcu; ncu = F.G; }
    if (cu < 0) return;
    const int gw = cu * NWAVES + F.wave, NGW = ncu * NWAVES;
    const int m0 = contig ? 8 * gw : gw, mstep = contig ? 1 : NGW, mend = contig ? 8 * gw + 8 : M;
    f32x4 g[8];
#pragma unroll
    for (int j = 0; j < 8; ++j) g[j] = ((const GAS f32x4*)gain)[F.lane + 64 * j];
    f32x4 nv[8];
    if (m0 < mend) { const GAS f32x4* xr = (const GAS f32x4*)(src + (size_t)m0 * DM) + F.lane;
#pragma unroll
        for (int j = 0; j < 8; ++j) nv[j] = xr[64 * j]; }
    for (int m = m0; m < mend; m += mstep) {
        f32x4 v[8]; float s = 0.f;
#pragma unroll
        for (int j = 0; j < 8; ++j) v[j] = nv[j];
        if (m + mstep < mend) { const GAS f32x4* xn = (const GAS f32x4*)(src + (size_t)(m + mstep) * DM) + F.lane;
#pragma unroll
            for (int j = 0; j < 8; ++j) nv[j] = xn[64 * j]; }
#pragma unroll
        for (int j = 0; j < 8; ++j) s += (v[j].x * v[j].x + v[j].y * v[j].y) + (v[j].z * v[j].z + v[j].w * v[j].w);
        const float rstd = 1.f / sqrtf(wave_sum(s) * (1.f / DM) + 1e-6f);
#pragma unroll
        for (int j = 0; j < 8; ++j) v[j] = v[j] * rstd * g[j];
        const float scl = quant_row_store(v, Uq + (size_t)m * DM, F.lane);
        if (F.lane == 0) sc[m] = scl;
    }
}
__device__ __forceinline__ void final_norm(Frame& F, const float* gain) {
    const int gw = F.vcu * NWAVES + F.wave, NGW = F.G * NWAVES; float* outb = F.outp();
    const bool contig = NGW * 8 == M; const int m0 = contig ? 8 * gw : gw, mstep = contig ? 1 : NGW, mend = contig ? 8 * gw + 8 : M;
    f32x4 g[8];
#pragma unroll
    for (int j = 0; j < 8; ++j) g[j] = ((const GAS f32x4*)gain)[F.lane + 64 * j];
    f32x4 nv[8];
    if (m0 < mend) { const GAS f32x4* x0 = (const GAS f32x4*)(outb + (size_t)m0 * DM) + F.lane;
#pragma unroll
        for (int j = 0; j < 8; ++j) nv[j] = x0[64 * j]; }
    for (int m = m0; m < mend; m += mstep) {
        GAS f32x4* xr = (GAS f32x4*)(outb + (size_t)m * DM) + F.lane; f32x4 v[8]; float s = 0.f;
#pragma unroll
        for (int j = 0; j < 8; ++j) v[j] = nv[j];
        if (m + mstep < mend) { const GAS f32x4* xn = (const GAS f32x4*)(outb + (size_t)(m + mstep) * DM) + F.lane;
#pragma unroll
            for (int j = 0; j < 8; ++j) nv[j] = xn[64 * j]; }
#pragma unroll
        for (int j = 0; j < 8; ++j) s += (v[j].x * v[j].x + v[j].y * v[j].y) + (v[j].z * v[j].z + v[j].w * v[j].w);
        const float rstd = 1.f / sqrtf(wave_sum(s) * (1.f / DM) + 1e-6f);
#pragma unroll
        for (int j = 0; j < 8; ++j) xr[64 * j] = v[j] * rstd * g[j];
    }
}
__device__ __forceinline__ void ffn_norm_phase(Frame& F, const float* gain, const float* wrouter, unsigned char* U, bool moe) {
    float* outb = F.outp(); unsigned char* wsb = F.wsp();
    if (!moe) { norm_rows_q(F, outb, gain, U, (float*)(wsb + WS_SAS)); return; }
    LAS float* wl = (LAS float*)(F.lds + RING_OFF);
    LAS int* mo = (LAS int*)(F.lds + MOE_OFF);
    for (int c = F.tid; c < DM; c += NWAVES * 64) { const f32x4 a = ((const GAS f32x4*)wrouter)[2 * c], b = ((const GAS f32x4*)wrouter)[2 * c + 1];
        wl[0 * DM + c] = a.x; wl[1 * DM + c] = a.y; wl[2 * DM + c] = a.z; wl[3 * DM + c] = a.w; wl[4 * DM + c] = b.x; wl[5 * DM + c] = b.y; wl[6 * DM + c] = b.z; wl[7 * DM + c] = b.w; }
    if (F.tid < 8) mo[48 + F.tid] = 0;
    __syncthreads();
    f32x4 g[8];
#pragma unroll
    for (int j = 0; j < 8; ++j) g[j] = ((const GAS f32x4*)gain)[F.lane + 64 * j];
    f32x4 nv[8];
    { const GAS f32x4* x0 = (const GAS f32x4*)(outb + (size_t)(64 * F.vcu + 8 * F.wave) * DM) + F.lane;
#pragma unroll
      for (int j = 0; j < 8; ++j) nv[j] = x0[64 * j]; }
    for (int k = 0; k < 8; ++k) {
        const int m = 64 * F.vcu + 8 * F.wave + k;
        f32x4 v[8]; float s = 0.f;
#pragma unroll
        for (int j = 0; j < 8; ++j) v[j] = nv[j];
        if (k + 1 < 8) { const GAS f32x4* xn = (const GAS f32x4*)(outb + (size_t)(m + 1) * DM) + F.lane;
#pragma unroll
            for (int j = 0; j < 8; ++j) nv[j] = xn[64 * j]; }
#pragma unroll
        for (int j = 0; j < 8; ++j) s += (v[j].x * v[j].x + v[j].y * v[j].y) + (v[j].z * v[j].z + v[j].w * v[j].w);
        const float rstd = 1.f / sqrtf(wave_sum(s) * (1.f / DM) + 1e-6f);
        float lg[8];
#pragma unroll
        for (int e = 0; e < 8; ++e) lg[e] = 0.f;
#pragma unroll
        for (int j = 0; j < 8; ++j) { const f32x4 y = v[j] * rstd * g[j]; v[j] = y;
#pragma unroll
            for (int e = 0; e < 8; ++e) { const f32x4 w = ((const LAS f32x4*)(wl + e * DM))[F.lane + 64 * j]; lg[e] += (y.x * w.x + y.y * w.y) + (y.z * w.z + y.w * w.w); } }
#pragma unroll
        for (int e = 0; e < 8; ++e) lg[e] = wave_sum(lg[e]);
        const float scl = quant_row_store(v, U + (size_t)m * DM, F.lane);
        int i0 = 0; float l0 = lg[0];
#pragma unroll
        for (int e = 1; e < 8; ++e) if (lg[e] > l0) { l0 = lg[e]; i0 = e; }
        int i1 = -1; float l1 = -INFINITY;
#pragma unroll
        for (int e = 0; e < 8; ++e) if (e != i0 && lg[e] > l1) { l1 = lg[e]; i1 = e; }
        const float g0 = 1.f / (1.f + expf(l1 - l0)), g1 = 1.f - g0;
        if (F.lane == 0) { v4u sv; sv.x = (unsigned)i0; sv.y = (unsigned)i1; sv.z = __float_as_uint(g0); sv.w = __float_as_uint(g1); ((GAS v4u*)(wsb + WS_SEL))[m] = sv; ((GAS float*)(wsb + WS_SATOK))[m] = scl;
            atomicAdd((int*)&mo[48 + i0], 1); atomicAdd((int*)&mo[48 + i1], 1); }
    }
    __syncthreads();
    if (F.tid < 8) ((GAS int*)(wsb + WS_HIST))[F.vcu * 8 + F.tid] = mo[48 + F.tid];
}
__device__ __forceinline__ void moe_offsets(Frame& F) {
    LAS int* mo = (LAS int*)(F.lds + MOE_OFF);
    __syncthreads();
    if (F.tid < 48) mo[F.tid] = 0;
    __syncthreads();
    if (F.tid < 256) { const GAS v4i* hp = (const GAS v4i*)(F.wsp() + WS_HIST) + 2 * F.tid; const v4i a = hp[0], b = hp[1]; const int h[8] = {a.x, a.y, a.z, a.w, b.x, b.y, b.z, b.w};
#pragma unroll
        for (int e = 0; e < 8; ++e) { const int t = wave_sum_i(h[e]), p = wave_sum_i(F.tid < F.vcu ? h[e] : 0);
            if (F.lane == 0) { atomicAdd((int*)&mo[32 + e], t); atomicAdd((int*)&mo[16 + e], p); } } }
    __syncthreads();
    if (F.tid == 0) { int t = 0; mo[0] = 0;
#pragma unroll
        for (int e = 0; e < 8; ++e) { t += (mo[32 + e] + 255) >> 8; mo[e + 1] = t; } }
    __syncthreads();
}
__device__ __forceinline__ void moe_permute(Frame& F, const unsigned char* U, unsigned char* XP) {
    moe_offsets(F);
    LAS int* mo = (LAS int*)(F.lds + MOE_OFF);
    LAS int* sl = (LAS int*)(F.lds + RING_OFF);
    unsigned char* wsb = F.wsp();
    if (F.wave == 0) { const int m = 64 * F.vcu + F.lane; const v4u sv = ((const GAS v4u*)(wsb + WS_SEL))[m]; const int e0 = (int)sv.x, e1 = (int)sv.y; int r0 = 0, r1 = 0;
        const unsigned long long lt = (1ull << F.lane) - 1ull;
#pragma unroll
        for (int e = 0; e < 8; ++e) { const unsigned long long both = __ballot(e0 == e) | __ballot(e1 == e); const int before = __popcll(both & lt), base = 256 * mo[e] + mo[16 + e];
            if (e0 == e) r0 = base + before; if (e1 == e) r1 = base + before; }
        sl[2 * F.lane] = r0; sl[2 * F.lane + 1] = r1; ((GAS int*)(wsb + WS_SEL + 512 * 1024))[2 * m] = r0; ((GAS int*)(wsb + WS_SEL + 512 * 1024))[2 * m + 1] = r1; }
    __syncthreads();
    v4u xa[8], xb[8]; float scv[8];
#pragma unroll
    for (int k = 0; k < 8; ++k) { const int m = 64 * F.vcu + 8 * F.wave + k; const GAS v4u* src = (const GAS v4u*)(U + (size_t)m * DM) + F.lane; xa[k] = src[0]; xb[k] = src[64]; scv[k] = ((const GAS float*)(wsb + WS_SATOK))[m]; }
#pragma unroll
    for (int k = 0; k < 8; ++k) { const int t = 8 * F.wave + k; const int s0 = sl[2 * t], s1 = sl[2 * t + 1];
        GAS v4u* d0 = (GAS v4u*)(XP + (size_t)s0 * DM) + F.lane; GAS v4u* d1 = (GAS v4u*)(XP + (size_t)s1 * DM) + F.lane;
        d0[0] = xa[k]; d0[64] = xb[k]; d1[0] = xa[k]; d1[64] = xb[k];
        if (F.lane == 0) { ((GAS float*)(wsb + WS_SAS))[s0] = scv[k]; ((GAS float*)(wsb + WS_SAS))[s1] = scv[k]; } }
}
__device__ __forceinline__ void combine_norm(Frame& F, const bf16* Y, const bf16* YP, const float* gain, unsigned char* U, bool moe, bool sliced) {
    const int gw = F.vcu * NWAVES + F.wave, NGW = F.G * NWAVES; float* outb = F.outp(); unsigned char* wsb = F.wsp();
    f32x4 g[8];
#pragma unroll
    for (int j = 0; j < 8; ++j) g[j] = ((const GAS f32x4*)gain)[F.lane + 64 * j];
    v4u nsv = (v4u){0u, 0u, 0u, 0u}; int ns0 = gw, ns1 = gw;
    if (moe && gw < M) { nsv = ((const GAS v4u*)(wsb + WS_SEL))[gw]; ns0 = ((const GAS int*)(wsb + WS_SEL + 512 * 1024))[2 * gw]; ns1 = ((const GAS int*)(wsb + WS_SEL + 512 * 1024))[2 * gw + 1]; }
    for (int m = gw; m < M; m += NGW) {
        int s0 = m, s1 = m; float g0 = 1.f, g1 = 0.f;
        if (moe) { g0 = __uint_as_float(nsv.z); g1 = __uint_as_float(nsv.w); s0 = ns0; s1 = ns1;
            const int mn = m + NGW; if (mn < M) { nsv = ((const GAS v4u*)(wsb + WS_SEL))[mn]; ns0 = ((const GAS int*)(wsb + WS_SEL + 512 * 1024))[2 * mn]; ns1 = ((const GAS int*)(wsb + WS_SEL + 512 * 1024))[2 * mn + 1]; } }
        GAS f32x4* xr = (GAS f32x4*)(outb + (size_t)m * DM) + F.lane; const GAS v2u* y0 = (const GAS v2u*)(Y + (size_t)s0 * DM) + F.lane; const GAS v2u* y1 = (const GAS v2u*)(Y + (size_t)s1 * DM) + F.lane;
        const bool p0 = sliced && s0 >= 32768, p1 = sliced && s1 >= 32768;
        const GAS v2u* q0 = (const GAS v2u*)(YP + (size_t)(s0 - 32768) * DM) + F.lane; const GAS v2u* q1 = (const GAS v2u*)(YP + (size_t)(s1 - 32768) * DM) + F.lane;
        f32x4 v[8]; v2u ya[8], yb[8]; float s = 0.f;
#pragma unroll
        for (int j = 0; j < 8; ++j) { v[j] = xr[64 * j]; ya[j] = (v2u){0u, 0u}; yb[j] = (v2u){0u, 0u}; }
        if (!p0) {
#pragma unroll
            for (int j = 0; j < 8; ++j) ya[j] = y0[64 * j]; }
        if (moe && !p1) {
#pragma unroll
            for (int j = 0; j < 8; ++j) yb[j] = y1[64 * j]; }
#pragma unroll
        for (int j = 0; j < 8; ++j) { v[j].x += g0 * bflo(ya[j].x); v[j].y += g0 * bfhi(ya[j].x); v[j].z += g0 * bflo(ya[j].y); v[j].w += g0 * bfhi(ya[j].y);
            v[j].x += g1 * bflo(yb[j].x); v[j].y += g1 * bfhi(yb[j].x); v[j].z += g1 * bflo(yb[j].y); v[j].w += g1 * bfhi(yb[j].y); }
        if (p0) {
#pragma unroll
            for (int k = 0; k < 4; ++k)
#pragma unroll
                for (int j = 0; j < 8; ++j) { const v2u a = q0[(size_t)k * (2048 * 2048 / 4) + 64 * j]; v[j].x += g0 * bflo(a.x); v[j].y += g0 * bfhi(a.x); v[j].z += g0 * bflo(a.y); v[j].w += g0 * bfhi(a.y); } }
        if (moe && p1) {
#pragma unroll
            for (int k = 0; k < 4; ++k)
#pragma unroll
                for (int j = 0; j < 8; ++j) { const v2u b = q1[(size_t)k * (2048 * 2048 / 4) + 64 * j]; v[j].x += g1 * bflo(b.x); v[j].y += g1 * bfhi(b.x); v[j].z += g1 * bflo(b.y); v[j].w += g1 * bfhi(b.y); } }
#pragma unroll
        for (int j = 0; j < 8; ++j) { xr[64 * j] = v[j]; s += (v[j].x * v[j].x + v[j].y * v[j].y) + (v[j].z * v[j].z + v[j].w * v[j].w); }
        const float rstd = 1.f / sqrtf(wave_sum(s) * (1.f / DM) + 1e-6f);
#pragma unroll
        for (int j = 0; j < 8; ++j) v[j] = v[j] * rstd * g[j];
        const float scl = quant_row_store(v, U + (size_t)m * DM, F.lane);
        if (F.lane == 0) ((GAS float*)(wsb + WS_SATOK))[m] = scl;
    }
}
__device__ __forceinline__ void unpack8(const v4u x, float (&f)[8]) { f[0] = bflo(x.x); f[1] = bfhi(x.x); f[2] = bflo(x.y); f[3] = bfhi(x.y); f[4] = bflo(x.z); f[5] = bfhi(x.z); f[6] = bflo(x.w); f[7] = bfhi(x.w); }
__device__ __forceinline__ v4u pack8f(const float (&f)[8]) { v4u o; o.x = pk2(f[0], f[1]); o.y = pk2(f[2], f[3]); o.z = pk2(f[4], f[5]); o.w = pk2(f[6], f[7]); return o; }
__device__ __forceinline__ void thin_phase(Frame& F, int L) {
    LAS float* dwl = (LAS float*)(F.lds + RING_OFF);
    { const GAS f32x4* dw = (const GAS f32x4*)((const float*)F.ptr(12) + (size_t)L * 31 * 512); for (int i = F.tid; i < 31 * 512 / 4; i += NWAVES * 64) ((LAS f32x4*)dwl)[i] = dw[i]; }
    const float lam_init = L == 0 ? LAM_INIT0 : LAM_INIT1;
    float lam; { const float a = ((const float*)F.ptr(5))[L * 64 + F.lane] * ((const float*)F.ptr(6))[L * 64 + F.lane], b = ((const float*)F.ptr(7))[L * 64 + F.lane] * ((const float*)F.ptr(8))[L * 64 + F.lane];
        lam = expf(wave_sum(a)) - expf(wave_sum(b)) + lam_init; }
    __syncthreads();
    unsigned char* wsb = F.wsp(); const float* subg = F.inf(9) + L * 128; const float* cbias = F.inf(13) + L * 512; const float* clng = F.inf(14) + L * 512; const float* clnb = F.inf(15) + L * 512;
    const bf16* O0 = (const bf16*)(wsb + WS_O0); const bf16* O1 = (const bf16*)(wsb + WS_O1); const bf16* ZP = (const bf16*)(wsb + WS_ZP); const bf16* CG = (const bf16*)(wsb + WS_CG);
    bf16* CAT = (bf16*)(wsb + WS_CAT);
    const int lane = F.lane;
    for (int task = F.vcu * NWAVES + F.wave; task < M / 8; task += F.G * NWAVES) {
        const int T0 = task * 8, s0 = T0 & (SEQ - 1);
        { const int col = (lane >> 3) * 128 + (lane & 7) * 16; float gn[16];
#pragma unroll
          for (int q = 0; q < 4; ++q) { const f32x4 t = ((const GAS f32x4*)(subg + (lane & 7) * 16))[q]; gn[4 * q] = t.x; gn[4 * q + 1] = t.y; gn[4 * q + 2] = t.z; gn[4 * q + 3] = t.w; }
          v4u A0[8], A1[8], B0[8], B1[8];
#pragma unroll
          for (int tt = 0; tt < 8; ++tt) { const size_t ro = (size_t)(T0 + tt) * 1024 + col; A0[tt] = *(const GAS v4u*)(O0 + ro); A1[tt] = *(const GAS v4u*)(O0 + ro + 8); B0[tt] = *(const GAS v4u*)(O1 + ro); B1[tt] = *(const GAS v4u*)(O1 + ro + 8); }
#pragma unroll
          for (int tt = 0; tt < 8; ++tt) { const v4u a0 = A0[tt], a1 = A1[tt], b0 = B0[tt], b1 = B1[tt];
              float x0[8], x1[8], y0[8], y1[8]; unpack8(a0, x0); unpack8(a1, x1); unpack8(b0, y0); unpack8(b1, y1); float ss = 0.f;
#pragma unroll
              for (int q = 0; q < 8; ++q) { x0[q] -= lam * y0[q]; x1[q] -= lam * y1[q]; ss += x0[q] * x0[q] + x1[q] * x1[q]; }
              ss = row8_sum(ss);
              const float r = (1.f - lam_init) / sqrtf(ss * (1.f / 128.f) + 1e-5f);
#pragma unroll
              for (int q = 0; q < 8; ++q) { x0[q] *= r * gn[q]; x1[q] *= r * gn[8 + q]; }
              GAS v4u* o = (GAS v4u*)(CAT + (size_t)(T0 + tt) * 2048 + col); o[0] = pack8f(x0); o[1] = pack8f(x1); } }
        { const int w = 2 << (lane >> 4); float S[8];
#pragma unroll
          for (int q = 0; q < 8; ++q) S[q] = 0.f;
          v4u pre[15], slf[8], tl[8];
#pragma unroll
          for (int j = 1; j < 16; ++j) { pre[j - 1] = (v4u){0u, 0u, 0u, 0u}; if (j < w && s0 - j >= 0) pre[j - 1] = *(const GAS v4u*)(ZP + (size_t)(T0 - j) * 512 + 8 * lane); }
#pragma unroll
          for (int tt = 0; tt < 8; ++tt) { slf[tt] = *(const GAS v4u*)(ZP + (size_t)(T0 + tt) * 512 + 8 * lane); tl[tt] = (v4u){0u, 0u, 0u, 0u}; if (s0 + tt - w + 1 >= 0) tl[tt] = *(const GAS v4u*)(ZP + (size_t)(T0 + tt - w + 1) * 512 + 8 * lane); }
#pragma unroll
          for (int j = 0; j < 15; ++j) { float f[8]; unpack8(pre[j], f);
#pragma unroll
              for (int q = 0; q < 8; ++q) S[q] += f[q]; }
#pragma unroll
          for (int tt = 0; tt < 8; ++tt) { float self[8], o[8], f[8]; unpack8(slf[tt], self); unpack8(tl[tt], f);
              const int cnt = (s0 + tt + 1) < w ? (s0 + tt + 1) : w; const float ic = 1.f / (float)cnt;
#pragma unroll
              for (int q = 0; q < 8; ++q) { S[q] += self[q]; o[q] = S[q] * ic - self[q]; S[q] -= f[q]; }
              *(GAS v4u*)(CAT + (size_t)(T0 + tt) * 2048 + 1024 + 8 * lane) = pack8f(o); } }
        { f32x4 aA[8], aB[8];
#pragma unroll
          for (int tt = 0; tt < 8; ++tt) { aA[tt] = (f32x4){0.f, 0.f, 0.f, 0.f}; aB[tt] = (f32x4){0.f, 0.f, 0.f, 0.f}; }
          v4u xq[8], xn[8];
#pragma unroll
          for (int q = 0; q < 8; ++q) { xq[q] = (v4u){0u, 0u, 0u, 0u}; if (s0 - 30 + q >= 0) xq[q] = *(const GAS v4u*)(CG + (size_t)(T0 - 30 + q) * 512 + 8 * lane); }
#pragma unroll 1
          for (int c = 0; c < 5; ++c) {
#pragma unroll
              for (int q = 0; q < 8; ++q) { const int rr = 8 * (c + 1) + q; xn[q] = (v4u){0u, 0u, 0u, 0u}; if (rr < 38 && s0 - 30 + rr >= 0) xn[q] = *(const GAS v4u*)(CG + (size_t)(T0 - 30 + rr) * 512 + 8 * lane); }
              f32x4 fa[8], fb[8];
#pragma unroll
              for (int q = 0; q < 8; ++q) { float f[8]; unpack8(xq[q], f); fa[q] = (f32x4){f[0], f[1], f[2], f[3]}; fb[q] = (f32x4){f[4], f[5], f[6], f[7]}; }
#pragma unroll
              for (int dj = -7; dj <= 7; ++dj) { const int j = 8 * c + dj;
                  if (j >= 0 && j <= 30) { const LAS f32x4* wp = (const LAS f32x4*)(dwl + j * 512 + 8 * lane); const f32x4 w0 = wp[0], w1 = wp[1];
#pragma unroll
                      for (int tt = 0; tt < 8; ++tt) { const int q = dj + tt; if (q >= 0 && q < 8) { aA[tt] += w0 * fa[q]; aB[tt] += w1 * fb[q]; } } } }
#pragma unroll
              for (int q = 0; q < 8; ++q) xq[q] = xn[q]; }
          const GAS f32x4* bp = (const GAS f32x4*)(cbias + 8 * lane); const GAS f32x4* gp = (const GAS f32x4*)(clng + 8 * lane); const GAS f32x4* lp = (const GAS f32x4*)(clnb + 8 * lane);
          const f32x4 bA = bp[0], bB = bp[1], gA = gp[0], gB = gp[1], lA = lp[0], lB = lp[1];
#pragma unroll
          for (int tt = 0; tt < 8; ++tt) { f32x4 vA = aA[tt] + bA, vB = aB[tt] + bB;
              const float mean = wave_sum((vA.x + vA.y) + (vA.z + vA.w) + (vB.x + vB.y) + (vB.z + vB.w)) * (1.f / 512.f); vA = vA - mean; vB = vB - mean;
              const float var = wave_sum((vA.x * vA.x + vA.y * vA.y) + (vA.z * vA.z + vA.w * vA.w) + (vB.x * vB.x + vB.y * vB.y) + (vB.z * vB.z + vB.w * vB.w)) * (1.f / 512.f);
              const float rs = 1.f / sqrtf(var + 1e-5f); vA = vA * rs * gA + lA; vB = vB * rs * gB + lB; float o[8] = {vA.x, vA.y, vA.z, vA.w, vB.x, vB.y, vB.z, vB.w};
#pragma unroll
              for (int q = 0; q < 8; ++q) o[q] = o[q] * sigm(o[q]);
              *(GAS v4u*)(CAT + (size_t)(T0 + tt) * 2048 + 1536 + 8 * lane) = pack8f(o); } }
    }
}

struct Args { const void* in[30]; float* out; unsigned char* ws; int ph_lo, ph_hi, li, pad; };
__global__ void __launch_bounds__(NWAVES * 64, 2) mk_fwd(Args args) {
    extern __shared__ __attribute__((aligned(16))) unsigned char lds[];
    LAS unsigned char* const L3 = (LAS unsigned char*)lds;
    const int wave_s = __builtin_amdgcn_readfirstlane((int)threadIdx.x >> 6);
    for (int u = threadIdx.x; u < (LDS_BYTES - LDSCTL_OFF) / 4; u += NWAVES * 64) ((LAS unsigned*)(L3 + LDSCTL_OFF))[u] = 0u;
    __syncthreads();
    if (threadIdx.x == 0) { LAS unsigned long long* t = (LAS unsigned long long*)(L3 + PTR_OFF);
#pragma unroll
        for (int i = 0; i < 30; ++i) t[i] = (unsigned long long)args.in[i];
        t[30] = (unsigned long long)args.out; t[31] = (unsigned long long)args.ws; }
    __syncthreads();
    if (N_LAUNCHES == 1) { const Frame F0 = make_frame(L3, wave_s); (void)xcd_barrier_post((unsigned*)(F0.wsp() + WS_CTL) + CW_BAR, (volatile LAS unsigned*)(L3 + MISC_OFF) + 8); }
#define GRID_BAR() do { if (N_LAUNCHES == 1) { const Frame Fb = make_frame(L3, wave_s); XcdBarrier bar; bar.bar = (unsigned*)(Fb.wsp() + WS_CTL) + CW_BAR; bar.x = xb_xcc_id(); bar.st = (volatile LAS unsigned*)(L3 + MISC_OFF) + 8; xcd_barrier(bar, Fb.tid == 0); } } while (0)
    const int lo = (N_LAUNCHES == 1) ? 0 : args.ph_lo, hi = (N_LAUNCHES == 1) ? N_PHASES : args.ph_hi;
#define IN(k) (lo <= (k) && (k) < hi)
#define F_G_IS(n) ((int)gridDim.x == (n))
#define SEAM(k) do { if (IN(k) && IN((k) + 1)) GRID_BAR(); } while (0)
#ifndef PROBE_DUP
#define PROBE_DUP 0
#endif
#define DUP_BEGIN(b) _Pragma("unroll 1") for (int rep_ = 0; rep_ < (((PROBE_DUP >> (b)) & 1) ? 2 : 1); ++rep_) {
#define DUP_END(b) if (rep_ + 1 < (((PROBE_DUP >> (b)) & 1) ? 2 : 1)) GRID_BAR(); }

    DUP_BEGIN(0) if (IN(0)) { Frame F = make_frame(L3, wave_s); p0_prologue(F); } DUP_END(0)
    SEAM(0);

#pragma unroll 1
    for (int L = 0; L < DEPTH; ++L) {
        const int pb = 1 + 13 * L; const bool moe = (L & 1) != 0; constexpr bool ALL_F8 = (DOWN_I8 == 3u) && MOE_DOWN_F8;
        const bool dq = ALL_F8 ? true : ((DOWN_I8 >> L) & 1u) != 0u; const bool f8 = ALL_F8 ? true : (dq && MOE_DOWN_F8);
        DUP_BEGIN(6) if (IN(pb + 0)) { Frame F = make_frame(L3, wave_s); unsigned char* ws = F.wsp(); if (L == 0 && F.G > 64) norm_rows_q(F, F.inf(0), F.inf(3), (unsigned char*)(ws + WS_U), (float*)(ws + WS_SATOK), (int)blockIdx.x - 64, F.G - 64);
            else norm_rows_q(F, L == 0 ? F.inf(0) : (const float*)F.outp(), F.inf(3) + L * DM, (unsigned char*)(ws + WS_U), (float*)(ws + WS_SATOK)); } DUP_END(6)
        if (IN(pb + 0) && L == 0) { Frame F = make_frame(L3, wave_s); unsigned char* ws = F.wsp();
            pg8::Gemm g{(const bf16*)(ws + WS_WOHI), (const bf16*)(ws + WS_BD), 2 * DM, 1024, 1024, (size_t)1024 * 1024 * 2}; pg8::GOrder S; S.init(16, 4, F.G, (int)blockIdx.x); S.ts[1] = 8;
            pg8::EpiBf16<0> E{(bf16*)(ws + WS_WOUT) + 1024, DM, nullptr, 0, 0, 1.f};
            pg8::gemm_phase<pg8::EpiBf16<0>, pg8::GOrder, PG8_ALIGN, PG8_SP2>(F.lds + RING_OFF, g, S, E, F.tid);
        }
        SEAM(pb + 0);
        DUP_BEGIN(1) if (IN(pb + 1)) { Frame F = make_frame(L3, wave_s); unsigned char* ws = F.wsp();
            pg8::Gemm g{(const bf16*)(ws + WS_U), (const bf16*)(ws + WS_WIN + (size_t)L * INC * DM), M, INC, DM / 2, 0};   pg8::GOrder S; S.init(M / 256, INC / 256, F.G, (int)blockIdx.x);
            pg8::EpiIn E{(bf16*)(ws + WS_Q), (bf16*)(ws + WS_K), (bf16*)(ws + WS_V), (bf16*)(ws + WS_ZP), (bf16*)(ws + WS_CG), (const float*)(ws + WS_ROPE), attn_body::C2, (const float*)(ws + WS_SATOK), (const float*)(ws + WS_SWIN) + L * INC};
            pg8::gemm_phase<pg8::EpiIn, pg8::GOrder, PG8_ALIGN, PG8_SP2, 1>(F.lds + RING_OFF, g, S, E, F.tid);
        } DUP_END(1)
        if (IN(pb + 1)) {
            { Frame F = make_frame(L3, wave_s); unsigned char* ws = F.wsp();
              pg8::Gemm g{(const bf16*)(ws + WS_PBF) + (size_t)L * M * PLED, (const bf16*)(ws + WS_WPP) + (size_t)L * DM * PLED, M, DM, PLED, 0}; pg8::GOrder S; S.init(M / 512, DM / 256, F.G / 2, (int)blockIdx.x - F.G / 2);
              pg8::EpiBf16<0> E{(bf16*)(ws + WS_PP), DM, nullptr, 0, 0, 1.f};
              pg8::gemm_phase<pg8::EpiBf16<0>, pg8::GOrder, PG8_ALIGN, PG8_SP2>(F.lds + RING_OFF, g, S, E, F.tid); }
            if (L == 0 && F_G_IS(256)) { const int j = (int)blockIdx.x - 128;
                if (j >= 0 && j < NS_WIN1 - NS_PRO) { Frame F = make_frame(L3, wave_s); strip_range(F, NS_PRO, NS_WIN1, j, NS_WIN1 - NS_PRO); } }
        }
        SEAM(pb + 1);
        DUP_BEGIN(2) if (IN(pb + 2)) {
          const int grp = (int)((blockIdx.x >> 5) & 3u);
#pragma unroll 1
          for (int seg = 0; seg < 4; ++seg) {
            if (seg == grp) { Frame F = make_frame(L3, wave_s);
                if (L == 0) { strip_range(F, NS_WIN1, NS_XHALF); down_q_items(F, 0, 1); }
                else { strip_range(F, NS_XHALF, NSTRIP_ALL); down_q_items(F, 1, 9, 0, -1); } }
            Frame F = make_frame(L3, wave_s); unsigned char* ws = F.wsp();
            const attn_body::AttnTensors AT{(const attn_body::bf16*)(ws + WS_Q), (const attn_body::bf16*)(ws + WS_K), (const attn_body::bf16*)(ws + WS_V), (attn_body::bf16*)(ws + WS_O0), (attn_body::bf16*)(ws + WS_O1)};
            attn_body::attn_phase<8>((char*)(F.lds + RING_OFF), AT, F.vcu, F.G, F.tid, seg, seg + 1);
            __syncthreads();
          }
        } DUP_END(2)
        SEAM(pb + 2);
        DUP_BEGIN(3) if (IN(pb + 3)) { Frame F = make_frame(L3, wave_s); thin_phase(F, L); } DUP_END(3)
        SEAM(pb + 3);
        if (IN(pb + 5)) {
            { Frame F = make_frame(L3, wave_s); unsigned char* ws = F.wsp();
              pg8::Gemm g{(const bf16*)(ws + WS_CAT), (const bf16*)(ws + WS_WOUT) + (size_t)L * DM * DM, M, DM, DM, 0}; pg8::GOrder S; S.init(M / 256, DM / 256, F.G, (int)blockIdx.x);
              pg8::EpiRes E{L == 0 ? F.inf(0) : (const float*)F.outp(), F.outp()};
              pg8::gemm_phase<pg8::EpiRes, pg8::GOrder, PG8_ALIGN, PG8_SP2>(F.lds + RING_OFF, g, S, E, F.tid); }
            { Frame F = make_frame(L3, wave_s); unsigned char* ws = F.wsp();
              pg8::Gemm g{(const bf16*)(ws + WS_PBF) + (size_t)L * M * PLED + (size_t)(M / 2) * PLED, (const bf16*)(ws + WS_WPP) + (size_t)L * DM * PLED, M / 2, DM, PLED, 0}; pg8::GOrder S; S.init(M / 512, DM / 256, F.G, (int)blockIdx.x);
              pg8::EpiBf16<0> E{(bf16*)(ws + WS_PP) + (size_t)(M / 2) * DM, DM, nullptr, 0, 0, 1.f};
              pg8::gemm_phase<pg8::EpiBf16<0>, pg8::GOrder, PG8_ALIGN, PG8_SP2>(F.lds + RING_OFF, g, S, E, F.tid); }
        }
        SEAM(pb + 5);
        DUP_BEGIN(6) if (IN(pb + 6)) { Frame F = make_frame(L3, wave_s); ffn_norm_phase(F, F.inf(18) + L * DM, F.inf(22), (unsigned char*)(F.wsp() + WS_U), moe); } DUP_END(6)
        SEAM(pb + 6);
        DUP_BEGIN(9) if (IN(pb + 7)) { if (moe) { Frame F = make_frame(L3, wave_s); unsigned char* ws = F.wsp(); moe_permute(F, (const unsigned char*)(ws + WS_U), (unsigned char*)(ws + WS_XP)); } } DUP_END(9)
        if (moe) SEAM(pb + 7);
        DUP_BEGIN(4) if (IN(pb + 8)) {
          if (moe && N_LAUNCHES != 1) { Frame F = make_frame(L3, wave_s); moe_offsets(F); }
          const int nseg = 1, grp = (int)((blockIdx.x >> 3) & 1u);
#pragma unroll 1
          for (int seg = 0; seg < 2; ++seg) {
            if (seg == grp) { Frame F = make_frame(L3, wave_s);
                if (false) { }
                }
            if (seg >= nseg) continue;
            Frame F = make_frame(L3, wave_s);
            pg8::GOrder S; pg8::Gemm g;
            if (moe) { unsigned char* ws = F.wsp(); LAS int* mo = (LAS int*)(F.lds + MOE_OFF); S.init(__builtin_amdgcn_readfirstlane(mo[8]), FF / 128, F.G, (int)blockIdx.x);
#pragma unroll
                for (int e = 1; e < 9; ++e) S.ts[e] = __builtin_amdgcn_readfirstlane(mo[e]);
                g = pg8::Gemm{(const bf16*)(ws + WS_XP), (const bf16*)(ws + WS_WGUE), MAXSLOT, 2 * FF, DM / 2, (size_t)2 * FF * DM}; }
            else { unsigned char* ws = F.wsp(); S.init(M / 256, FF / 128, F.G, (int)blockIdx.x); g = pg8::Gemm{(const bf16*)(ws + WS_U), (const bf16*)(ws + WS_WGUD), M, 2 * FF, DM / 2, 0}; }
            { const int R = (S.nwg + F.G - 1) / F.G; S.r0 = seg * R / nseg; if (seg + 1 < nseg) S.r1 = (seg + 1) * R / nseg; }
            unsigned char* ws2 = F.wsp();
            if (f8) { pg8::EpiSwigluI8<true> E{(bf16*)(ws2 + WS_HPQ), FF, (const float*)(ws2 + WS_SAS), (const float*)(ws2 + WS_SWGU) + (moe ? 2 * FF : 0)};
                pg8::gemm_phase<pg8::EpiSwigluI8<true>, pg8::GOrder, PG8_ALIGN, PG8_SP2, 1>(F.lds + RING_OFF, g, S, E, F.tid); }
            else { pg8::EpiSwigluI8<false> E{(bf16*)(ws2 + WS_HP), FF, (const float*)(ws2 + WS_SAS), (const float*)(ws2 + WS_SWGU) + (moe ? 2 * FF : 0)};
                pg8::gemm_phase<pg8::EpiSwigluI8<false>, pg8::GOrder, PG8_ALIGN, PG8_SP2, 1>(F.lds + RING_OFF, g, S, E, F.tid); }
          }
        } DUP_END(4)
        SEAM(pb + 8);
        DUP_BEGIN(10) if (IN(pb + 9)) { if (dq && !f8) { Frame F = make_frame(L3, wave_s); int nrows = M; if (moe) { moe_offsets(F); nrows = 256 * __builtin_amdgcn_readfirstlane(((LAS int*)(F.lds + MOE_OFF))[8]); } hp_quant(F, nrows); } } DUP_END(10)
        if (dq && !f8) SEAM(pb + 9);
        DUP_BEGIN(5) if (IN(pb + 10)) {
          {
            Frame F = make_frame(L3, wave_s);
            pg8::GOrder S; pg8::Gemm g; const size_t kb = dq ? 1 : 2;
            if (moe) { if (N_LAUNCHES != 1) moe_offsets(F); unsigned char* ws = F.wsp(); LAS int* mo = (LAS int*)(F.lds + MOE_OFF); S.init(__builtin_amdgcn_readfirstlane(mo[8]), DM / 256, F.G, (int)blockIdx.x);
#pragma unroll
                for (int e = 1; e < 9; ++e) S.ts[e] = __builtin_amdgcn_readfirstlane(mo[e]);
                g = pg8::Gemm{(const bf16*)(ws + (dq ? WS_HPQ : WS_HP)), (const bf16*)(ws + WS_WDE), MAXSLOT, DM, dq ? FF / 2 : FF, (size_t)DM * FF * kb}; }
            else { unsigned char* ws = F.wsp(); S.init(M / 256, DM / 256, F.G, (int)blockIdx.x); g = pg8::Gemm{(const bf16*)(ws + (dq ? WS_HPQ : WS_HP)), (const bf16*)(ws + WS_WDD), M, DM, dq ? FF / 2 : FF, 0}; }
            unsigned char* ws2 = F.wsp();
            if (f8) { const int nrt = S.nM;
                if (moe && nrt > 128) { S.nM = 128; S.nwg = 128 * S.nN; }
                pg8::EpiScaleBf16 E{(bf16*)(ws2 + WS_Y), DM, (const float*)(ws2 + WS_SWD) + (moe ? DM : 0), 0};
                pg8::gemm_phase<pg8::EpiScaleBf16, pg8::GOrder, PG8_ALIGN, PG8_SP2, 2>(F.lds + RING_OFF, g, S, E, F.tid);
                if (moe && nrt > 128) { pg8::SliceOrder S2; S2.nitems = (nrt - 128) * 32; S2.c = (int)blockIdx.x; S2.pm0 = 128;
#pragma unroll
                    for (int e = 0; e < 9; ++e) S2.ts[e] = S.ts[e];
                    pg8::Gemm g2 = g; g2.K = FF / 8; g2.ldk = FF / 2; g2.kslice = FF / 4;
                    pg8::EpiScaleBf16 E2{(bf16*)(ws2 + WS_HP) - (size_t)32768 * DM, DM, (const float*)(ws2 + WS_SWD) + DM, (size_t)2048 * 2048};
                    pg8::gemm_phase<pg8::EpiScaleBf16, pg8::SliceOrder, PG8_ALIGN, PG8_SP2, 2>(F.lds + RING_OFF, g2, S2, E2, F.tid); } }
            else             if (dq) { const int nrt = S.nM;
                if (moe && nrt > 128) { S.nM = 128; S.nwg = 128 * S.nN; }
                pg8::EpiDqBf16 E{(bf16*)(ws2 + WS_Y), DM, (const float*)(ws2 + WS_SAH), (const float*)(ws2 + WS_SWD) + (moe ? DM : 0), 0};
                pg8::gemm_phase<pg8::EpiDqBf16, pg8::GOrder, PG8_ALIGN, PG8_SP2, 1>(F.lds + RING_OFF, g, S, E, F.tid);
                if (moe && nrt > 128) { pg8::SliceOrder S2; S2.nitems = (nrt - 128) * 32; S2.c = (int)blockIdx.x; S2.pm0 = 128;
#pragma unroll
                    for (int e = 0; e < 9; ++e) S2.ts[e] = S.ts[e];
                    pg8::Gemm g2 = g; g2.K = FF / 8; g2.ldk = FF / 2; g2.kslice = FF / 4;
                    pg8::EpiDqBf16 E2{(bf16*)(ws2 + WS_HP) - (size_t)32768 * DM, DM, (const float*)(ws2 + WS_SAH), (const float*)(ws2 + WS_SWD) + DM, (size_t)2048 * 2048};
                    pg8::gemm_phase<pg8::EpiDqBf16, pg8::SliceOrder, PG8_ALIGN, PG8_SP2, 1>(F.lds + RING_OFF, g2, S2, E2, F.tid); } }
            else { pg8::EpiBf16<0> E{(bf16*)(ws2 + WS_Y), DM, nullptr, 0, 0, 1.f};
                pg8::gemm_phase<pg8::EpiBf16<0>, pg8::GOrder, PG8_ALIGN, PG8_SP2>(F.lds + RING_OFF, g, S, E, F.tid); }
          }
        } DUP_END(5)
        SEAM(pb + 10);
        if (IN(pb + 11)) { Frame F = make_frame(L3, wave_s); unsigned char* ws = F.wsp(); combine_norm(F, (const bf16*)(ws + WS_Y), (const bf16*)(ws + WS_HP), F.inf(26) + L * DM, (unsigned char*)(ws + WS_U), moe, moe && dq); }
        SEAM(pb + 11);
        if (IN(pb + 12)) { Frame F = make_frame(L3, wave_s); unsigned char* ws = F.wsp();
            pg8::Gemm g{(const bf16*)(ws + WS_U), (const bf16*)(ws + WS_WPG + (size_t)L * DM * DM), M, DM, DM / 2, 0};   pg8::GOrder S; S.init(M / 256, DM / 256, F.G, (int)blockIdx.x);
            pg8::EpiPle E{F.outp(), (const bf16*)(ws + WS_PP), (const float*)(ws + WS_SATOK), (const float*)(ws + WS_SWPG) + L * DM};
            pg8::gemm_phase<pg8::EpiPle, pg8::GOrder, PG8_ALIGN, PG8_SP2, 1>(F.lds + RING_OFF, g, S, E, F.tid);
        }
        SEAM(pb + 12);
    }
    if (IN(27)) { Frame F = make_frame(L3, wave_s); final_norm(F, F.inf(29)); }
#undef IN
#undef F_G_IS
#undef SEAM
#undef GRID_BAR
#undef DUP_BEGIN
#undef DUP_END
}

extern "C" void kernel_launch(void* const* d_in, const int* in_sizes, int n_in, void* d_out, int out_size, void* d_ws, size_t ws_size, hipStream_t stream) {
    static int grid = 0;
    if (grid == 0) {
        if (n_in != 30 || in_sizes[0] != M * DM || out_size != M * DM || ws_size < WS_END) { fprintf(stderr, "kernel_launch: shape/workspace mismatch (n_in %d, ws %zu < %zu); nothing launched\n", n_in, ws_size, (size_t)WS_END); grid = -1; return; }
        int dev = 0, cus = 0;
        if (hipGetDevice(&dev) != hipSuccess || hipDeviceGetAttribute(&cus, hipDeviceAttributeMultiprocessorCount, dev) != hipSuccess) { grid = -1; return; }
        if (hipFuncSetAttribute((const void*)mk_fwd, hipFuncAttributeMaxDynamicSharedMemorySize, LDS_BYTES) != hipSuccess) { fprintf(stderr, "kernel_launch: hipFuncSetAttribute failed\n"); grid = -1; return; }
        int per_cu = 0;
        if (hipOccupancyMaxActiveBlocksPerMultiprocessor(&per_cu, (const void*)mk_fwd, NWAVES * 64, LDS_BYTES) != hipSuccess || per_cu < 1) fprintf(stderr, "kernel_launch: note: occupancy query reports %d workgroups per CU\n", per_cu);
        (void)hipGetLastError();
        grid = cus;
        if (grid != 256) { fprintf(stderr, "kernel_launch: this kernel is dealt for 256 CUs, device has %d; nothing launched\n", cus); grid = -1; return; }
    }
    if (grid < 0) return;
    if (hipMemsetAsync((char*)d_ws + WS_CTL, 0, CTL_ZERO_BYTES, stream) != hipSuccess) return;
    Args a{};
    for (int i = 0; i < 30; ++i) a.in[i] = d_in[i];
    a.out = (float*)d_out; a.ws = (unsigned char*)d_ws; a.pad = 0;
    for (int li = 0; li < N_LAUNCHES; ++li) {
        a.ph_lo = (N_LAUNCHES == 1) ? 0 : li; a.ph_hi = (N_LAUNCHES == 1) ? N_PHASES : li + 1; a.li = li;
        hipLaunchKernelGGL(mk_fwd, dim3(grid), dim3(NWAVES * 64), LDS_BYTES, stream, a);
        if (hipPeekAtLastError() != hipSuccess) break;
    }
}
```

```cpp
#include <hip/hip_runtime.h>
#include <cstdio>
#include <cstdint>
namespace pg8 {
#define PG8_LAS __attribute__((address_space(3)))
typedef unsigned short bf16_t;
typedef short bf16x8 __attribute__((ext_vector_type(8)));
typedef float f32x4 __attribute__((ext_vector_type(4)));
typedef unsigned u32x4 __attribute__((ext_vector_type(4)));
typedef int i32x4 __attribute__((ext_vector_type(4)));
typedef int i32x8 __attribute__((ext_vector_type(8)));
template <int MODE> struct AccT { typedef f32x4 type; }; template <> struct AccT<1> { typedef i32x4 type; };
constexpr int BM = 256, BK = 64, HALF = 128, HTB = HALF * BK * 2  , STAGE_BYTES = 8 * HTB, NXCD = 8, WGM = 4;

__host__ __device__ __forceinline__ int lds_byte(int r, int c) { const int st = (r >> 4) * 2 + (c >> 5), rr = r & 15, cc = c & 31, ob = rr * 64 + cc * 2; return st * 1024 + (ob ^ (((ob >> 9) & 1) << 5)); }
__host__ __device__ __forceinline__ void stage_rc(int b, int& R, int& C) { const int st = b / 1024, sb = b % 1024, swz = sb ^ (((sb >> 9) & 1) << 5); R = (st >> 1) * 16 + swz / 64; C = (st & 1) * 32 + (swz % 64) / 2; }
__host__ __device__ __forceinline__ int perm32(int rho) { const int n = rho >> 4, i = rho & 15; return 8 * (i >> 2) + 4 * n + (i & 3); }

struct Unit { int pm, pn, eb, ks; };
struct Gemm { const bf16_t* A; const bf16_t* Bt; int M, N, K; size_t bstride; int ldk; size_t kslice; };

struct GOrder {
    int nM, nN, nwg, G, c; int ts[9]; int r0, r1; unsigned mnig;
    __device__ __forceinline__ void init(int nM_, int nN_, int G_, int c_) { nM = nM_; nN = nN_; nwg = nM * nN; G = G_; c = c_; ts[0] = 0; r0 = 0; r1 = 0x3fffffff; mnig = ((1u << 24) + (unsigned)(WGM * nN_) - 1u) / (unsigned)(WGM * nN_);
#pragma unroll
        for (int e = 1; e < 9; ++e) ts[e] = nM_; }
    __device__ __forceinline__ bool next(int i, Unit& u) const {
        if (i + r0 >= r1) return false;
        const int L = (i + r0) * G + c; if (c < 0 || L >= nwg) return false;
        unsigned wgid = (unsigned)L; { const unsigned q = (unsigned)nwg >> 3, r = (unsigned)nwg & 7u, xcd = wgid & 7u, off = wgid >> 3; wgid = (xcd < r ? xcd * (q + 1) : r * (q + 1) + (xcd - r) * q) + off; }
        const unsigned nig = (unsigned)(WGM * nN), gid = (wgid * mnig) >> 24, rem = wgid - gid * nig, fm = gid * WGM;
        const unsigned left = (unsigned)nM - fm, gsz = left < (unsigned)WGM ? left : (unsigned)WGM;
        const unsigned m16 = gsz == 1u ? 65536u : gsz == 2u ? 32768u : gsz == 3u ? 21846u : 16384u, pnn = (rem * m16) >> 16;
        u.pm = (int)(fm + (rem - pnn * gsz)); u.pn = (int)pnn;
        int e = 0;
#pragma unroll
        for (int k = 1; k < 8; ++k) e += (u.pm >= ts[k]) ? 1 : 0;
        u.eb = e; u.ks = 0; return true;
    }
    __device__ __forceinline__ void a_ready(const Unit&) const {}
    __device__ __forceinline__ void done(const Unit&) const {}
};

struct SliceOrder {
    int nitems, c, pm0; int ts[9];
    __device__ __forceinline__ bool next(int i, Unit& u) const {
        if (i > 0 || c >= nitems) return false;
        const int unit = c >> 2; u.ks = c & 3; u.pn = unit & 7; u.pm = pm0 + (unit >> 3);
        int e = 0;
#pragma unroll
        for (int k = 1; k < 8; ++k) e += (u.pm >= ts[k]) ? 1 : 0;
        u.eb = e; return true;
    }
    __device__ __forceinline__ void a_ready(const Unit&) const {}
    __device__ __forceinline__ void done(const Unit&) const {}
};
__device__ __forceinline__ unsigned cvt_pk_bf16(float lo, float hi) { unsigned r; asm volatile("v_cvt_pk_bf16_f32 %0, %1, %2" : "=v"(r) : "v"(lo), "v"(hi)); return r; }
typedef float f32x2 __attribute__((ext_vector_type(2)));
__device__ __forceinline__ f32x2 gelu_pk(f32x2 v) {
    const f32x2 av = __builtin_elementwise_abs(v), d = av * 0.2316418882f + 1.0f;
    f32x2 t; t.x = __builtin_amdgcn_rcpf(d.x); t.y = __builtin_amdgcn_rcpf(d.y);
    f32x2 q = t * 0.5307027145f + (-0.7265760135f); q = q * t + 0.7107068705f; q = q * t + (-0.142248368f); q = q * t + 0.127414796f; q = q * t;
    const f32x2 s = (v * v) * (-0.72134752044f);
    f32x2 e; e.x = __builtin_amdgcn_exp2f(s.x); e.y = __builtin_amdgcn_exp2f(s.y);
    const f32x2 m = v * (q * e), r = v - m;
    f32x2 o; o.x = v.x < 0.f ? m.x : r.x; o.y = v.y < 0.f ? m.y : r.y; return o;
}

template <int ACT  > struct EpiBf16 {
    static constexpr bool PERM = true, AFTER_DRAIN = false; static_assert(ACT == 0 || ACT == 1, "EpiBf16: ACT is 0 (none) or 1 (gelu_pk)");
    bf16_t* O; int ldc; const float* bias; int split_cols; size_t split_stride; float scale0;
    __device__ __forceinline__ void operator()(const f32x4 (&acc)[2][2][4][2], const Unit& u, int wr, int wc, int fr, int fq) const {
        const int row0 = u.pm * BM + wr * 64 + fr; int colt = u.pn * BM; bf16_t* base = O;
        float sc = 1.f; if (split_cols) { const int t = colt / split_cols; base += (size_t)t * split_stride; colt -= t * split_cols; if (t == 0) sc = scale0; }
        const int col0 = colt + wc * 32 + 8 * fq, bcol0 = u.pn * BM + wc * 32 + 8 * fq;
        f32x4 bv[2][2];
#pragma unroll
        for (int bj = 0; bj < 2; ++bj)
#pragma unroll
            for (int n = 0; n < 2; ++n) bv[bj][n] = bias ? *(const f32x4*)(bias + bcol0 + bj * HALF + 4 * n) : (f32x4){0.f, 0.f, 0.f, 0.f};
#pragma unroll
        for (int ai = 0; ai < 2; ++ai)
#pragma unroll
            for (int m = 0; m < 4; ++m) { bf16_t* rowp = base + (size_t)(row0 + ai * HALF + m * 16) * ldc + col0;
#pragma unroll
                for (int bj = 0; bj < 2; ++bj) { f32x4 v0 = acc[ai][bj][m][0] + bv[bj][0], v1 = acc[ai][bj][m][1] + bv[bj][1];
                    if (ACT == 1) { f32x2 a = gelu_pk((f32x2){v0[0], v0[1]}), b = gelu_pk((f32x2){v0[2], v0[3]}), c = gelu_pk((f32x2){v1[0], v1[1]}), d = gelu_pk((f32x2){v1[2], v1[3]});
                        v0 = (f32x4){a.x, a.y, b.x, b.y}; v1 = (f32x4){c.x, c.y, d.x, d.y}; }
                    v0 = v0 * sc; v1 = v1 * sc; u32x4 w; w.x = cvt_pk_bf16(v0[0], v0[1]); w.y = cvt_pk_bf16(v0[2], v0[3]); w.z = cvt_pk_bf16(v1[0], v1[1]); w.w = cvt_pk_bf16(v1[2], v1[3]);
                    *(u32x4*)(rowp + bj * HALF) = w; } }
    }
};

__device__ __forceinline__ float sigm(float x) { return __builtin_amdgcn_rcpf(1.0f + __builtin_amdgcn_exp2f(-1.4426950408889634f * x)); }
__device__ __forceinline__ u32x4 pack8(const f32x4 v0, const f32x4 v1) { u32x4 w; w.x = cvt_pk_bf16(v0[0], v0[1]); w.y = cvt_pk_bf16(v0[2], v0[3]); w.z = cvt_pk_bf16(v1[0], v1[1]); w.w = cvt_pk_bf16(v1[2], v1[3]); return w; }
struct EpiIn {
    static constexpr bool PERM = true, AFTER_DRAIN = false;
    bf16_t *Q, *K, *V, *ZP, *CG; const float* rope; float qscale; const float* sa; const float* sw;
    __device__ __forceinline__ void operator()(const i32x4 (&acc)[2][2][4][2], const Unit& u, int wr, int wc, int fr, int fq) const {
        const int row0 = u.pm * BM + wr * 64 + fr, pn = u.pn, cw = wc * 32 + 8 * fq;
        f32x4 swv[2][2];
#pragma unroll
        for (int bj = 0; bj < 2; ++bj)
#pragma unroll
            for (int n = 0; n < 2; ++n) swv[bj][n] = *(const f32x4*)(sw + pn * BM + bj * HALF + cw + 4 * n);
        float srv[2][4];
#pragma unroll
        for (int ai = 0; ai < 2; ++ai)
#pragma unroll
            for (int m = 0; m < 4; ++m) srv[ai][m] = sa[row0 + ai * HALF + m * 16];
#define DQ(ai, bj, m, n) (__builtin_convertvector(acc[ai][bj][m][n], f32x4) * (swv[bj][n] * sr))
        if (pn < 8) {
            bf16_t* base = (pn < 4 ? Q : K) + (pn & 3) * 256 + cw; const float sc = pn < 4 ? qscale : 1.f;
            const bool rl = ((wc & 1) == 0) && (fq < 2);
#pragma unroll
            for (int ai = 0; ai < 2; ++ai)
#pragma unroll
              for (int mp = 0; mp < 4; mp += 2) { f32x4 csv[2], snv[2];
#pragma unroll
                for (int mm = 0; mm < 2; ++mm) { const int r = row0 + ai * HALF + (mp + mm) * 16; csv[mm] = (f32x4){1.f, 1.f, 1.f, 1.f}; snv[mm] = (f32x4){0.f, 0.f, 0.f, 0.f};
                    if (rl) { csv[mm] = *(const f32x4*)(rope + (size_t)r * 16 + 4 * fq); snv[mm] = *(const f32x4*)(rope + (size_t)r * 16 + 8 + 4 * fq); } }
#pragma unroll
                for (int mm = 0; mm < 2; ++mm) { const int m = mp + mm; const int r = row0 + ai * HALF + m * 16; const float sr = srv[ai][m]; const f32x4 cs = csv[mm], sn = snv[mm];
#pragma unroll
                    for (int bj = 0; bj < 2; ++bj) { const f32x4 v0 = DQ(ai, bj, m, 0), v1 = DQ(ai, bj, m, 1); f32x4 w0, w1;
                        w0[0] = v0[0] * cs[0] - v0[1] * sn[0]; w0[1] = v0[1] * cs[0] + v0[0] * sn[0];
                        w0[2] = v0[2] * cs[1] - v0[3] * sn[1]; w0[3] = v0[3] * cs[1] + v0[2] * sn[1];
                        w1[0] = v1[0] * cs[2] - v1[1] * sn[2]; w1[1] = v1[1] * cs[2] + v1[0] * sn[2];
                        w1[2] = v1[2] * cs[3] - v1[3] * sn[3]; w1[3] = v1[3] * cs[3] + v1[2] * sn[3];
                        *(u32x4*)(base + (size_t)r * 1024 + bj * HALF) = pack8(w0 * sc, w1 * sc); } } }
        } else if (pn < 14) {
            const bool isv = pn < 12; const int ld = isv ? 1024 : 512; bf16_t* base = (isv ? V + (pn - 8) * 256 : ZP + (pn - 12) * 256) + cw;
#pragma unroll
            for (int ai = 0; ai < 2; ++ai)
#pragma unroll
                for (int m = 0; m < 4; ++m) { const int r = row0 + ai * HALF + m * 16; const float sr = srv[ai][m];
#pragma unroll
                    for (int bj = 0; bj < 2; ++bj) *(u32x4*)(base + (size_t)r * ld + bj * HALF) = pack8(DQ(ai, bj, m, 0), DQ(ai, bj, m, 1)); }
        } else {
            bf16_t* base = CG + (pn - 14) * 128 + cw;
#pragma unroll
            for (int ai = 0; ai < 2; ++ai)
#pragma unroll
                for (int m = 0; m < 4; ++m) { const int r = row0 + ai * HALF + m * 16; const float sr = srv[ai][m]; f32x4 c[2];
#pragma unroll
                    for (int n = 0; n < 2; ++n) { const f32x4 a = DQ(ai, 0, m, n), b = DQ(ai, 1, m, n);
#pragma unroll
                        for (int j = 0; j < 4; ++j) c[n][j] = a[j] * sigm(b[j]); }
                    *(u32x4*)(base + (size_t)r * 512) = pack8(c[0], c[1]); }
        }
#undef DQ
    }
};
struct EpiRes {
    static constexpr bool PERM = false, AFTER_DRAIN = false;
    const float* base; float* out;
    __device__ __forceinline__ void operator()(const f32x4 (&acc)[2][2][4][2], const Unit& u, int wr, int wc, int fr, int fq) const {
        const int row0 = u.pm * BM + wr * 64 + fr, col0 = u.pn * BM + wc * 32 + 4 * fq;
#pragma unroll
        for (int ai = 0; ai < 2; ++ai)
#pragma unroll
            for (int mp = 0; mp < 4; mp += 2) { f32x4 bs[2][2][2];
#pragma unroll
                for (int mm = 0; mm < 2; ++mm) { const size_t off = (size_t)(row0 + ai * HALF + (mp + mm) * 16) * 2048 + col0;
#pragma unroll
                    for (int bj = 0; bj < 2; ++bj)
#pragma unroll
                        for (int n = 0; n < 2; ++n) bs[mm][bj][n] = *(const f32x4*)(base + off + bj * HALF + n * 16); }
#pragma unroll
                for (int mm = 0; mm < 2; ++mm) { const size_t off = (size_t)(row0 + ai * HALF + (mp + mm) * 16) * 2048 + col0;
#pragma unroll
                    for (int bj = 0; bj < 2; ++bj)
#pragma unroll
                        for (int n = 0; n < 2; ++n) *(f32x4*)(out + off + bj * HALF + n * 16) = bs[mm][bj][n] + acc[ai][bj][mp + mm][n]; } }
    }
};
struct EpiSwiglu {
    static constexpr bool PERM = true, AFTER_DRAIN = false;
    bf16_t* O; int ldc;
    __device__ __forceinline__ void operator()(const f32x4 (&acc)[2][2][4][2], const Unit& u, int wr, int wc, int fr, int fq) const {
        const int row0 = u.pm * BM + wr * 64 + fr; bf16_t* base = O + u.pn * 128 + wc * 32 + 8 * fq;
#pragma unroll
        for (int ai = 0; ai < 2; ++ai)
#pragma unroll
            for (int m = 0; m < 4; ++m) { const int r = row0 + ai * HALF + m * 16; f32x4 c[2];
#pragma unroll
                for (int n = 0; n < 2; ++n) { const f32x4 g = acc[ai][0][m][n], up = acc[ai][1][m][n];
#pragma unroll
                    for (int j = 0; j < 4; ++j) c[n][j] = g[j] * sigm(g[j]) * up[j]; }
                *(u32x4*)(base + (size_t)r * ldc) = pack8(c[0], c[1]); }
    }
};
__device__ __forceinline__ unsigned cvt4_fp8(float a, float b, float c, float d) {
    a = __builtin_fminf(__builtin_fmaxf(a, -448.f), 448.f); b = __builtin_fminf(__builtin_fmaxf(b, -448.f), 448.f); c = __builtin_fminf(__builtin_fmaxf(c, -448.f), 448.f); d = __builtin_fminf(__builtin_fmaxf(d, -448.f), 448.f);
    int w = 0; w = __builtin_amdgcn_cvt_pk_fp8_f32(a, b, w, false); w = __builtin_amdgcn_cvt_pk_fp8_f32(c, d, w, true); return (unsigned)w; }
struct EpiScaleBf16 {
    static constexpr bool PERM = true, AFTER_DRAIN = false;
    bf16_t* O; int ldc; const float* sw; size_t ks_stride;
    __device__ __forceinline__ void operator()(const f32x4 (&acc)[2][2][4][2], const Unit& u, int wr, int wc, int fr, int fq) const {
        const int row0 = u.pm * BM + wr * 64 + fr, col0 = u.pn * BM + wc * 32 + 8 * fq; const float* swp = sw + (size_t)u.eb * 2048 + col0; bf16_t* Ob = O + (size_t)u.ks * ks_stride;
        f32x4 swv[2][2];
#pragma unroll
        for (int bj = 0; bj < 2; ++bj)
#pragma unroll
            for (int n = 0; n < 2; ++n) swv[bj][n] = *(const f32x4*)(swp + bj * HALF + 4 * n);
#pragma unroll
        for (int ai = 0; ai < 2; ++ai)
#pragma unroll
            for (int m = 0; m < 4; ++m) { const int r = row0 + ai * HALF + m * 16;
#pragma unroll
                for (int bj = 0; bj < 2; ++bj) *(u32x4*)(Ob + (size_t)r * ldc + col0 + bj * HALF) = pack8(acc[ai][bj][m][0] * swv[bj][0], acc[ai][bj][m][1] * swv[bj][1]); }
    }
};
template <bool F8OUT> struct EpiSwigluI8 {
    static constexpr bool PERM = true, AFTER_DRAIN = false;
    bf16_t* O; int ldc; const float* sa; const float* sw;
    __device__ __forceinline__ void operator()(const i32x4 (&acc)[2][2][4][2], const Unit& u, int wr, int wc, int fr, int fq) const {
        const int row0 = u.pm * BM + wr * 64 + fr; bf16_t* base = O + u.pn * 128 + wc * 32 + 8 * fq;
        const float* swp = sw + (size_t)u.eb * 14336 + u.pn * 256 + wc * 32 + 8 * fq;
        const f32x4 sg[2] = {*(const f32x4*)(swp) * 1.4426950408889634f, *(const f32x4*)(swp + 4) * 1.4426950408889634f}, su[2] = {*(const f32x4*)(swp + 128) * 0.6931471805599453f, *(const f32x4*)(swp + 132) * 0.6931471805599453f};
        float srv[2][4];
#pragma unroll
        for (int ai = 0; ai < 2; ++ai)
#pragma unroll
            for (int m = 0; m < 4; ++m) srv[ai][m] = sa[row0 + ai * HALF + m * 16];
#pragma unroll
        for (int ai = 0; ai < 2; ++ai)
#pragma unroll
            for (int m = 0; m < 4; ++m) { const int r = row0 + ai * HALF + m * 16; const float sr = srv[ai][m]; f32x4 c[2];
#pragma unroll
                for (int n = 0; n < 2; ++n) { const f32x4 g = __builtin_convertvector(acc[ai][0][m][n], f32x4) * (sg[n] * sr), up = __builtin_convertvector(acc[ai][1][m][n], f32x4) * (su[n] * sr);
                    f32x4 d;
#pragma unroll
                    for (int j = 0; j < 4; ++j) d[j] = __builtin_amdgcn_rcpf(1.0f + __builtin_amdgcn_exp2f(-g[j]));
                    c[n] = (g * d) * up; }
                if constexpr (F8OUT) { typedef unsigned u32x2 __attribute__((ext_vector_type(2))); u32x2 w; w.x = cvt4_fp8(c[0][0], c[0][1], c[0][2], c[0][3]); w.y = cvt4_fp8(c[1][0], c[1][1], c[1][2], c[1][3]);
                    *(u32x2*)((unsigned char*)O + (size_t)r * ldc + u.pn * 128 + wc * 32 + 8 * fq) = w; }
                else *(u32x4*)(base + (size_t)r * ldc) = pack8(c[0], c[1]); }
    }
};
struct EpiDqBf16 {
    static constexpr bool PERM = true, AFTER_DRAIN = false;
    bf16_t* O; int ldc; const float* sa; const float* sw; size_t ks_stride;
    __device__ __forceinline__ void operator()(const i32x4 (&acc)[2][2][4][2], const Unit& u, int wr, int wc, int fr, int fq) const {
        const int row0 = u.pm * BM + wr * 64 + fr, col0 = u.pn * BM + wc * 32 + 8 * fq; const float* swp = sw + (size_t)u.eb * 2048 + col0; bf16_t* Ob = O + (size_t)u.ks * ks_stride;
        f32x4 swv[2][2];
#pragma unroll
        for (int bj = 0; bj < 2; ++bj)
#pragma unroll
            for (int n = 0; n < 2; ++n) swv[bj][n] = *(const f32x4*)(swp + bj * HALF + 4 * n);
#pragma unroll
        for (int ai = 0; ai < 2; ++ai)
#pragma unroll
            for (int m = 0; m < 4; ++m) { const int r = row0 + ai * HALF + m * 16; const float sr = sa[r];
#pragma unroll
                for (int bj = 0; bj < 2; ++bj) *(u32x4*)(Ob + (size_t)r * ldc + col0 + bj * HALF) = pack8(__builtin_convertvector(acc[ai][bj][m][0], f32x4) * (swv[bj][0] * sr), __builtin_convertvector(acc[ai][bj][m][1], f32x4) * (swv[bj][1] * sr)); }
    }
};
struct EpiPle {
    static constexpr bool PERM = false, AFTER_DRAIN = false;
    float* h; const bf16_t* P; const float* sa; const float* sw;
    __device__ __forceinline__ void operator()(const i32x4 (&acc)[2][2][4][2], const Unit& u, int wr, int wc, int fr, int fq) const {
        typedef unsigned u32x2 __attribute__((ext_vector_type(2)));
        const int row0 = u.pm * BM + wr * 64 + fr, col0 = u.pn * BM + wc * 32 + 4 * fq;
        f32x4 swv[2][2];
#pragma unroll
        for (int bj = 0; bj < 2; ++bj)
#pragma unroll
            for (int n = 0; n < 2; ++n) swv[bj][n] = *(const f32x4*)(sw + col0 + bj * HALF + n * 16);
        f32x4 hv[2][2][2]; u32x2 pw[2][2][2]; float srg[2];
#define PLE_LOAD(g, s) do { const int rr = row0 + ((g) >> 2) * HALF + ((g) & 3) * 16; const size_t off = (size_t)rr * 2048 + col0; srg[s] = sa[rr]; \
            _Pragma("unroll") for (int bj = 0; bj < 2; ++bj) _Pragma("unroll") for (int n = 0; n < 2; ++n) { const size_t o2 = off + bj * HALF + n * 16; hv[s][bj][n] = *(const f32x4*)(h + o2); pw[s][bj][n] = *(const u32x2*)(P + o2); } } while (0)
        PLE_LOAD(0, 0);
#pragma unroll
        for (int g = 0; g < 8; ++g) { const int s = g & 1, ai = g >> 2, m = g & 3; const size_t off = (size_t)(row0 + ai * HALF + m * 16) * 2048 + col0;
            if (g + 1 < 8) { if (s == 0) PLE_LOAD(g + 1, 1); else PLE_LOAD(g + 1, 0); }
            f32x4 ov[2][2];
#pragma unroll
            for (int bj = 0; bj < 2; ++bj)
#pragma unroll
                for (int n = 0; n < 2; ++n) { const f32x4 a = __builtin_convertvector(acc[ai][bj][m][n], f32x4) * (swv[bj][n] * srg[s]); const u32x2 pq = pw[s][bj][n]; f32x4 pv;
                    pv[0] = __uint_as_float(pq.x << 16); pv[1] = __uint_as_float(pq.x & 0xffff0000u); pv[2] = __uint_as_float(pq.y << 16); pv[3] = __uint_as_float(pq.y & 0xffff0000u);
#pragma unroll
                    for (int j = 0; j < 4; ++j) ov[bj][n][j] = hv[s][bj][n][j] + pv[j] * sigm(a[j]); }
#pragma unroll
            for (int bj = 0; bj < 2; ++bj)
#pragma unroll
                for (int n = 0; n < 2; ++n) *(f32x4*)(h + off + bj * HALF + n * 16) = ov[bj][n]; }
#undef PLE_LOAD
    }
};

template <class Epi, class Sched, bool ALIGN_EPI = false, bool SP2 = false, int MODE = 0>
__device__ __forceinline__ void gemm_phase(PG8_LAS unsigned char* lds, const Gemm g, const Sched& S, const Epi& E, int tid) {
    asm volatile("" : "+v"(tid));
    const int wid = __builtin_amdgcn_readfirstlane(tid >> 6), lane = tid & 63, wr = wid >> 2, wc = wid & 3, fr = lane & 15, fq = lane >> 4;
    const int K = g.ldk ? g.ldk : g.K, nt = g.K / BK;
    unsigned voffA[2], voffB[2];
#pragma unroll
    for (int i = 0; i < 2; ++i) { int R, C; stage_rc(tid * 16 + i * 8192, R, C); const int Rb = Epi::PERM ? ((R & ~31) + perm32(R & 31)) : R;
        voffA[i] = (unsigned)(R * K + C) * 2u; voffB[i] = (unsigned)(Rb * K + C) * 2u; }
    const size_t kstep = (size_t)(BK * 2);
    const size_t hstep = (size_t)HALF * K * 2;
    const size_t tstep = 2 * hstep;
    const unsigned ldsw = (unsigned)wid * 1024u;
    const int aoff = lds_byte(wr * 64 + fr, fq * 8), boff = lds_byte(wc * 32 + fr, fq * 8);
#define PG8_SA(b, h) (((b) * 2 + (h)) * HTB)
#define PG8_SB(b, h) ((4 + (b) * 2 + (h)) * HTB)
#define PG8_STAGE(bufoff, gbase, voff) do { _Pragma("unroll") for (int _i = 0; _i < 2; ++_i) \
        __builtin_amdgcn_global_load_lds((const unsigned*)((const char*)(gbase) + (voff)[_i]), (PG8_LAS unsigned*)(lds + (bufoff) + ldsw + _i * 8192), 16, 0, 0); } while (0)
#define PG8_LDA(dst, b, h) do { if constexpr (MODE == 2) { _Pragma("unroll") for (int m = 0; m < 4; ++m) { dst##8[m].lo = *(const PG8_LAS i32x4*)(lds + PG8_SA(b, h) + aoff + m * 2048); dst##8[m].hi = *(const PG8_LAS i32x4*)(lds + PG8_SA(b, h) + aoff + m * 2048 + 1024); } } \
        else { _Pragma("unroll") for (int m = 0; m < 4; ++m) _Pragma("unroll") for (int k = 0; k < 2; ++k) dst[m][k] = *(const PG8_LAS bf16x8*)(lds + PG8_SA(b, h) + aoff + m * 2048 + k * 1024); } } while (0)
#define PG8_LDB(dst, b, h) do { if constexpr (MODE == 2) { _Pragma("unroll") for (int n = 0; n < 2; ++n) { dst##8[n].lo = *(const PG8_LAS i32x4*)(lds + PG8_SB(b, h) + boff + n * 2048); dst##8[n].hi = *(const PG8_LAS i32x4*)(lds + PG8_SB(b, h) + boff + n * 2048 + 1024); } } \
        else { _Pragma("unroll") for (int n = 0; n < 2; ++n) _Pragma("unroll") for (int k = 0; k < 2; ++k) dst[n][k] = *(const PG8_LAS bf16x8*)(lds + PG8_SB(b, h) + boff + n * 2048 + k * 1024); } } while (0)
#define PG8_MMA(ai, bj, At, Bt) do { __builtin_amdgcn_s_setprio(3); _Pragma("unroll") for (int m = 0; m < 4; ++m) _Pragma("unroll") for (int n = 0; n < 2; ++n) _Pragma("unroll") for (int k = 0; k < 2; ++k) \
        { if constexpr (MODE == 1) acc[ai][bj][m][n] = __builtin_bit_cast(acc_t, __builtin_amdgcn_mfma_i32_16x16x64_i8(__builtin_bit_cast(i32x4, Bt[n][k]), __builtin_bit_cast(i32x4, At[m][k]), __builtin_bit_cast(i32x4, acc[ai][bj][m][n]), 0, 0, 0)); \
          else if constexpr (MODE == 2) { if (k == 0) asm volatile("v_mfma_scale_f32_16x16x128_f8f6f4 %0, %1, %2, %0, %3, %3 op_sel_hi:[0,0,0]" : "+v"(acc[ai][bj][m][n]) : "v"(Bt##8[n]), "v"(At##8[m]), "v"(f8scale)); } \
          else acc[ai][bj][m][n] = __builtin_bit_cast(acc_t, __builtin_amdgcn_mfma_f32_16x16x32_bf16(Bt[n][k], At[m][k], __builtin_bit_cast(f32x4, acc[ai][bj][m][n]), 0, 0, 0)); } __builtin_amdgcn_s_setprio(0); } while (0)
#define PG8_WAIT_V(n) asm volatile("s_waitcnt vmcnt(" #n ")" ::: "memory")
#define PG8_WAIT_L(n) asm volatile("s_waitcnt lgkmcnt(" #n ")" ::: "memory")
#define PG8_BAR __builtin_amdgcn_s_barrier()
#define PG8_SCHED __builtin_amdgcn_sched_barrier(0)
    Unit cur, nxt; int ui = 0;
    if (!S.next(0, cur)) return;
    typedef typename AccT<MODE>::type acc_t;
    acc_t acc[2][2][4][2];
#pragma unroll
    for (int a = 0; a < 2; ++a)
#pragma unroll
        for (int b = 0; b < 2; ++b)
#pragma unroll
            for (int m = 0; m < 4; ++m)
#pragma unroll
                for (int n = 0; n < 2; ++n) acc[a][b][m][n] = acc_t{};
    const int f8scale = 0x7f7f7f7f;
    bf16x8 At[4][2], B0[2][2], B1[2][2]; i32x8 At8[4], B08[2], B18[2];
    const char* cA = (const char*)g.A + (size_t)cur.pm * tstep + (size_t)cur.ks * g.kslice; const char* cB = (const char*)g.Bt + (size_t)cur.eb * g.bstride + (size_t)cur.pn * tstep + (size_t)cur.ks * g.kslice;
    S.a_ready(cur);
    if constexpr (SP2) {
        PG8_STAGE(PG8_SB(0, 0), cB, voffB); PG8_STAGE(PG8_SB(0, 1), cB + hstep, voffB); PG8_STAGE(PG8_SA(0, 0), cA, voffA); PG8_STAGE(PG8_SA(0, 1), cA + hstep, voffA);
        if (wr == 1) PG8_BAR;
        PG8_WAIT_V(2); PG8_BAR;
        PG8_STAGE(PG8_SB(1, 0), cB + kstep, voffB); PG8_STAGE(PG8_SA(1, 0), cA + kstep, voffA); PG8_STAGE(PG8_SB(1, 1), cB + hstep + kstep, voffB);
        PG8_WAIT_V(6); PG8_BAR;
    } else {
        PG8_STAGE(PG8_SB(0, 0), cB, voffB); PG8_STAGE(PG8_SA(0, 0), cA, voffA); PG8_STAGE(PG8_SB(0, 1), cB + hstep, voffB); PG8_STAGE(PG8_SA(0, 1), cA + hstep, voffA);
        if (wr == 1) PG8_BAR;
        PG8_WAIT_V(4); PG8_BAR;
        PG8_STAGE(PG8_SB(1, 0), cB + kstep, voffB); PG8_STAGE(PG8_SA(1, 0), cA + kstep, voffA); PG8_STAGE(PG8_SB(1, 1), cB + hstep + kstep, voffB);
        PG8_WAIT_V(6); PG8_BAR;
    }
    for (;;) {
        const bool has_next = S.next(ui + 1, nxt);
        const char* nA = has_next ? (const char*)g.A + (size_t)nxt.pm * tstep + (size_t)nxt.ks * g.kslice : cA; const char* nB = has_next ? (const char*)g.Bt + (size_t)nxt.eb * g.bstride + (size_t)nxt.pn * tstep + (size_t)nxt.ks * g.kslice : cB;
        for (int t = 0; t < nt; t += 2) {
            const bool last = (t == nt - 2);
            const char* a1 = cA + (size_t)(t + 1) * kstep;
            const char* a2 = last ? nA : cA + (size_t)(t + 2) * kstep; const char* b2 = last ? nB : cB + (size_t)(t + 2) * kstep;
            const char* a3 = a2 + kstep; const char* b3 = b2 + kstep;
            if (last && has_next) S.a_ready(nxt);
            if constexpr (SP2) {
            PG8_LDB(B0, 0, 0); PG8_LDB(B1, 0, 1); PG8_SCHED; PG8_LDA(At, 0, 0); PG8_STAGE(PG8_SA(1, 1), a1 + hstep, voffA);
            PG8_WAIT_V(8); PG8_WAIT_L(0); PG8_BAR; PG8_MMA(0, 0, At, B0); PG8_MMA(0, 1, At, B1); PG8_BAR; PG8_SCHED;
            PG8_LDA(At, 0, 1); PG8_STAGE(PG8_SB(0, 0), b2, voffB); PG8_STAGE(PG8_SB(0, 1), b2 + hstep, voffB); PG8_STAGE(PG8_SA(0, 0), a2, voffA);
            PG8_WAIT_V(8); PG8_WAIT_L(0); PG8_BAR; PG8_MMA(1, 0, At, B0); PG8_MMA(1, 1, At, B1); PG8_BAR; PG8_SCHED;
            PG8_LDB(B0, 1, 0); PG8_LDB(B1, 1, 1); PG8_SCHED; PG8_LDA(At, 1, 0); PG8_STAGE(PG8_SA(0, 1), a2 + hstep, voffA);
            PG8_WAIT_V(8); PG8_WAIT_L(0); PG8_BAR; PG8_MMA(0, 0, At, B0); PG8_MMA(0, 1, At, B1); PG8_BAR; PG8_SCHED;
            PG8_LDA(At, 1, 1); PG8_STAGE(PG8_SB(1, 0), b3, voffB); PG8_STAGE(PG8_SB(1, 1), b3 + hstep, voffB); PG8_STAGE(PG8_SA(1, 0), a3, voffA);
            PG8_WAIT_V(8); PG8_WAIT_L(0); PG8_BAR; PG8_MMA(1, 0, At, B0); PG8_MMA(1, 1, At, B1); PG8_BAR; PG8_SCHED;
            } else {
            PG8_LDB(B0, 0, 0); PG8_SCHED; PG8_LDA(At, 0, 0); PG8_STAGE(PG8_SA(1, 1), a1 + hstep, voffA);
            PG8_WAIT_L(8); PG8_BAR; PG8_WAIT_L(0); PG8_MMA(0, 0, At, B0); PG8_BAR; PG8_SCHED;
            PG8_LDB(B1, 0, 1); PG8_STAGE(PG8_SB(0, 0), b2, voffB);
            PG8_BAR; PG8_WAIT_L(0); PG8_MMA(0, 1, At, B1); PG8_BAR;
            PG8_LDA(At, 0, 1); PG8_STAGE(PG8_SA(0, 0), a2, voffA);
            PG8_BAR; PG8_WAIT_L(0); PG8_MMA(1, 0, At, B0); PG8_BAR; PG8_SCHED;
            PG8_STAGE(PG8_SB(0, 1), b2 + hstep, voffB);
            PG8_WAIT_V(6); PG8_BAR; PG8_MMA(1, 1, At, B1); PG8_BAR;
            PG8_LDB(B0, 1, 0); PG8_SCHED; PG8_LDA(At, 1, 0); PG8_STAGE(PG8_SA(0, 1), a2 + hstep, voffA);
            PG8_WAIT_L(8); PG8_BAR; PG8_WAIT_L(0); PG8_MMA(0, 0, At, B0); PG8_BAR; PG8_SCHED;
            PG8_LDB(B1, 1, 1); PG8_STAGE(PG8_SB(1, 0), b3, voffB);
            PG8_BAR; PG8_WAIT_L(0); PG8_MMA(0, 1, At, B1); PG8_BAR;
            PG8_LDA(At, 1, 1); PG8_STAGE(PG8_SA(1, 0), a3, voffA);
            PG8_BAR; PG8_WAIT_L(0); PG8_MMA(1, 0, At, B0); PG8_BAR; PG8_SCHED;
            PG8_STAGE(PG8_SB(1, 1), b3 + hstep, voffB);
            PG8_WAIT_V(6); PG8_BAR; PG8_MMA(1, 1, At, B1); PG8_BAR;
            }
        }
        if constexpr (MODE == 2) asm volatile("s_nop 15\n\ts_nop 7" ::: "memory");
        if constexpr (ALIGN_EPI) { if (wr == 0) PG8_BAR; }
        if constexpr (!Epi::AFTER_DRAIN) { E(acc, cur, wr, wc, fr, fq); S.done(cur); }
        if (!has_next) break;
#pragma unroll
        for (int a = 0; a < 2; ++a)
#pragma unroll
            for (int b = 0; b < 2; ++b)
#pragma unroll
                for (int m = 0; m < 4; ++m)
#pragma unroll
                    for (int n = 0; n < 2; ++n) acc[a][b][m][n] = acc_t{};
        cur = nxt; cA = nA; cB = nB; ++ui;
        if constexpr (ALIGN_EPI) { if (wr == 1) PG8_BAR; }
    }
    PG8_WAIT_V(0);
    if constexpr (!ALIGN_EPI) { if (wr == 0) PG8_BAR; }
    PG8_BAR;
    if constexpr (Epi::AFTER_DRAIN) { E.fused(acc, cur, wr, wc, fr, fq, lds, wid, lane); S.done(cur); }
#undef PG8_SA
#undef PG8_SB
#undef PG8_STAGE
#undef PG8_LDA
#undef PG8_LDB
#undef PG8_MMA
#undef PG8_WAIT_V
#undef PG8_WAIT_L
#undef PG8_BAR
#undef PG8_SCHED
}
}

#ifndef PG8_SP2
#define PG8_SP2 true
#endif
#ifndef PG8_ALIGN
#define PG8_ALIGN true
#endif
#include <hip/hip_bf16.h>
#include <cmath>
namespace attn_body {
using bf16=__hip_bfloat16;
using bf16x8=__attribute__((ext_vector_type(8)))short;
using s16x4=__attribute__((ext_vector_type(4)))short;
using f32x16=__attribute__((ext_vector_type(16)))float;
using u32x4=__attribute__((ext_vector_type(4)))unsigned;
constexpr int BATCH=4,SEQ=4096,D=64,DM=1024;
constexpr int NW=8,QBLK=32,QB=QBLK*NW,KVBLK=64,NQB=SEQ/QB;
constexpr int ATTN_PITCH=DM, ATTN_UNIT_ROWS=QB;
__device__ __forceinline__ int crow(int r,int hi){return (r&3)+8*(r>>2)+4*hi;}
#define SBAR() __builtin_amdgcn_sched_barrier(0)
__device__ __forceinline__ void cmask(f32x16&p0,f32x16&p1,int jb,int qrel,int hi){
  const float NEG=-INFINITY; int kb=64*jb+4*hi;
  #pragma unroll
  for(int r=0;r<16;++r){int kv=kb+(r&3)+8*(r>>2); if(kv>qrel)p0[r]=NEG; if(kv+32>qrel)p1[r]=NEG;}
}

constexpr int NSLOT=3, SLOTB=8192;
constexpr int VSLOTB=2*SLOTB;
constexpr int LDS_K=0, LDS_V=NSLOT*SLOTB, LDS_WS=LDS_V+NSLOT*VSLOTB, LDS_OST=LDS_WS+NW*64*4, LDS_BYTES=LDS_OST+NW*4096;
constexpr float C2=0.125f*1.4426950408889634f;
__device__ __forceinline__ void glds16(const void*gsrc,unsigned lds_dst){unsigned keep;
  asm volatile("s_mov_b32 %0, m0\n\ts_mov_b32 m0, %2\n\ts_nop 0\n\tglobal_load_lds_dwordx4 %1, off\n\ts_mov_b32 m0, %0":"=&s"(keep):"v"(gsrc),"s"(lds_dst):"memory");}
__device__ __forceinline__ float max3f(float a,float b,float c){float r;asm("v_max3_f32 %0, %1, %2, %3":"=v"(r):"v"(a),"v"(b),"v"(c));return r;}
__device__ __forceinline__ float max2f(float a,float b){float r;asm("v_max_f32_e32 %0, %1, %2":"=v"(r):"v"(a),"v"(b));return r;}
__device__ __forceinline__ float fadd_s(float a,float b){float r;asm("v_add_f32_e32 %0, %1, %2":"=v"(r):"v"(a),"v"(b));return r;}
__device__ __forceinline__ float fsub_s(float a,float b){float r;asm("v_sub_f32_e32 %0, %1, %2":"=v"(r):"v"(a),"v"(b));return r;}
typedef float f32x2_t __attribute__((ext_vector_type(2))); typedef __bf16 bf16x2_t __attribute__((ext_vector_type(2)));
__device__ __forceinline__ unsigned cvtpk_s(float lo,float hi){f32x2_t v={lo,hi};bf16x2_t b=__builtin_convertvector(v,bf16x2_t);return __builtin_bit_cast(unsigned,b);}
#define WAIT_BAR(N) asm volatile("s_waitcnt vmcnt(" #N ") lgkmcnt(0)\n\ts_barrier":::"memory")

__device__ __forceinline__ void qkt(f32x16&p0,f32x16&p1,const char*Kslot,const bf16x8*qr,const f32x16&negm,int r32,int hi){
  const char*kb=Kslot+hi*1024+r32*16;
  #pragma unroll
  for(int d0=0;d0<4;++d0){
    const bf16x8 b0=*reinterpret_cast<const bf16x8*>(kb+d0*2048);
    const bf16x8 b1=*reinterpret_cast<const bf16x8*>(kb+d0*2048+512);
    if(d0==0){p0=__builtin_amdgcn_mfma_f32_32x32x16_bf16(b0,qr[0],negm,0,0,0);p1=__builtin_amdgcn_mfma_f32_32x32x16_bf16(b1,qr[0],negm,0,0,0);}
    else{p0=__builtin_amdgcn_mfma_f32_32x32x16_bf16(b0,qr[d0],p0,0,0,0);p1=__builtin_amdgcn_mfma_f32_32x32x16_bf16(b1,qr[d0],p1,0,0,0);}}
}
typedef __attribute__((address_space(3))) const char* lds_cptr;
typedef short v4i16_t __attribute__((ext_vector_type(4)));
__device__ __forceinline__ void kload8(bf16x8*kf,lds_cptr kp){
  kf[0]=*(const __attribute__((address_space(3))) bf16x8*)(kp);      kf[1]=*(const __attribute__((address_space(3))) bf16x8*)(kp+512);
  kf[2]=*(const __attribute__((address_space(3))) bf16x8*)(kp+2048); kf[3]=*(const __attribute__((address_space(3))) bf16x8*)(kp+2560);
  kf[4]=*(const __attribute__((address_space(3))) bf16x8*)(kp+4096); kf[5]=*(const __attribute__((address_space(3))) bf16x8*)(kp+4608);
  kf[6]=*(const __attribute__((address_space(3))) bf16x8*)(kp+6144); kf[7]=*(const __attribute__((address_space(3))) bf16x8*)(kp+6656);
}
__device__ __forceinline__ void kload2(bf16x8*kf,lds_cptr kp,int j){ kf[2*j]=*(const __attribute__((address_space(3))) bf16x8*)(kp+j*2048); kf[2*j+1]=*(const __attribute__((address_space(3))) bf16x8*)(kp+j*2048+512); }
__device__ __forceinline__ s16x4 vtr(lds_cptr p){ return __builtin_bit_cast(s16x4,__builtin_amdgcn_ds_read_tr16_b64_v4i16((__attribute__((address_space(3))) v4i16_t*)p)); }
__device__ __forceinline__ float rowmax(const f32x16&p0,const f32x16&p1){
  float a=max3f(p0[0],p0[1],p1[0]),b=max3f(p0[2],p0[3],p1[1]);a=max3f(a,p1[2],p1[3]);
  #pragma unroll
  for(int r=4;r<16;r+=4){a=max3f(a,p0[r],p0[r+1]);b=max3f(b,p0[r+2],p0[r+3]);a=max3f(a,p1[r],p1[r+1]);b=max3f(b,p1[r+2],p1[r+3]);}
  const float m=max2f(a,b);
  auto rr=__builtin_amdgcn_permlane32_swap(__float_as_uint(m),__float_as_uint(m),false,false);
  return max2f(__uint_as_float(rr[0]),__uint_as_float(rr[1]));
}
__device__ __forceinline__ void pv(f32x16*o,int vb,bf16x8 pa0,bf16x8 pa1,bf16x8 pa2,bf16x8 pa3){
  #pragma unroll
  for(int d0=0;d0<4;++d0){s16x4 lo[4],hi[4];
    #pragma unroll
    for(int ks=0;ks<4;++ks){
      asm volatile("ds_read_b64_tr_b16 %0,%1 offset:%c2":"=&v"(lo[ks]):"v"(vb),"i"(d0*4096+ks*1024):"memory");
      asm volatile("ds_read_b64_tr_b16 %0,%1 offset:%c2":"=&v"(hi[ks]):"v"(vb),"i"(d0*4096+ks*1024+512):"memory");}
    asm volatile("s_waitcnt lgkmcnt(0)":::"memory");SBAR();
    #define PK(k) (bf16x8){lo[k][0],lo[k][1],lo[k][2],lo[k][3],hi[k][0],hi[k][1],hi[k][2],hi[k][3]}
    o[d0]=__builtin_amdgcn_mfma_f32_32x32x16_bf16(pa0,PK(0),o[d0],0,0,0);
    o[d0]=__builtin_amdgcn_mfma_f32_32x32x16_bf16(pa1,PK(1),o[d0],0,0,0);
    o[d0]=__builtin_amdgcn_mfma_f32_32x32x16_bf16(pa2,PK(2),o[d0],0,0,0);
    o[d0]=__builtin_amdgcn_mfma_f32_32x32x16_bf16(pa3,PK(3),o[d0],0,0,0);
    #undef PK
  }
}

#ifndef ATTN_STORE16
#define ATTN_STORE16(p,v) (*(u32x4*)(p)=(v))
#endif
template<int THRL> __device__ __forceinline__ void attn_unit(int b,int qcol,int vcol,int qb,const bf16*Q,const bf16*__restrict__ K,const bf16*__restrict__ V,bf16*O,char*shm,int tid){
  asm volatile("":"+v"(tid)); const int lane=tid&63,r32=lane&31,hi=lane>>5; const int wid=__builtin_amdgcn_readfirstlane(tid>>6);
  const long rowbase=(long)b*SEQ; const int q0=qb*QB;
  const bf16*Qw=Q+(rowbase+q0+wid*QBLK)*DM+qcol;
  const bf16*Kh=K+rowbase*DM+qcol,*Vh=V+rowbase*DM+vcol;
  const unsigned lds0=(unsigned)(uintptr_t)shm;
  float*wsf=(float*)(shm+LDS_WS)+wid*64;
  const bf16*ksrc=Kh+(long)lane*DM+wid*8;
  const bf16*vsrc=Vh+(long)(16*(wid&3)+(lane>>2))*DM+(wid>>2)*32+(lane&3)*8;
  const unsigned kdst=lds0+LDS_K+wid*1024, vdst=lds0+LDS_V+wid*1024;
  #define DMA_K(t,slot) glds16(ksrc+(long)(t)*KVBLK*DM,(unsigned)__builtin_amdgcn_readfirstlane(kdst+(slot)))
  #define DMA_V(t,slot) do{ glds16(vsrc+(long)(t)*KVBLK*DM,(unsigned)__builtin_amdgcn_readfirstlane(vdst+2*(slot))); glds16(vsrc+64+(long)(t)*KVBLK*DM,(unsigned)__builtin_amdgcn_readfirstlane(vdst+2*(slot)+8192)); }while(0)
  const int vb0=(int)(lds0+LDS_V)+((lane>>4)&1)*32+(lane&3)*8+(4*hi+((lane&15)>>2))*64;
  const char*Kbase=shm+LDS_K; bf16x8 kf[8];
  const lds_cptr shm3=(lds_cptr)shm; const lds_cptr kp0=shm3+LDS_K+hi*1024+r32*16; const lds_cptr vp0=shm3+LDS_V+((lane>>4)&1)*32+(lane&3)*8+(4*hi+((lane&15)>>2))*64;
  const int NT=(q0+QB)/KVBLK;
  DMA_K(0,0);DMA_V(0,0);DMA_K(1,SLOTB);
  bf16x8 qr[4];
  #pragma unroll
  for(int d0=0;d0<4;++d0)qr[d0]=*reinterpret_cast<const bf16x8*>(&Qw[(long)r32*DM+d0*16+hi*8]);
  float mhat=0.f,l_reg=0.f;f32x16 o[4];o[0]=f32x16{};o[1]=f32x16{};o[2]=f32x16{};o[3]=f32x16{};const f32x16 zero16=f32x16{};
  const int qrel=wid*QBLK+r32;
  #define CMASK(P0,P1,t) do{int jb_=(t)-(NT-4); if(jb_>=0)cmask(P0,P1,jb_,qrel,hi);}while(0)
  bool resc=false;
  #define START(P0,P1) do{ const float rm=rowmax(P0,P1); resc=false; \
    { const float dl=rm; mhat=fadd_s(mhat,dl); \
      _Pragma("unroll") for(int r=0;r<16;++r){P0[r]=fsub_s(P0[r],dl);P1[r]=fsub_s(P1[r],dl);} } \
    _Pragma("unroll") for(int r=0;r<16;++r)P0[r]=__builtin_amdgcn_exp2f(P0[r]); }while(0)
  #define RESC() do{ if(resc){ asm volatile("s_waitcnt lgkmcnt(0)":::"memory"); \
      _Pragma("unroll") for(int d_=0;d_<4;++d_) _Pragma("unroll") for(int r=0;r<16;++r)o[d_][r]*=wsf[crow(r,hi)]; } }while(0)
  f32x16 pA0,pA1,pB0,pB1;
  int sl_prev=0,sl_cur=0,sl_next=SLOTB;
  #define ROT() do{sl_prev=sl_cur;sl_cur=sl_next;sl_next=(sl_next==(NSLOT-1)*SLOTB)?0:sl_next+SLOTB;}while(0)
  DMA_K(2,2*SLOTB);
  WAIT_BAR(4);
  qkt(pA0,pA1,Kbase,qr,zero16,r32,hi);asm volatile("s_nop 15\n\ts_nop 7":"+v"(pA0),"+v"(pA1));CMASK(pA0,pA1,0);
  START(pA0,pA1);
  _Pragma("unroll") for(int r=0;r<16;++r)pA1[r]=__builtin_amdgcn_exp2f(pA1[r]);
  WAIT_BAR(0);
  DMA_K(3,0);DMA_V(1,SLOTB);
  ROT();
  kload8(kf,kp0+sl_cur);
  WAIT_BAR(3);
  s16x4 vlo[16],vhi[16]; u32x4 pw0,pw1,pw2,pw3;
  #define PKW(P,B) cvtpk_s(P[B],P[B+1])
  #define PAF(k) __builtin_bit_cast(bf16x8,pw##k)
  #define VFR(i) (bf16x8){vlo[i][0],vlo[i][1],vlo[i][2],vlo[i][3],vhi[i][0],vhi[i][1],vhi[i][2],vhi[i][3]}
  #define PIN(x) asm volatile("":"+v"(x))
  #define MX3(a,b,c) __builtin_fmaxf(__builtin_fmaxf((a),(b)),(c))
  #define GAPA(MF,A0,A1,A2,A3,W0,W1,PW) do{ MF; sacc+=A0; sacc+=A1; sacc+=A2; sacc+=A3; PIN(sacc); W0; W1; PIN(PW); SBAR(); }while(0)
  #define EX(v) __builtin_amdgcn_exp2f(v)
  #define GAPB(MF,X,B) do{ MF; X[B]=EX(X[B]-mhat); X[B+1]=EX(X[B+1]-mhat); PIN(X); SBAR(); }while(0)
  #define VRD(f) do{ vlo[f]=vtr(vp_+(((f)&3)*4096+((f)>>2)*1024)); vhi[f]=vtr(vp_+(((f)&3)*4096+((f)>>2)*1024+512)); }while(0)
  #define KRD(G,j) do{ if(G){ kload2(kf,kp0+sl_next,j); SBAR(); } }while(0)
  #define STEP(C0,C1,P0,P1,t,GK,GV,GL) do{ SBAR(); \
    const lds_cptr vp_=vp0+2*sl_prev; \
    float sacc=(P0[0]+P0[1]); \
    GAPA(C0=__builtin_amdgcn_mfma_f32_32x32x16_bf16(kf[0],qr[0],zero16,0,0,0), P0[2],P0[3],P0[4],P0[5],     pw0[0]=PKW(P0,0), pw0[1]=PKW(P0,2), pw0); \
    GAPA(C1=__builtin_amdgcn_mfma_f32_32x32x16_bf16(kf[1],qr[0],zero16,0,0,0), P0[6],P0[7],P0[8],P0[9],     pw0[2]=PKW(P0,4), pw0[3]=PKW(P0,6), pw0); \
    GAPA(C0=__builtin_amdgcn_mfma_f32_32x32x16_bf16(kf[2],qr[1],C0,0,0,0),   P0[10],P0[11],P0[12],P0[13], pw1[0]=PKW(P0,8), pw1[1]=PKW(P0,10), pw1); \
    GAPA(C1=__builtin_amdgcn_mfma_f32_32x32x16_bf16(kf[3],qr[1],C1,0,0,0),   P0[14],P0[15],P1[0],P1[1],   pw1[2]=PKW(P0,12),pw1[3]=PKW(P0,14), pw1); \
    VRD(0); SBAR(); GAPA(C0=__builtin_amdgcn_mfma_f32_32x32x16_bf16(kf[4],qr[2],C0,0,0,0),   P1[2],P1[3],P1[4],P1[5],     pw2[0]=PKW(P1,0), pw2[1]=PKW(P1,2), pw2); \
    VRD(1); SBAR(); GAPA(C1=__builtin_amdgcn_mfma_f32_32x32x16_bf16(kf[5],qr[2],C1,0,0,0),   P1[6],P1[7],P1[8],P1[9],     pw2[2]=PKW(P1,4), pw2[3]=PKW(P1,6), pw2); \
    VRD(2); SBAR(); GAPA(C0=__builtin_amdgcn_mfma_f32_32x32x16_bf16(kf[6],qr[3],C0,0,0,0),   P1[10],P1[11],P1[12],P1[13], pw3[0]=PKW(P1,8), pw3[1]=PKW(P1,10), pw3); \
    VRD(3); SBAR(); GAPA(C1=__builtin_amdgcn_mfma_f32_32x32x16_bf16(kf[7],qr[3],C1,0,0,0),   P1[14],P1[15],0.f,0.f,       pw3[2]=PKW(P1,12),pw3[3]=PKW(P1,14), pw3); \
    l_reg+=sacc; \
    if(GK){DMA_K((t)+3,sl_cur);} if(GV){DMA_V((t)+1,sl_next);} \
    CMASK(C0,C1,t); \
    { float a=MX3(C0[0],C0[1],C1[0]),b=MX3(C0[2],C0[3],C1[1]); a=MX3(a,C1[2],C1[3]); \
      _Pragma("unroll") for(int r=4;r<16;r+=4){a=MX3(a,C0[r],C0[r+1]);b=MX3(b,C0[r+2],C0[r+3]);a=MX3(a,C1[r],C1[r+1]);b=MX3(b,C1[r+2],C1[r+3]);} \
      float rm=__builtin_fmaxf(a,b); { auto rr=__builtin_amdgcn_permlane32_swap(__float_as_uint(rm),__float_as_uint(rm),false,false); rm=__builtin_fmaxf(__uint_as_float(rr[0]),__uint_as_float(rr[1])); } \
      rm-=mhat; resc=false;     \
      if(__builtin_expect(__any(rm>(float)THRL),0)){ const float dl=__builtin_fmaxf(rm,0.f); mhat+=dl; \
        const float f=__builtin_amdgcn_exp2f(-dl); l_reg*=f; if(hi==0)wsf[r32]=f; resc=true; } } \
    SBAR(); \
    VRD(4);  SBAR(); GAPB(o[0]=__builtin_amdgcn_mfma_f32_32x32x16_bf16(PAF(0),VFR(0),o[0],0,0,0),  C0,0); \
    VRD(5);  SBAR(); GAPB(o[1]=__builtin_amdgcn_mfma_f32_32x32x16_bf16(PAF(0),VFR(1),o[1],0,0,0),  C0,2); \
    VRD(6);  SBAR(); GAPB(o[2]=__builtin_amdgcn_mfma_f32_32x32x16_bf16(PAF(0),VFR(2),o[2],0,0,0),  C0,4); \
    VRD(7);  SBAR(); GAPB(o[3]=__builtin_amdgcn_mfma_f32_32x32x16_bf16(PAF(0),VFR(3),o[3],0,0,0),  C0,6); \
    VRD(8);  SBAR(); GAPB(o[0]=__builtin_amdgcn_mfma_f32_32x32x16_bf16(PAF(1),VFR(4),o[0],0,0,0),  C0,8); \
    VRD(9);  SBAR(); GAPB(o[1]=__builtin_amdgcn_mfma_f32_32x32x16_bf16(PAF(1),VFR(5),o[1],0,0,0),  C0,10); \
    VRD(10); SBAR(); GAPB(o[2]=__builtin_amdgcn_mfma_f32_32x32x16_bf16(PAF(1),VFR(6),o[2],0,0,0),  C0,12); \
    VRD(11); SBAR(); GAPB(o[3]=__builtin_amdgcn_mfma_f32_32x32x16_bf16(PAF(1),VFR(7),o[3],0,0,0),  C0,14); \
    VRD(12); SBAR(); GAPB(o[0]=__builtin_amdgcn_mfma_f32_32x32x16_bf16(PAF(2),VFR(8),o[0],0,0,0),  C1,0); \
    VRD(13); SBAR(); GAPB(o[1]=__builtin_amdgcn_mfma_f32_32x32x16_bf16(PAF(2),VFR(9),o[1],0,0,0),  C1,2); \
    VRD(14); SBAR(); GAPB(o[2]=__builtin_amdgcn_mfma_f32_32x32x16_bf16(PAF(2),VFR(10),o[2],0,0,0), C1,4); \
    VRD(15); SBAR(); GAPB(o[3]=__builtin_amdgcn_mfma_f32_32x32x16_bf16(PAF(2),VFR(11),o[3],0,0,0), C1,6); \
    KRD(GL,0); GAPB(o[0]=__builtin_amdgcn_mfma_f32_32x32x16_bf16(PAF(3),VFR(12),o[0],0,0,0), C1,8); \
    KRD(GL,1); GAPB(o[1]=__builtin_amdgcn_mfma_f32_32x32x16_bf16(PAF(3),VFR(13),o[1],0,0,0), C1,10); \
    KRD(GL,2); GAPB(o[2]=__builtin_amdgcn_mfma_f32_32x32x16_bf16(PAF(3),VFR(14),o[2],0,0,0), C1,12); \
    KRD(GL,3); GAPB(o[3]=__builtin_amdgcn_mfma_f32_32x32x16_bf16(PAF(3),VFR(15),o[3],0,0,0), C1,14); \
    }while(0)
  int t=1;
  #undef CMASK
  #define CMASK(P0,P1,t) do{}while(0)
  for(;t+5<NT;t+=2){
    STEP(pB0,pB1,pA0,pA1,t,true,true,true);     WAIT_BAR(3); RESC(); ROT();
    STEP(pA0,pA1,pB0,pB1,t+1,true,true,true);   WAIT_BAR(3); RESC(); ROT();
  }
  #undef CMASK
  #define CMASK(P0,P1,t) do{int jb_=(t)-(NT-4); if(jb_>=0)cmask(P0,P1,jb_,qrel,hi);}while(0)
  #define ENDW(tt) do{ if((tt)+3<NT){WAIT_BAR(3);} else if((tt)+2<NT){WAIT_BAR(2);} else {WAIT_BAR(0);} }while(0)
  for(;t+1<NT;t+=2){
    STEP(pB0,pB1,pA0,pA1,t,(t+3<NT),(t+1<NT),(t+1<NT));       ENDW(t);   RESC(); ROT();
    STEP(pA0,pA1,pB0,pB1,t+1,(t+4<NT),(t+2<NT),(t+2<NT));     ENDW(t+1); RESC(); ROT();
  }
  STEP(pB0,pB1,pA0,pA1,NT-1,false,false,false); RESC();
  { float sacc=pB0[0]+pB0[1]; _Pragma("unroll") for(int r=2;r<16;++r)sacc+=pB0[r]; _Pragma("unroll") for(int r=0;r<16;++r)sacc+=pB1[r]; l_reg+=sacc;
    pw0=(u32x4){PKW(pB0,0),PKW(pB0,2),PKW(pB0,4),PKW(pB0,6)};pw1=(u32x4){PKW(pB0,8),PKW(pB0,10),PKW(pB0,12),PKW(pB0,14)};pw2=(u32x4){PKW(pB1,0),PKW(pB1,2),PKW(pB1,4),PKW(pB1,6)};pw3=(u32x4){PKW(pB1,8),PKW(pB1,10),PKW(pB1,12),PKW(pB1,14)};
    SBAR(); pv(o,vb0+2*sl_cur,PAF(0),PAF(1),PAF(2),PAF(3)); }
  #undef PKW
  #undef PAF
  #undef VFR
  #undef PIN
  #undef MX3
  #undef GAPA
  #undef GAPB
  #undef EX
  #undef VRD
  #undef KRD
  #undef STEP
  #undef ENDW
  {auto rr=__builtin_amdgcn_permlane32_swap(__float_as_uint(l_reg),__float_as_uint(l_reg),false,false);l_reg=__uint_as_float(rr[0])+__uint_as_float(rr[1]);}
  if(hi==0)wsf[32+r32]=l_reg;asm volatile("s_waitcnt lgkmcnt(0)":::"memory");
  float rli[16];
  #pragma unroll
  for(int r=0;r<16;++r)rli[r]=__builtin_amdgcn_rcpf(wsf[32+crow(r,hi)]);
  bf16*Ow=O+(rowbase+q0+wid*QBLK)*DM+vcol;
  { bf16*stg=(bf16*)(shm+LDS_OST)+wid*2048;
    #pragma unroll
    for(int h2=0;h2<2;++h2){
      #pragma unroll
      for(int r=0;r<16;++r){const int orow=crow(r,hi);
        #pragma unroll
        for(int d0=0;d0<2;++d0)stg[orow*64+d0*32+r32]=__float2bfloat16(o[2*h2+d0][r]*rli[r]);}
      asm volatile("s_waitcnt lgkmcnt(0)":::"memory");
      #pragma unroll
      for(int i=0;i<4;++i){const int row=i*8+(lane>>3),ch=lane&7; const u32x4 v=*(const u32x4*)(stg+row*64+ch*8); ATTN_STORE16(Ow+(long)row*DM+64*h2+ch*8,v);}
      asm volatile("s_waitcnt lgkmcnt(0)":::"memory"); } }
  asm volatile("s_waitcnt lgkmcnt(0)\n\ts_barrier":::"memory");
  #undef DMA_K
  #undef DMA_V
  #undef CMASK
  #undef START
  #undef RESC
  #undef ROT
}
constexpr int ATTN_LDS_BYTES=LDS_BYTES;
struct AttnTensors { const bf16* Q; const bf16* K; const bf16* V; bf16* O0; bf16* O1; };
template<int THRL=8> __device__ __forceinline__ void attn_phase(char*lds,const AttnTensors&T,int vcu,int G,int tid){
  for(int i=0;;++i){
    int b,hc,qb;
    if(G==256){ if(i>=4)break; const int pr=vcu>>2; b=pr>>4; hc=pr&15; const int s=(vcu&3)+4*(i>>1); qb=(i&1)?15-s:s; }
    else { const int L=i*G+vcu; if(L>=BATCH*16*NQB)break; qb=L%NQB; hc=(L/NQB)&15; b=L/(NQB*16); }
    attn_unit<THRL>(b,hc*64,(hc>>1)*128,qb,T.Q,T.K,T.V,(hc&1)?T.O1:T.O0,lds,tid);
  }
}
#undef SBAR
#undef WAIT_BAR
}
constexpr int NWAVES = 8;
#ifndef MK_N_LAUNCHES
#define MK_N_LAUNCHES 1
#endif
constexpr int N_PHASES = 28;
constexpr bool MOE_DOWN_F8 = true;
constexpr unsigned DOWN_I8 = 3u;
constexpr int N_LAUNCHES = MK_N_LAUNCHES;
static_assert(N_LAUNCHES == 1 || N_LAUNCHES == N_PHASES, "MK_N_LAUNCHES is 1 or 28");

constexpr int DM = 2048, BATCH = 4, SEQ = 4096, M = BATCH * SEQ, DEPTH = 2, INC = 4608, FF = 7168, NEXP = 8, PLED = 256;
constexpr int MAXSLOT = 136 * 256;
constexpr float LAM_INIT0 = 0.2f, LAM_INIT1 = 0.35550906759f;
constexpr size_t MiB = 1u << 20;
constexpr size_t WS_CTL = 0, CTL_ZERO_BYTES = 256 * 1024;
constexpr size_t WS_HIST = 1 * MiB;
constexpr size_t WS_ROPE = 2 * MiB;
constexpr size_t WS_SEL = 3 * MiB;
constexpr size_t WS_SWGU = WS_HIST + 65536;
constexpr size_t WS_SWIN = WS_HIST + 65536 + 524288, WS_SWPG = WS_HIST + 640 * 1024;
constexpr size_t WS_SWD = WS_HIST + 704 * 1024, WS_SAH = WS_HIST + 800 * 1024;
constexpr int CW_DMAX = 32768;
constexpr size_t WS_SATOK = WS_SEL + 640 * 1024, WS_SAS = WS_SEL + 768 * 1024;
constexpr size_t WS_WIN = 4 * MiB, WS_WOUT = 40 * MiB, WS_BD = 56 * MiB, WS_WPG = 60 * MiB, WS_WPP = 76 * MiB, WS_PBF = 78 * MiB;
constexpr size_t WS_WOHI = 68 * MiB;
constexpr size_t WS_WGUD = 94 * MiB, WS_WDD = 122 * MiB, WS_WGUE = 150 * MiB, WS_WDE = 374 * MiB, WS_HPQ = 598 * MiB;
constexpr size_t WS_U = 850 * MiB, WS_PP = 914 * MiB;
constexpr size_t WS_Q = 978 * MiB, WS_K = 1010 * MiB, WS_V = 1042 * MiB, WS_ZP = 1074 * MiB, WS_CG = 1090 * MiB, WS_O0 = 1106 * MiB, WS_O1 = 1138 * MiB, WS_DS = 1170 * MiB, WS_CAT = 1202 * MiB;
constexpr size_t WS_XP = 978 * MiB, WS_Y = 1114 * MiB;
constexpr size_t WS_HP = 1266 * MiB, WS_END = 1742 * MiB;
static_assert(WS_XP + (size_t)MAXSLOT * DM * 2 <= WS_Y && WS_Y + (size_t)MAXSLOT * DM * 2 <= WS_HP && WS_HP + (size_t)MAXSLOT * FF * 2 <= WS_END, "d_ws map");
static_assert(WS_WDE + (size_t)NEXP * DM * FF * 2 <= WS_HPQ && WS_HPQ + (size_t)MAXSLOT * FF <= WS_U && WS_WGUE + (size_t)NEXP * 2 * FF * DM <= WS_WDE && WS_WGUD + (size_t)2 * FF * DM <= WS_WDD && WS_WDD + (size_t)DM * FF * 2 <= WS_WGUE && WS_CAT + (size_t)M * DM * 2 <= WS_HP, "d_ws map");
constexpr int CW_TMO = 0, CW_CODE = 1, CW_BAR = 4096;
constexpr int RING_OFF = 0, RING_BYTES = 131072;
constexpr int LDSCTL_OFF = RING_BYTES, MISC_OFF = LDSCTL_OFF + 320;
constexpr int MOE_OFF = LDSCTL_OFF;
constexpr int PTR_OFF = MISC_OFF + 128;
constexpr int CM_OFF = PTR_OFF + 256;
constexpr int LDS_BYTES = 147456;
static_assert(CM_OFF + 128 <= LDS_BYTES, "LDS map");

#define GAS __attribute__((address_space(1)))
#define LAS __attribute__((address_space(3)))
typedef unsigned short bf16;
typedef unsigned v4u __attribute__((ext_vector_type(4)));
typedef unsigned v2u __attribute__((ext_vector_type(2)));
typedef int v4i __attribute__((ext_vector_type(4)));
typedef float f32x4 __attribute__((ext_vector_type(4)));
typedef short bf16x8 __attribute__((ext_vector_type(8)));
typedef GAS unsigned gu32;
typedef GAS unsigned long long gu64;
#define RLX_AGENT __ATOMIC_RELAXED, __HIP_MEMORY_SCOPE_AGENT
#define LDS_WAIT() asm volatile("s_waitcnt lgkmcnt(0)" ::: "memory")
#define VM_WAIT() asm volatile("s_waitcnt vmcnt(0)" ::: "memory")
__device__ __forceinline__ unsigned f2bf(float f) { unsigned u = __builtin_bit_cast(unsigned, f); return (u + 0x7fffu + ((u >> 16) & 1u)) >> 16; }
__device__ __forceinline__ unsigned pk2(float lo, float hi) { return f2bf(lo) | (f2bf(hi) << 16); }
__device__ __forceinline__ float bflo(unsigned w) { return __uint_as_float(w << 16); }
__device__ __forceinline__ float bfhi(unsigned w) { return __uint_as_float(w & 0xffff0000u); }
__device__ __forceinline__ float sigm(float x) { return __builtin_amdgcn_rcpf(1.0f + __builtin_amdgcn_exp2f(-1.4426950408889634f * x)); }

#define XB_TMO      128
#define XB_XCNT(j)  (256  + 64 * (j))
#define XB_XSUB(j)  (1280 + 64 * (j))
#define XB_XGEN(j)  (2304 + 64 * (j))
#define XB_TOP      3328
#define XB_TOPGEN   3392
#define XCD_BAR_WORDS 3456
#define XB_SPIN_CAP (1u << 18)

__device__ __forceinline__ unsigned xb_ld(unsigned* p)              { return __hip_atomic_load(p, __ATOMIC_RELAXED, __HIP_MEMORY_SCOPE_AGENT); }
__device__ __forceinline__ unsigned xb_add(unsigned* p, unsigned v) { return __hip_atomic_fetch_add(p, v, __ATOMIC_RELAXED, __HIP_MEMORY_SCOPE_AGENT); }
__device__ __forceinline__ unsigned xb_xcc_id() { return (unsigned)__builtin_amdgcn_s_getreg((3 << 11) | 20) & 0xFu; }
#define XB_SPIN(cond, bar) do { unsigned _sp = 0; while (cond) { __builtin_amdgcn_s_sleep(1); \
    if ((++_sp & 255u) == 0u) { if (xb_ld(&(bar)[XB_TMO])) break; if (_sp > XB_SPIN_CAP) { atomicAdd(&(bar)[XB_TMO], 1u); break; } } } } while (0)

struct XcdBarrier {
    unsigned* bar; unsigned x;
    volatile LAS unsigned* st;
};

__device__ __forceinline__ XcdBarrier xcd_barrier_post(unsigned* bar, volatile LAS unsigned* st) {
    XcdBarrier b; b.bar = bar; b.x = xb_xcc_id(); b.st = st;
    if (threadIdx.x == 0) (void)xb_add(&bar[XB_XCNT(b.x)], 1u);
    return b;
}
__device__ __forceinline__ void xcd_barrier_complete(unsigned* bar, unsigned x, unsigned& nloc, unsigned& nx) {
    const unsigned G = gridDim.x * gridDim.y * gridDim.z;
    unsigned sum, cnt, mine, sp = 0u;
    for (;;) {
        sum = 0u; cnt = 0u; mine = 0u;
#pragma unroll
        for (unsigned j = 0; j < 16; ++j) { const unsigned c = xb_ld(&bar[XB_XCNT(j)]); sum += c; cnt += (c > 0u) ? 1u : 0u; mine = (j == x) ? c : mine; }
        if (sum == G) break;
        __builtin_amdgcn_s_sleep(1);
        if ((++sp & 255u) == 0u) { if (xb_ld(&bar[XB_TMO])) break; if (sp > XB_SPIN_CAP) { atomicAdd(&bar[XB_TMO], 1u); break; } }
    }
    nloc = mine > 0u ? mine : 1u; nx = cnt > 0u ? cnt : 1u;
}

__device__ __forceinline__ void xcd_barrier(const XcdBarrier& b, const bool leader  ) {
    asm volatile("s_waitcnt vmcnt(0)" ::: "memory");
    __syncthreads();
    if (leader) {
        unsigned* bar = b.bar;
        __builtin_amdgcn_s_waitcnt(0);
        unsigned nloc = b.st[0], nx = b.st[1];
        if (nloc == 0u) { xcd_barrier_complete(bar, b.x, nloc, nx); b.st[0] = nloc; b.st[1] = nx; }
        const unsigned old = xb_add(&bar[XB_XSUB(b.x)], 1u);
        const unsigned gen = old / nloc;
        if (old + 1u == (gen + 1u) * nloc) {
            __builtin_amdgcn_fence(__ATOMIC_RELEASE, "agent");
            asm volatile("s_waitcnt vmcnt(0)" ::: "memory");
            const unsigned og = xb_add(&bar[XB_TOP], 1u);
            const unsigned tg = og / nx;
            if (og + 1u == (tg + 1u) * nx) xb_add(&bar[XB_TOPGEN], 1u);
            else XB_SPIN(xb_ld(&bar[XB_TOPGEN]) == tg, bar);
            __builtin_amdgcn_fence(__ATOMIC_ACQUIRE, "agent");
            xb_add(&bar[XB_XGEN(b.x)], 1u);
            asm volatile("s_waitcnt vmcnt(0)" ::: "memory");
        } else {
            XB_SPIN(xb_ld(&bar[XB_XGEN(b.x)]) == gen, bar);
            __builtin_amdgcn_fence(__ATOMIC_ACQUIRE, "agent");
            asm volatile("s_waitcnt vmcnt(0)" ::: "memory");
        }
    }
    __syncthreads();
}

struct Frame {
    LAS unsigned char* lds;
    int tid, lane, wave, vcu, G;
    __device__ __forceinline__ const void* ptr(int k) const { const LAS unsigned* t = (const LAS unsigned*)(lds + PTR_OFF) + 2 * k;
        const unsigned lo = (unsigned)__builtin_amdgcn_readfirstlane((int)t[0]), hi = (unsigned)__builtin_amdgcn_readfirstlane((int)t[1]); return (const void*)(const GAS unsigned char*)(((unsigned long long)hi << 32) | lo); }
    __device__ __forceinline__ const float* inf(int k) const { return (const float*)ptr(k); }
    __device__ __forceinline__ float* outp() const { return (float*)ptr(30); }
    __device__ __forceinline__ unsigned char* wsp() const { return (unsigned char*)ptr(31); }
};
__device__ __forceinline__ Frame make_frame(LAS unsigned char* lds, int wave_s) {
    Frame F; int tid = wave_s * 64 + (int)__builtin_amdgcn_mbcnt_hi(~0u, __builtin_amdgcn_mbcnt_lo(~0u, 0u)); asm volatile("" : "+v"(tid)); asm volatile("" ::: "memory");
    { unsigned lb = (unsigned)(unsigned long long)lds; asm volatile("" : "+s"(lb)); F.lds = (LAS unsigned char*)lb; }
    F.tid = tid; F.lane = tid & 63; F.wave = __builtin_amdgcn_readfirstlane(tid >> 6);
    F.G = gridDim.x; { const int bx = blockIdx.x; F.vcu = (F.G % 8 == 0) ? (bx % 8) * (F.G / 8) + bx / 8 : bx; }
    return F;
}
template <int CTRL, int ROWMASK> __device__ __forceinline__ float dpp_mov(float old, float v) { return __int_as_float(__builtin_amdgcn_update_dpp(__float_as_int(old), __float_as_int(v), CTRL, ROWMASK, 0xf, false)); }
__device__ __forceinline__ float row8_sum(float v) {
    v += dpp_mov<0xB1, 0xf>(0.f, v); v += dpp_mov<0x4E, 0xf>(0.f, v); v += dpp_mov<0x141, 0xf>(0.f, v); return v; }
__device__ __forceinline__ float wave_sum(float v) {
    v = row8_sum(v); v += dpp_mov<0x140, 0xf>(0.f, v);
    v += dpp_mov<0x142, 0xa>(0.f, v); v += dpp_mov<0x143, 0xc>(0.f, v);
    return __int_as_float(__builtin_amdgcn_readlane(__float_as_int(v), 63));
}
__device__ __forceinline__ int wave_sum_i(int v) {
#define DPPI(ctrl, rm) __builtin_amdgcn_update_dpp(0, v, ctrl, rm, 0xf, false)
    v += DPPI(0xB1, 0xf); v += DPPI(0x4E, 0xf); v += DPPI(0x141, 0xf); v += DPPI(0x140, 0xf); v += DPPI(0x142, 0xa); v += DPPI(0x143, 0xc);
#undef DPPI
    return __builtin_amdgcn_readlane(v, 63);
}
__device__ __forceinline__ float max_x8_x16(float a) {
    a = fmaxf(a, dpp_mov<0x128, 0xf>(a, a));
    a = fmaxf(a, __int_as_float(__builtin_amdgcn_ds_swizzle(__float_as_int(a), 0x401F)));
    return a;
}
__device__ __forceinline__ float wave_max(float v) {
    v = fmaxf(v, dpp_mov<0xB1, 0xf>(v, v)); v = fmaxf(v, dpp_mov<0x4E, 0xf>(v, v)); v = fmaxf(v, dpp_mov<0x141, 0xf>(v, v)); v = fmaxf(v, dpp_mov<0x140, 0xf>(v, v));
    v = fmaxf(v, dpp_mov<0x142, 0xa>(v, v)); v = fmaxf(v, dpp_mov<0x143, 0xc>(v, v));
    return __int_as_float(__builtin_amdgcn_readlane(__float_as_int(v), 63));
}
enum { MAP_ID = 0, MAP_WIN = 1, MAP_GU0 = 2, MAP_GU1 = 3 };
__device__ __forceinline__ int dst_row(int mode, int n) {
    if (mode == MAP_ID) return n;
    if (mode == MAP_WIN) {
        if (n < 2048) { const int d = n & 63, b = n & ~63; const int p = d < 8 ? 2 * d : (d < 16 ? 2 * (d - 8) + 1 : d); return b + p; }
        if (n < 3584) return n;
        if (n < 4096) { const int ch = n - 3584; return 3584 + 256 * (ch >> 7) + (ch & 127); }
        { const int ch = n - 4096; return 3584 + 256 * (ch >> 7) + 128 + (ch & 127); }
    }
    return 256 * (n >> 7) + (mode == MAP_GU1 ? 128 : 0) + (n & 127);
}
__device__ __forceinline__ void p0_transpose_item(const float* W, int K, int N, bf16* WT, int mode, LAS float* scr, int item, int lane, int ldt = 0) {
    if (ldt == 0) ldt = K;
    const int nblk = N / 32, kb = item / nblk, nb = item % nblk, k0 = 64 * kb, n0 = 32 * nb;
    float tv[32];
#pragma unroll
    for (int i = 0; i < 32; ++i) { const int kk = 2 * i + (lane >> 5); tv[i] = W[(size_t)(k0 + kk) * N + n0 + (lane & 31)]; }
#pragma unroll
    for (int i = 0; i < 32; ++i) { const int kk = 2 * i + (lane >> 5); scr[kk * 33 + (lane & 31)] = tv[i]; }
    LDS_WAIT(); asm volatile("" ::: "memory");
    const int c = lane & 7;
#pragma unroll
    for (int j = 0; j < 4; ++j) { const int n = (lane >> 3) + 8 * j; const LAS float* s = scr + (8 * c) * 33 + n;
        v4u o; o.x = pk2(s[0 * 33], s[1 * 33]); o.y = pk2(s[2 * 33], s[3 * 33]); o.z = pk2(s[4 * 33], s[5 * 33]); o.w = pk2(s[6 * 33], s[7 * 33]);
        *(GAS v4u*)(WT + (size_t)dst_row(mode, n0 + n) * ldt + k0 + 8 * c) = o; }
    LDS_WAIT(); asm volatile("" ::: "memory");
}
__device__ __forceinline__ unsigned q4_i8(float a, float b, float c, float d, float iv) {
    const float MG = 12582912.f;
    const unsigned A = __float_as_uint(__builtin_fmaf(a, iv, MG)), B = __float_as_uint(__builtin_fmaf(b, iv, MG)), C = __float_as_uint(__builtin_fmaf(c, iv, MG)), D = __float_as_uint(__builtin_fmaf(d, iv, MG));
    return __builtin_amdgcn_perm(B, A, 0x0c0c0400u) | __builtin_amdgcn_perm(D, C, 0x04000c0cu);
}
struct StripJob { const float* W; unsigned char* W8; float* sw; int N, n0, mode; };
#define LDS_BAR() asm volatile("s_waitcnt lgkmcnt(0)\n\ts_barrier" ::: "memory")
__device__ __forceinline__ StripJob strip_job(Frame& F, int st0) {
    constexpr int NS_IN = 2 * (INC / 32), NS_PG = 2 * (DM / 32);
    StripJob j;
    if (st0 < NS_IN) { const int L = st0 / (INC / 32), nb = st0 % (INC / 32);
        j.W = (const float*)F.ptr(4) + (size_t)L * DM * INC; j.N = INC; j.n0 = 32 * nb; j.mode = MAP_WIN; j.W8 = (unsigned char*)(F.wsp() + WS_WIN) + (size_t)L * INC * DM; j.sw = (float*)(F.wsp() + WS_SWIN) + L * INC; return j; }
    if (st0 < NS_IN + NS_PG) { const int q2 = st0 - NS_IN, L = q2 / (DM / 32), nb = q2 % (DM / 32);
        j.W = (const float*)F.ptr(27) + (size_t)L * DM * DM; j.N = DM; j.n0 = 32 * nb; j.mode = MAP_ID; j.W8 = (unsigned char*)(F.wsp() + WS_WPG) + (size_t)L * DM * DM; j.sw = (float*)(F.wsp() + WS_SWPG) + L * DM; return j; }
    const int st = st0 - NS_IN - NS_PG, s = st / (2 * (FF / 32)), q = st % (2 * (FF / 32)), which = q / (FF / 32), nb = q % (FF / 32);
    j.W = s == 0 ? (const float*)F.ptr(which ? 20 : 19) : (const float*)F.ptr(which ? 24 : 23) + (size_t)(s - 1) * DM * FF; j.N = FF; j.n0 = 32 * nb; j.mode = which ? MAP_GU1 : MAP_GU0;
    j.W8 = (unsigned char*)(F.wsp() + (s == 0 ? WS_WGUD : WS_WGUE)) + (s == 0 ? (size_t)0 : (size_t)(s - 1) * 2 * FF * DM); j.sw = (float*)(F.wsp() + WS_SWGU) + (size_t)s * 2 * FF; return j;
}
__device__ __forceinline__ void strip_load(Frame& F, const StripJob& j, f32x4 (&v)[8][4]) {
    const int c4 = F.lane & 7, rs = F.lane >> 3;
    const GAS unsigned char* Wb = (const GAS unsigned char*)((const GAS float*)j.W + j.n0); const unsigned toff = (unsigned)((32 * F.wave + 4 * rs) * j.N + 4 * c4) * 4u;
#pragma unroll
    for (int it = 0; it < 8; ++it)
#pragma unroll
        for (int jj = 0; jj < 4; ++jj) v[it][jj] = __builtin_nontemporal_load((const GAS f32x4*)(Wb + (size_t)(256 * it + jj) * (size_t)j.N * 4 + toff));
}
__device__ __forceinline__ void strip_quant(Frame& F, const StripJob& j, f32x4 (&v)[8][4], bool hasn, const StripJob& nj) {
    LAS unsigned* cm = (LAS unsigned*)(F.lds + CM_OFF); LAS unsigned* lq = (LAS unsigned*)(F.lds + RING_OFF);
    const int c4 = F.lane & 7, rs = F.lane >> 3;
    if (F.tid < 32) cm[F.tid] = 0u;
    f32x4 am = (f32x4){0.f, 0.f, 0.f, 0.f};
#pragma unroll
    for (int it = 0; it < 8; ++it)
#pragma unroll
        for (int jj = 0; jj < 4; ++jj)
#pragma unroll
            for (int cc = 0; cc < 4; ++cc) am[cc] = fmaxf(am[cc], fabsf(v[it][jj][cc]));
#pragma unroll
    for (int cc = 0; cc < 4; ++cc) am[cc] = max_x8_x16(am[cc]);
    LDS_BAR();
    if ((F.lane & 31) < 8) {
#pragma unroll
        for (int cc = 0; cc < 4; ++cc) atomicMax((unsigned*)&cm[4 * c4 + cc], __float_as_uint(am[cc])); }
    LDS_BAR();
    float iv[4];
#pragma unroll
    for (int cc = 0; cc < 4; ++cc) { const float mx = __uint_as_float(cm[4 * c4 + cc]); iv[cc] = mx > 0.f ? 127.f / mx : 0.f; }
    const GAS unsigned char* nWb = (const GAS unsigned char*)((const GAS float*)nj.W + nj.n0); const unsigned ntoff = (unsigned)((32 * F.wave + 4 * rs) * nj.N + 4 * c4) * 4u;
    if (F.tid < 32) { const float mx = __uint_as_float(cm[F.tid]); j.sw[dst_row(j.mode, j.n0 + F.tid)] = mx > 0.f ? mx * (1.f / 127.f) : 1.f; }
#pragma unroll
    for (int it = 0; it < 8; ++it) { const int kd = 64 * it + 8 * F.wave + rs;
#pragma unroll
        for (int cc = 0; cc < 4; ++cc) { const int n = 4 * c4 + cc; lq[n * 512 + (kd ^ n)] = q4_i8(v[it][0][cc], v[it][1][cc], v[it][2][cc], v[it][3][cc], iv[cc]); }
        if (hasn) {
#pragma unroll
            for (int jj = 0; jj < 4; ++jj) v[it][jj] = __builtin_nontemporal_load((const GAS f32x4*)(nWb + (size_t)(256 * it + jj) * (size_t)nj.N * 4 + ntoff)); } }
    LDS_BAR();
#pragma unroll
    for (int i = 0; i < 8; ++i) { const int nn = 4 * i + (F.wave >> 1), c = 64 * (F.wave & 1) + F.lane;
        v4u x = ((const LAS v4u*)lq)[nn * 128 + (c ^ (nn >> 2))];
        if (nn & 1) { unsigned t = x.x; x.x = x.y; x.y = t; t = x.z; x.z = x.w; x.w = t; }
        if (nn & 2) { unsigned t = x.x; x.x = x.z; x.z = t; t = x.y; x.y = x.w; x.w = t; }
        *(GAS v4u*)(j.W8 + (size_t)dst_row(j.mode, j.n0 + nn) * 2048 + 16 * c) = x; }
    LDS_BAR();
}
__device__ __forceinline__ bool down_i8_set(int s) { return s == 0 ? (DOWN_I8 & 1u) != 0u : (DOWN_I8 & 2u) != 0u; }
__device__ __forceinline__ void p0_down_amax(Frame& F) {
    const int s = F.vcu % 9, idx = F.vcu / 9;
    if (F.vcu >= 252 || !down_i8_set(s)) return;
    const float* wd = s == 0 ? (const float*)F.ptr(21) : (const float*)F.ptr(25) + (size_t)(s - 1) * FF * DM;
    LAS unsigned* lm = (LAS unsigned*)(F.lds + RING_OFF);
    __syncthreads();
    for (int i = F.tid; i < DM; i += NWAVES * 64) lm[i] = 0u;
    __syncthreads();
    f32x4 mx[8];
#pragma unroll
    for (int j = 0; j < 8; ++j) mx[j] = (f32x4){0.f, 0.f, 0.f, 0.f};
#pragma unroll 2
    for (int r = F.wave; r < 256; r += NWAVES) { const GAS f32x4* p = (const GAS f32x4*)(wd + (size_t)(idx * 256 + r) * DM) + F.lane;
#pragma unroll
        for (int j = 0; j < 8; ++j) { const f32x4 v = p[64 * j]; mx[j].x = fmaxf(mx[j].x, fabsf(v.x)); mx[j].y = fmaxf(mx[j].y, fabsf(v.y)); mx[j].z = fmaxf(mx[j].z, fabsf(v.z)); mx[j].w = fmaxf(mx[j].w, fabsf(v.w)); } }
#pragma unroll
    for (int j = 0; j < 8; ++j) { const int c = 4 * (F.lane + 64 * j); atomicMax((unsigned*)&lm[c], __float_as_uint(mx[j].x)); atomicMax((unsigned*)&lm[c + 1], __float_as_uint(mx[j].y)); atomicMax((unsigned*)&lm[c + 2], __float_as_uint(mx[j].z)); atomicMax((unsigned*)&lm[c + 3], __float_as_uint(mx[j].w)); }
    __syncthreads();
    unsigned* dmax = (unsigned*)(F.wsp() + WS_CTL) + CW_DMAX + s * DM;
    for (int i = F.tid; i < DM; i += NWAVES * 64) atomicMax(dmax + i, lm[i]);
    __syncthreads();
}
struct DqJob { const float* W; unsigned char* W8; float* swd; const unsigned* dmaxp; int kbase, n0; };
__device__ __forceinline__ DqJob dq_job(Frame& F, int st) {
    constexpr int PER_SET = 4 * (DM / 32);
    const int s = st / PER_SET, q = st % PER_SET, kc = q / (DM / 32), nb = q % (DM / 32);
    DqJob j; j.W = s == 0 ? (const float*)F.ptr(21) : (const float*)F.ptr(25) + (size_t)(s - 1) * FF * DM;
    j.W8 = (unsigned char*)(F.wsp() + (s == 0 ? WS_WDD : WS_WDE)) + (s == 0 ? (size_t)0 : (size_t)(s - 1) * DM * FF);
    j.swd = (float*)(F.wsp() + WS_SWD) + s * DM; j.dmaxp = (const unsigned*)(F.wsp() + WS_CTL) + CW_DMAX + s * DM; j.kbase = 1792 * kc; j.n0 = 32 * nb; return j;
}
__device__ __forceinline__ void dq_sample_load(Frame& F, const DqJob& j, f32x4 (&sx)[4]) {
    const int c4 = F.lane & 7, rs = F.lane >> 3;
    const GAS unsigned char* Ws = (const GAS unsigned char*)((const GAS float*)j.W + j.n0) + (unsigned)((32 * (F.wave & 1) + 4 * rs) * DM + 4 * c4) * 4u;
#pragma unroll
    for (int q = 0; q < 4; ++q) sx[q] = *(const GAS f32x4*)(Ws + (size_t)q * DM * 4);
}
__device__ __forceinline__ const GAS unsigned char* dq_base(const DqJob& j) { return (const GAS unsigned char*)((const GAS float*)j.W + j.n0 + (size_t)j.kbase * DM); }
__device__ __forceinline__ void dq_process(Frame& F, const DqJob& j, f32x4 (&v)[7][4], f32x4 (&sx)[4], bool hasn, const DqJob& nj, bool f8) {
    constexpr int NIT = 28;
    LAS unsigned* lq = (LAS unsigned*)(F.lds + RING_OFF); LAS unsigned* cm = (LAS unsigned*)(F.lds + CM_OFF);
    const int c4 = F.lane & 7, rs = F.lane >> 3;
    float qmax = 127.f; float mx[4];
    if (f8) {
        f32x4 sm = (f32x4){0.f, 0.f, 0.f, 0.f};
#pragma unroll
        for (int q = 0; q < 4; ++q)
#pragma unroll
            for (int cc = 0; cc < 4; ++cc) sm[cc] = fmaxf(sm[cc], fabsf(sx[q][cc]));
#pragma unroll
        for (int cc = 0; cc < 4; ++cc) sm[cc] = max_x8_x16(sm[cc]);
        LDS_BAR();
        if (F.tid < 32) cm[F.tid] = 0u;
        LDS_BAR();
        if ((F.lane & 31) < 8) {
#pragma unroll
            for (int cc = 0; cc < 4; ++cc) atomicMax((unsigned*)&cm[4 * c4 + cc], __float_as_uint(sm[cc])); }
        LDS_BAR();
#pragma unroll
        for (int cc = 0; cc < 4; ++cc) mx[cc] = __uint_as_float(cm[4 * c4 + cc]);
        qmax = 28.f;
    } else {
#pragma unroll
        for (int cc = 0; cc < 4; ++cc) mx[cc] = __uint_as_float(j.dmaxp[j.n0 + 4 * c4 + cc]);
        LDS_BAR(); }
    if (hasn && f8) dq_sample_load(F, nj, sx);
    float iv[4];
#pragma unroll
    for (int cc = 0; cc < 4; ++cc) iv[cc] = mx[cc] > 0.f ? qmax / mx[cc] : 0.f;
    if (j.kbase == 0 && F.wave == 0 && rs == 0) {
#pragma unroll
        for (int cc = 0; cc < 4; ++cc) j.swd[j.n0 + 4 * c4 + cc] = mx[cc] > 0.f ? mx[cc] / qmax : 1.f; }
    const GAS unsigned char* nWb = dq_base(nj); const unsigned toff = (unsigned)((32 * F.wave + 4 * rs) * DM + 4 * c4) * 4u;
#pragma unroll
    for (int it = 0; it < 7; ++it) { const int kd = 64 * it + 8 * F.wave + rs;
#pragma unroll
        for (int cc = 0; cc < 4; ++cc) { const int n = 4 * c4 + cc; unsigned w;
            if (f8) w = pg8::cvt4_fp8(v[it][0][cc] * iv[cc], v[it][1][cc] * iv[cc], v[it][2][cc] * iv[cc], v[it][3][cc] * iv[cc]);
            else w = q4_i8(v[it][0][cc], v[it][1][cc], v[it][2][cc], v[it][3][cc], iv[cc]);
            lq[n * (16 * NIT) + (kd ^ n)] = w; }
        if (hasn) {
#pragma unroll
            for (int q = 0; q < 4; ++q) v[it][q] = __builtin_nontemporal_load((const GAS f32x4*)(nWb + (size_t)(256 * it + q) * DM * 4 + toff)); } }
    LDS_BAR();
#pragma unroll
    for (int i = 0; i < 7; ++i) { const int item = i * (NWAVES * 64) + F.tid, nn = item / (4 * NIT), c = item % (4 * NIT);
        const v4u x = ((const LAS v4u*)lq)[nn * (4 * NIT) + (c ^ (nn >> 2))]; const bool s1 = (nn & 1) != 0, s2 = (nn & 2) != 0;
        const unsigned a0 = s1 ? x.y : x.x, a1 = s1 ? x.x : x.y, a2 = s1 ? x.w : x.z, a3 = s1 ? x.z : x.w;
        v4u o; o.x = s2 ? a2 : a0; o.y = s2 ? a3 : a1; o.z = s2 ? a0 : a2; o.w = s2 ? a1 : a3;
        *(GAS v4u*)(j.W8 + (size_t)(j.n0 + nn) * FF + j.kbase + 16 * c) = o; }
}
__device__ __forceinline__ void down_q_items(Frame& F, int set_lo, int set_hi, int xb = 0, int xe = -1) {
    constexpr int PER_SET = 4 * (DM / 32);
    __syncthreads();
    const int slot = (F.vcu & 1) * (F.G >> 1) + (F.vcu >> 1);
    const int st0 = xe >= 0 ? xb : set_lo * PER_SET + slot, st1 = xe >= 0 ? xe : set_hi * PER_SET, stp = xe >= 0 ? 1 : F.G;
    f32x4 v[7][4], sx[4]; DqJob cur, nxt; int st = st0; bool has = st < st1;
    if (has) { cur = dq_job(F, st); if (MOE_DOWN_F8) dq_sample_load(F, cur, sx);
        const GAS unsigned char* Wb = dq_base(cur); const unsigned toff = (unsigned)((32 * F.wave + 4 * (F.lane >> 3)) * DM + 4 * (F.lane & 7)) * 4u;
#pragma unroll
        for (int it = 0; it < 7; ++it)
#pragma unroll
            for (int q = 0; q < 4; ++q) v[it][q] = __builtin_nontemporal_load((const GAS f32x4*)(Wb + (size_t)(256 * it + q) * DM * 4 + toff)); }
    while (has) { const int stn = st + stp; const bool hasn = stn < st1; if (hasn) nxt = dq_job(F, stn);
        dq_process(F, cur, v, sx, hasn, nxt, MOE_DOWN_F8);
        cur = nxt; st = stn; has = hasn; }
    __syncthreads();
}
__device__ __forceinline__ void hp_quant(Frame& F, int nrows) {
    const int gw = F.vcu * NWAVES + F.wave, NGW = F.G * NWAVES; unsigned char* wsb = F.wsp();
    const bf16* HP = (const bf16*)(wsb + WS_HP); unsigned char* HQ = wsb + WS_HPQ; float* sah = (float*)(wsb + WS_SAH);
    for (int row = gw; row < nrows; row += NGW) {
        const GAS v4u* src = (const GAS v4u*)(HP + (size_t)row * FF) + F.lane; v4u x[14]; float am = 0.f;
#pragma unroll
        for (int j = 0; j < 14; ++j) x[j] = src[64 * j];
#pragma unroll
        for (int j = 0; j < 14; ++j) { const unsigned a = x[j].x & 0x7fff7fffu, b = x[j].y & 0x7fff7fffu, c = x[j].z & 0x7fff7fffu, d = x[j].w & 0x7fff7fffu;
            am = fmaxf(fmaxf(am, fmaxf(bflo(a), bfhi(a))), fmaxf(fmaxf(bflo(b), bfhi(b)), fmaxf(fmaxf(bflo(c), bfhi(c)), fmaxf(bflo(d), bfhi(d))))); }
        am = wave_max(am); const float iv = am > 0.f ? 127.f / am : 0.f;
        GAS v2u* dst = (GAS v2u*)(HQ + (size_t)row * FF) + F.lane;
#pragma unroll
        for (int j = 0; j < 14; ++j) { const unsigned w[4] = {x[j].x, x[j].y, x[j].z, x[j].w}; unsigned o[2] = {0u, 0u};
#pragma unroll
            for (int q = 0; q < 4; ++q) { const int a = (int)__builtin_rintf(bflo(w[q]) * iv), b = (int)__builtin_rintf(bfhi(w[q]) * iv); o[q >> 1] |= (((unsigned)a & 0xffu) | (((unsigned)b & 0xffu) << 8)) << (16 * (q & 1)); }
            v2u ov; ov.x = o[0]; ov.y = o[1]; dst[64 * j] = ov; }
        if (F.lane == 0) sah[row] = am > 0.f ? am * (1.f / 127.f) : 1.f;
    }
}
constexpr int NS_XHALF = 864 + 1792  , NS_L0IN = INC / 32, NS_PRO = 256  , NS_WIN1 = NS_PRO + 96  , NS_IN_ = 2 * (INC / 32), NS_PG_ = 2 * (DM / 32), NS_P0 = NS_IN_ + NS_PG_ + 2 * (FF / 32), NSTRIP_ALL = NS_IN_ + NS_PG_ + 9 * 2 * (FF / 32);
__device__ __forceinline__ void strip_range(Frame& F, int s0, int s1, int xslot = -1, int xn = 0) {
    __syncthreads();
    const int slot = xn > 0 ? xslot : (s0 > 0 ? (F.vcu & 1) * (F.G >> 1) + (F.vcu >> 1) : F.vcu), nsl = xn > 0 ? xn : F.G;
    f32x4 v[8][4]; StripJob cur, nxt; int st = s0 + slot; bool has = st < s1;
    if (has) { cur = strip_job(F, st); strip_load(F, cur, v); }
    while (has) { const int stn = st + nsl; const bool hasn = stn < s1; if (hasn) nxt = strip_job(F, stn);
        strip_quant(F, cur, v, hasn, nxt);
        cur = nxt; st = stn; has = hasn; }
    __syncthreads();
}
__device__ __forceinline__ void p0_prologue(Frame& F) {
    LAS float* scr = (LAS float*)(F.lds + RING_OFF + F.wave * 16384);
    const int gw = F.vcu * NWAVES + F.wave, NGW = F.G * NWAVES;
    constexpr int I_IN = (DM / 64) * (INC / 32), I_SQ = (DM / 64) * (DM / 32), I_PP = (PLED / 64) * (DM / 32), I_GU = (DM / 64) * (FF / 32), I_DN = (FF / 64) * (DM / 32);
    constexpr int IL = I_SQ + I_PP, IFS = I_DN, NITEMS = 2 * IL + 9 * IFS;
    for (int it = gw; it < NITEMS; it += NGW) {
        int r = it;
        if (r < 2 * IL) { const int L = r / IL; r -= L * IL;
            if (r < I_SQ / 2) { p0_transpose_item((const float*)F.ptr(17) + (size_t)L * DM * DM, DM / 2, DM, (bf16*)(F.wsp() + WS_WOUT) + (size_t)L * DM * DM, MAP_ID, scr, r, F.lane, DM); continue; } r -= I_SQ / 2;
            if (r < I_SQ / 2) { p0_transpose_item((const float*)F.ptr(17) + (size_t)L * DM * DM + (size_t)(DM / 2) * DM, DM / 2, DM, (bf16*)(F.wsp() + WS_WOHI) + (size_t)L * DM * (DM / 2), MAP_ID, scr, r, F.lane); continue; } r -= I_SQ / 2;
            p0_transpose_item((const float*)F.ptr(28) + (size_t)L * PLED * DM, PLED, DM, (bf16*)(F.wsp() + WS_WPP) + (size_t)L * DM * PLED, MAP_ID, scr, r, F.lane); continue; }
        r -= 2 * IL;
        const int s = r / IFS; r -= s * IFS;
        if (down_i8_set(s)) continue;
        const float* wd; bf16* dn;
        if (s == 0) { wd = (const float*)F.ptr(21); dn = (bf16*)(F.wsp() + WS_WDD); }
        else { const size_t e = (size_t)(s - 1); wd = (const float*)F.ptr(25) + e * FF * DM; dn = (bf16*)(F.wsp() + WS_WDE) + e * DM * FF; }
        p0_transpose_item(wd, FF, DM, dn, MAP_ID, scr, r, F.lane);
    }
    strip_range(F, 0, NS_PRO, F.vcu, F.G);
    if (!MOE_DOWN_F8) p0_down_amax(F);
    const int gt = F.vcu * (NWAVES * 64) + F.tid, NT = F.G * NWAVES * 64;
    { const GAS f32x4* src = (const GAS f32x4*)F.ptr(1); GAS v2u* dst = (GAS v2u*)(F.wsp() + WS_PBF);
      for (int i0 = gt; i0 < DEPTH * M * PLED / 4; i0 += 8 * NT) { f32x4 v[8];
#pragma unroll
          for (int u = 0; u < 8; ++u) { const int i = i0 + u * NT; v[u] = (f32x4){0.f, 0.f, 0.f, 0.f}; if (i < DEPTH * M * PLED / 4) v[u] = __builtin_nontemporal_load(&src[i]); }
#pragma unroll
          for (int u = 0; u < 8; ++u) { const int i = i0 + u * NT; if (i < DEPTH * M * PLED / 4) { v2u o; o.x = pk2(v[u].x, v[u].y); o.y = pk2(v[u].z, v[u].w); dst[i] = o; } } } }
    { const int* pos = (const int*)F.ptr(2); float* rope = (float*)(F.wsp() + WS_ROPE);
      for (int i = gt; i < M * 8; i += NT) { const int tok = i >> 3, k = i & 7;
          const double inv = k == 0 ? 1.0 : k == 1 ? 0.19388721168191904 : k == 2 ? 0.03759225085361404 : k == 3 ? 0.007288656698743457 : k == 4 ? 0.0014142135623730951 : k == 5 ? 0.0002741979242171174 : k == 6 ? 5.316346907993441e-05 : 1.0307716781164267e-05;
          const double ang = (double)pos[tok] * inv;
          const double qd = __builtin_rint(ang * 0.6366197723675814); const double r = (ang - qd * 1.5707963267948966) - qd * 6.123233995736766e-17; const double r2 = r * r;
          double sp = r2 * (1.0 / 6227020800.0) - (1.0 / 39916800.0); sp = sp * r2 + (1.0 / 362880.0); sp = sp * r2 - (1.0 / 5040.0); sp = sp * r2 + (1.0 / 120.0); sp = sp * r2 - (1.0 / 6.0); const double sr = r + r * r2 * sp;
          double cp = r2 * (1.0 / 479001600.0) - (1.0 / 3628800.0); cp = cp * r2 + (1.0 / 40320.0); cp = cp * r2 - (1.0 / 720.0); cp = cp * r2 + (1.0 / 24.0); cp = cp * r2 - 0.5; const double cr = 1.0 + r2 * cp;
          const int qi = (int)qd & 3; const double cv = qi == 0 ? cr : qi == 1 ? -sr : qi == 2 ? -cr : sr, sv = qi == 0 ? sr : qi == 1 ? cr : qi == 2 ? -sr : -cr;
          rope[tok * 16 + k] = (float)cv; rope[tok * 16 + 8 + k] = (float)sv; } }
    { const float* wpool = (const float*)F.ptr(10); const float* pscale = (const float*)F.ptr(11); const float* wpw = (const float*)F.ptr(16); GAS unsigned* bd = (GAS unsigned*)(F.wsp() + WS_BD);
      for (int i0 = gt; i0 < DEPTH * 1024 * 512; i0 += 8 * NT) { unsigned ov[8];
#pragma unroll
          for (int u = 0; u < 8; ++u) { const int i = i0 + u * NT; const int L = (i >> 19) & 1, kp = (i >> 9) & 1023, j0 = (i & 511) * 2; float v[2];
#pragma unroll
              for (int q = 0; q < 2; ++q) { const int j = j0 + q; float x = 0.f;
                  if (i < DEPTH * 1024 * 512) {
                      if (kp < 512) { const int g = kp >> 7, c = kp & 127; if (j < 512 && (j >> 7) == g) x = wpool[(((size_t)L * 4 + g) * 128 + c) * 128 + (j & 127)] * pscale[L * 512 + j]; }
                      else if (j >= 512) x = wpw[((size_t)L * 512 + (kp - 512)) * 512 + (j - 512)]; }
                  v[q] = x; }
              ov[u] = pk2(v[0], v[1]); }
#pragma unroll
          for (int u = 0; u < 8; ++u) { const int i = i0 + u * NT; if (i < DEPTH * 1024 * 512) bd[i] = ov[u]; } } }
}
__device__ __forceinline__ float quant_row_store(const f32x4 (&y)[8], unsigned char* qrow, int lane) {
    float am = 0.f;
#pragma unroll
    for (int j = 0; j < 8; ++j) am = fmaxf(fmaxf(am, fmaxf(fabsf(y[j].x), fabsf(y[j].y))), fmaxf(fabsf(y[j].z), fabsf(y[j].w)));
    am = wave_max(am); const float iv = am > 0.f ? 127.f / am : 0.f;
    GAS unsigned* o4 = (GAS unsigned*)qrow + lane;
#pragma unroll
    for (int j = 0; j < 8; ++j) o4[64 * j] = q4_i8(y[j].x, y[j].y, y[j].z, y[j].w, iv);
    return am > 0.f ? am * (1.f / 127.f) : 1.f;
}
__device__ __forceinline__ void norm_rows_q(Frame& F, const float* src, const float* gain, unsigned char* Uq, float* sc, int cu = -1, int ncu = 0) {
    const bool contig = ncu == 0 && F.G * NWAVES * 8 == M;
    if (ncu == 0) { cu = F.vcu; ncu = F.G; }
    if (cu < 0) return;
    const int gw = cu * NWAVES + F.wave, NGW = ncu * NWAVES;
    const int m0 = contig ? 8 * gw : gw, mstep = contig ? 1 : NGW, mend = contig ? 8 * gw + 8 : M;
    f32x4 g[8];
#pragma unroll
    for (int j = 0; j < 8; ++j) g[j] = ((const GAS f32x4*)gain)[F.lane + 64 * j];
    f32x4 nv[8];
    if (m0 < mend) { const GAS f32x4* xr = (const GAS f32x4*)(src + (size_t)m0 * DM) + F.lane;
#pragma unroll
        for (int j = 0; j < 8; ++j) nv[j] = xr[64 * j]; }
    for (int m = m0; m < mend; m += mstep) {
        f32x4 v[8]; float s = 0.f;
#pragma unroll
        for (int j = 0; j < 8; ++j) v[j] = nv[j];
        if (m + mstep < mend) { const GAS f32x4* xn = (const GAS f32x4*)(src + (size_t)(m + mstep) * DM) + F.lane;
#pragma unroll
            for (int j = 0; j < 8; ++j) nv[j] = xn[64 * j]; }
#pragma unroll
        for (int j = 0; j < 8; ++j) s += (v[j].x * v[j].x + v[j].y * v[j].y) + (v[j].z * v[j].z + v[j].w * v[j].w);
        const float rstd = 1.f / sqrtf(wave_sum(s) * (1.f / DM) + 1e-6f);
#pragma unroll
        for (int j = 0; j < 8; ++j) v[j] = v[j] * rstd * g[j];
        const float scl = quant_row_store(v, Uq + (size_t)m * DM, F.lane);
        if (F.lane == 0) sc[m] = scl;
    }
}
__device__ __forceinline__ void final_norm(Frame& F, const float* gain) {
    const int gw = F.vcu * NWAVES + F.wave, NGW = F.G * NWAVES; float* outb = F.outp();
    const bool contig = NGW * 8 == M; const int m0 = contig ? 8 * gw : gw, mstep = contig ? 1 : NGW, mend = contig ? 8 * gw + 8 : M;
    f32x4 g[8];
#pragma unroll
    for (int j = 0; j < 8; ++j) g[j] = ((const GAS f32x4*)gain)[F.lane + 64 * j];
    f32x4 nv[8];
    if (m0 < mend) { const GAS f32x4* x0 = (const GAS f32x4*)(outb + (size_t)m0 * DM) + F.lane;
#pragma unroll
        for (int j = 0; j < 8; ++j) nv[j] = x0[64 * j]; }
    for (int m = m0; m < mend; m += mstep) {
        GAS f32x4* xr = (GAS f32x4*)(outb + (size_t)m * DM) + F.lane; f32x4 v[8]; float s = 0.f;
#pragma unroll
        for (int j = 0; j < 8; ++j) v[j] = nv[j];
        if (m + mstep < mend) { const GAS f32x4* xn = (const GAS f32x4*)(outb + (size_t)(m + mstep) * DM) + F.lane;
#pragma unroll
            for (int j = 0; j < 8; ++j) nv[j] = xn[64 * j]; }
#pragma unroll
        for (int j = 0; j < 8; ++j) s += (v[j].x * v[j].x + v[j].y * v[j].y) + (v[j].z * v[j].z + v[j].w * v[j].w);
        const float rstd = 1.f / sqrtf(wave_sum(s) * (1.f / DM) + 1e-6f);
#pragma unroll
        for (int j = 0; j < 8; ++j) xr[64 * j] = v[j] * rstd * g[j];
    }
}
__device__ __forceinline__ void ffn_norm_phase(Frame& F, const float* gain, const float* wrouter, unsigned char* U, bool moe) {
    float* outb = F.outp(); unsigned char* wsb = F.wsp();
    if (!moe) { norm_rows_q(F, outb, gain, U, (float*)(wsb + WS_SAS)); return; }
    LAS float* wl = (LAS float*)(F.lds + RING_OFF);
    LAS int* mo = (LAS int*)(F.lds + MOE_OFF);
    for (int c = F.tid; c < DM; c += NWAVES * 64) { const f32x4 a = ((const GAS f32x4*)wrouter)[2 * c], b = ((const GAS f32x4*)wrouter)[2 * c + 1];
        wl[0 * DM + c] = a.x; wl[1 * DM + c] = a.y; wl[2 * DM + c] = a.z; wl[3 * DM + c] = a.w; wl[4 * DM + c] = b.x; wl[5 * DM + c] = b.y; wl[6 * DM + c] = b.z; wl[7 * DM + c] = b.w; }
    if (F.tid < 8) mo[48 + F.tid] = 0;
    __syncthreads();
    f32x4 g[8];
#pragma unroll
    for (int j = 0; j < 8; ++j) g[j] = ((const GAS f32x4*)gain)[F.lane + 64 * j];
    f32x4 nv[8];
    { const GAS f32x4* x0 = (const GAS f32x4*)(outb + (size_t)(64 * F.vcu + 8 * F.wave) * DM) + F.lane;
#pragma unroll
      for (int j = 0; j < 8; ++j) nv[j] = x0[64 * j]; }
    for (int k = 0; k < 8; ++k) {
        const int m = 64 * F.vcu + 8 * F.wave + k;
        f32x4 v[8]; float s = 0.f;
#pragma unroll
        for (int j = 0; j < 8; ++j) v[j] = nv[j];
        if (k + 1 < 8) { const GAS f32x4* xn = (const GAS f32x4*)(outb + (size_t)(m + 1) * DM) + F.lane;
#pragma unroll
            for (int j = 0; j < 8; ++j) nv[j] = xn[64 * j]; }
#pragma unroll
        for (int j = 0; j < 8; ++j) s += (v[j].x * v[j].x + v[j].y * v[j].y) + (v[j].z * v[j].z + v[j].w * v[j].w);
        const float rstd = 1.f / sqrtf(wave_sum(s) * (1.f / DM) + 1e-6f);
        float lg[8];
#pragma unroll
        for (int e = 0; e < 8; ++e) lg[e] = 0.f;
#pragma unroll
        for (int j = 0; j < 8; ++j) { const f32x4 y = v[j] * rstd * g[j]; v[j] = y;
#pragma unroll
            for (int e = 0; e < 8; ++e) { const f32x4 w = ((const LAS f32x4*)(wl + e * DM))[F.lane + 64 * j]; lg[e] += (y.x * w.x + y.y * w.y) + (y.z * w.z + y.w * w.w); } }
#pragma unroll
        for (int e = 0; e < 8; ++e) lg[e] = wave_sum(lg[e]);
        const float scl = quant_row_store(v, U + (size_t)m * DM, F.lane);
        int i0 = 0; float l0 = lg[0];
#pragma unroll
        for (int e = 1; e < 8; ++e) if (lg[e] > l0) { l0 = lg[e]; i0 = e; }
        int i1 = -1; float l1 = -INFINITY;
#pragma unroll
        for (int e = 0; e < 8; ++e) if (e != i0 && lg[e] > l1) { l1 = lg[e]; i1 = e; }
        const float g0 = 1.f / (1.f + expf(l1 - l0)), g1 = 1.f - g0;
        if (F.lane == 0) { v4u sv; sv.x = (unsigned)i0; sv.y = (unsigned)i1; sv.z = __float_as_uint(g0); sv.w = __float_as_uint(g1); ((GAS v4u*)(wsb + WS_SEL))[m] = sv; ((GAS float*)(wsb + WS_SATOK))[m] = scl;
            atomicAdd((int*)&mo[48 + i0], 1); atomicAdd((int*)&mo[48 + i1], 1); }
    }
    __syncthreads();
    if (F.tid < 8) ((GAS int*)(wsb + WS_HIST))[F.vcu * 8 + F.tid] = mo[48 + F.tid];
}
__device__ __forceinline__ void moe_offsets(Frame& F) {
    LAS int* mo = (LAS int*)(F.lds + MOE_OFF);
    __syncthreads();
    if (F.tid < 48) mo[F.tid] = 0;
    __syncthreads();
    if (F.tid < 256) { const GAS v4i* hp = (const GAS v4i*)(F.wsp() + WS_HIST) + 2 * F.tid; const v4i a = hp[0], b = hp[1]; const int h[8] = {a.x, a.y, a.z, a.w, b.x, b.y, b.z, b.w};
#pragma unroll
        for (int e = 0; e < 8; ++e) { const int t = wave_sum_i(h[e]), p = wave_sum_i(F.tid < F.vcu ? h[e] : 0);
            if (F.lane == 0) { atomicAdd((int*)&mo[32 + e], t); atomicAdd((int*)&mo[16 + e], p); } } }
    __syncthreads();
    if (F.tid == 0) { int t = 0; mo[0] = 0;
#pragma unroll
        for (int e = 0; e < 8; ++e) { t += (mo[32 + e] + 255) >> 8; mo[e + 1] = t; } }
    __syncthreads();
}
__device__ __forceinline__ void moe_permute(Frame& F, const unsigned char* U, unsigned char* XP) {
    moe_offsets(F);
    LAS int* mo = (LAS int*)(F.lds + MOE_OFF);
    LAS int* sl = (LAS int*)(F.lds + RING_OFF);
    unsigned char* wsb = F.wsp();
    if (F.wave == 0) { const int m = 64 * F.vcu + F.lane; const v4u sv = ((const GAS v4u*)(wsb + WS_SEL))[m]; const int e0 = (int)sv.x, e1 = (int)sv.y; int r0 = 0, r1 = 0;
        const unsigned long long lt = (1ull << F.lane) - 1ull;
#pragma unroll
        for (int e = 0; e < 8; ++e) { const unsigned long long both = __ballot(e0 == e) | __ballot(e1 == e); const int before = __popcll(both & lt), base = 256 * mo[e] + mo[16 + e];
            if (e0 == e) r0 = base + before; if (e1 == e) r1 = base + before; }
        sl[2 * F.lane] = r0; sl[2 * F.lane + 1] = r1; ((GAS int*)(wsb + WS_SEL + 512 * 1024))[2 * m] = r0; ((GAS int*)(wsb + WS_SEL + 512 * 1024))[2 * m + 1] = r1; }
    __syncthreads();
    v4u xa[8], xb[8]; float scv[8];
#pragma unroll
    for (int k = 0; k < 8; ++k) { const int m = 64 * F.vcu + 8 * F.wave + k; const GAS v4u* src = (const GAS v4u*)(U + (size_t)m * DM) + F.lane; xa[k] = src[0]; xb[k] = src[64]; scv[k] = ((const GAS float*)(wsb + WS_SATOK))[m]; }
#pragma unroll
    for (int k = 0; k < 8; ++k) { const int t = 8 * F.wave + k; const int s0 = sl[2 * t], s1 = sl[2 * t + 1];
        GAS v4u* d0 = (GAS v4u*)(XP + (size_t)s0 * DM) + F.lane; GAS v4u* d1 = (GAS v4u*)(XP + (size_t)s1 * DM) + F.lane;
        d0[0] = xa[k]; d0[64] = xb[k]; d1[0] = xa[k]; d1[64] = xb[k];
        if (F.lane == 0) { ((GAS float*)(wsb + WS_SAS))[s0] = scv[k]; ((GAS float*)(wsb + WS_SAS))[s1] = scv[k]; } }
}
__device__ __forceinline__ void combine_norm(Frame& F, const bf16* Y, const bf16* YP, const float* gain, unsigned char* U, bool moe, bool sliced) {
    const int gw = F.vcu * NWAVES + F.wave, NGW = F.G * NWAVES; float* outb = F.outp(); unsigned char* wsb = F.wsp();
    f32x4 g[8];
#pragma unroll
    for (int j = 0; j < 8; ++j) g[j] = ((const GAS f32x4*)gain)[F.lane + 64 * j];
    v4u nsv = (v4u){0u, 0u, 0u, 0u}; int ns0 = gw, ns1 = gw;
    if (moe && gw < M) { nsv = ((const GAS v4u*)(wsb + WS_SEL))[gw]; ns0 = ((const GAS int*)(wsb + WS_SEL + 512 * 1024))[2 * gw]; ns1 = ((const GAS int*)(wsb + WS_SEL + 512 * 1024))[2 * gw + 1]; }
    for (int m = gw; m < M; m += NGW) {
        int s0 = m, s1 = m; float g0 = 1.f, g1 = 0.f;
        if (moe) { g0 = __uint_as_float(nsv.z); g1 = __uint_as_float(nsv.w); s0 = ns0; s1 = ns1;
            const int mn = m + NGW; if (mn < M) { nsv = ((const GAS v4u*)(wsb + WS_SEL))[mn]; ns0 = ((const GAS int*)(wsb + WS_SEL + 512 * 1024))[2 * mn]; ns1 = ((const GAS int*)(wsb + WS_SEL + 512 * 1024))[2 * mn + 1]; } }
        GAS f32x4* xr = (GAS f32x4*)(outb + (size_t)m * DM) + F.lane; const GAS v2u* y0 = (const GAS v2u*)(Y + (size_t)s0 * DM) + F.lane; const GAS v2u* y1 = (const GAS v2u*)(Y + (size_t)s1 * DM) + F.lane;
        const bool p0 = sliced && s0 >= 32768, p1 = sliced && s1 >= 32768;
        const GAS v2u* q0 = (const GAS v2u*)(YP + (size_t)(s0 - 32768) * DM) + F.lane; const GAS v2u* q1 = (const GAS v2u*)(YP + (size_t)(s1 - 32768) * DM) + F.lane;
        f32x4 v[8]; v2u ya[8], yb[8]; float s = 0.f;
#pragma unroll
        for (int j = 0; j < 8; ++j) { v[j] = xr[64 * j]; ya[j] = (v2u){0u, 0u}; yb[j] = (v2u){0u, 0u}; }
        if (!p0) {
#pragma unroll
            for (int j = 0; j < 8; ++j) ya[j] = y0[64 * j]; }
        if (moe && !p1) {
#pragma unroll
            for (int j = 0; j < 8; ++j) yb[j] = y1[64 * j]; }
#pragma unroll
        for (int j = 0; j < 8; ++j) { v[j].x += g0 * bflo(ya[j].x); v[j].y += g0 * bfhi(ya[j].x); v[j].z += g0 * bflo(ya[j].y); v[j].w += g0 * bfhi(ya[j].y);
            v[j].x += g1 * bflo(yb[j].x); v[j].y += g1 * bfhi(yb[j].x); v[j].z += g1 * bflo(yb[j].y); v[j].w += g1 * bfhi(yb[j].y); }
        if (p0) {
#pragma unroll
            for (int k = 0; k < 4; ++k)
#pragma unroll
                for (int j = 0; j < 8; ++j) { const v2u a = q0[(size_t)k * (2048 * 2048 / 4) + 64 * j]; v[j].x += g0 * bflo(a.x); v[j].y += g0 * bfhi(a.x); v[j].z += g0 * bflo(a.y); v[j].w += g0 * bfhi(a.y); } }
        if (moe && p1) {
#pragma unroll
            for (int k = 0; k < 4; ++k)
#pragma unroll
                for (int j = 0; j < 8; ++j) { const v2u b = q1[(size_t)k * (2048 * 2048 / 4) + 64 * j]; v[j].x += g1 * bflo(b.x); v[j].y += g1 * bfhi(b.x); v[j].z += g1 * bflo(b.y); v[j].w += g1 * bfhi(b.y); } }
#pragma unroll
        for (int j = 0; j < 8; ++j) { xr[64 * j] = v[j]; s += (v[j].x * v[j].x + v[j].y * v[j].y) + (v[j].z * v[j].z + v[j].w * v[j].w); }
        const float rstd = 1.f / sqrtf(wave_sum(s) * (1.f / DM) + 1e-6f);
#pragma unroll
        for (int j = 0; j < 8; ++j) v[j] = v[j] * rstd * g[j];
        const float scl = quant_row_store(v, U + (size_t)m * DM, F.lane);
        if (F.lane == 0) ((GAS float*)(wsb + WS_SATOK))[m] = scl;
    }
}
__device__ __forceinline__ void unpack8(const v4u x, float (&f)[8]) { f[0] = bflo(x.x); f[1] = bfhi(x.x); f[2] = bflo(x.y); f[3] = bfhi(x.y); f[4] = bflo(x.z); f[5] = bfhi(x.z); f[6] = bflo(x.w); f[7] = bfhi(x.w); }
__device__ __forceinline__ v4u pack8f(const float (&f)[8]) { v4u o; o.x = pk2(f[0], f[1]); o.y = pk2(f[2], f[3]); o.z = pk2(f[4], f[5]); o.w = pk2(f[6], f[7]); return o; }
__device__ __forceinline__ void thin_phase(Frame& F, int L) {
    LAS float* dwl = (LAS float*)(F.lds + RING_OFF);
    { const GAS f32x4* dw = (const GAS f32x4*)((const float*)F.ptr(12) + (size_t)L * 31 * 512); for (int i = F.tid; i < 31 * 512 / 4; i += NWAVES * 64) ((LAS f32x4*)dwl)[i] = dw[i]; }
    const float lam_init = L == 0 ? LAM_INIT0 : LAM_INIT1;
    float lam; { const float a = ((const float*)F.ptr(5))[L * 64 + F.lane] * ((const float*)F.ptr(6))[L * 64 + F.lane], b = ((const float*)F.ptr(7))[L * 64 + F.lane] * ((const float*)F.ptr(8))[L * 64 + F.lane];
        lam = expf(wave_sum(a)) - expf(wave_sum(b)) + lam_init; }
    __syncthreads();
    unsigned char* wsb = F.wsp(); const float* subg = F.inf(9) + L * 128; const float* cbias = F.inf(13) + L * 512; const float* clng = F.inf(14) + L * 512; const float* clnb = F.inf(15) + L * 512;
    const bf16* O0 = (const bf16*)(wsb + WS_O0); const bf16* O1 = (const bf16*)(wsb + WS_O1); const bf16* ZP = (const bf16*)(wsb + WS_ZP); const bf16* CG = (const bf16*)(wsb + WS_CG);
    bf16* CAT = (bf16*)(wsb + WS_CAT);
    const int lane = F.lane;
    for (int task = F.vcu * NWAVES + F.wave; task < M / 8; task += F.G * NWAVES) {
        const int T0 = task * 8, s0 = T0 & (SEQ - 1);
        { const int col = (lane >> 3) * 128 + (lane & 7) * 16; float gn[16];
#pragma unroll
          for (int q = 0; q < 4; ++q) { const f32x4 t = ((const GAS f32x4*)(subg + (lane & 7) * 16))[q]; gn[4 * q] = t.x; gn[4 * q + 1] = t.y; gn[4 * q + 2] = t.z; gn[4 * q + 3] = t.w; }
          v4u A0[8], A1[8], B0[8], B1[8];
#pragma unroll
          for (int tt = 0; tt < 8; ++tt) { const size_t ro = (size_t)(T0 + tt) * 1024 + col; A0[tt] = *(const GAS v4u*)(O0 + ro); A1[tt] = *(const GAS v4u*)(O0 + ro + 8); B0[tt] = *(const GAS v4u*)(O1 + ro); B1[tt] = *(const GAS v4u*)(O1 + ro + 8); }
#pragma unroll
          for (int tt = 0; tt < 8; ++tt) { const v4u a0 = A0[tt], a1 = A1[tt], b0 = B0[tt], b1 = B1[tt];
              float x0[8], x1[8], y0[8], y1[8]; unpack8(a0, x0); unpack8(a1, x1); unpack8(b0, y0); unpack8(b1, y1); float ss = 0.f;
#pragma unroll
              for (int q = 0; q < 8; ++q) { x0[q] -= lam * y0[q]; x1[q] -= lam * y1[q]; ss += x0[q] * x0[q] + x1[q] * x1[q]; }
              ss = row8_sum(ss);
              const float r = (1.f - lam_init) / sqrtf(ss * (1.f / 128.f) + 1e-5f);
#pragma unroll
              for (int q = 0; q < 8; ++q) { x0[q] *= r * gn[q]; x1[q] *= r * gn[8 + q]; }
              GAS v4u* o = (GAS v4u*)(CAT + (size_t)(T0 + tt) * 2048 + col); o[0] = pack8f(x0); o[1] = pack8f(x1); } }
        { const int w = 2 << (lane >> 4); float S[8];
#pragma unroll
          for (int q = 0; q < 8; ++q) S[q] = 0.f;
          v4u pre[15], slf[8], tl[8];
#pragma unroll
          for (int j = 1; j < 16; ++j) { pre[j - 1] = (v4u){0u, 0u, 0u, 0u}; if (j < w && s0 - j >= 0) pre[j - 1] = *(const GAS v4u*)(ZP + (size_t)(T0 - j) * 512 + 8 * lane); }
#pragma unroll
          for (int tt = 0; tt < 8; ++tt) { slf[tt] = *(const GAS v4u*)(ZP + (size_t)(T0 + tt) * 512 + 8 * lane); tl[tt] = (v4u){0u, 0u, 0u, 0u}; if (s0 + tt - w + 1 >= 0) tl[tt] = *(const GAS v4u*)(ZP + (size_t)(T0 + tt - w + 1) * 512 + 8 * lane); }
#pragma unroll
          for (int j = 0; j < 15; ++j) { float f[8]; unpack8(pre[j], f);
#pragma unroll
              for (int q = 0; q < 8; ++q) S[q] += f[q]; }
#pragma unroll
          for (int tt = 0; tt < 8; ++tt) { float self[8], o[8], f[8]; unpack8(slf[tt], self); unpack8(tl[tt], f);
              const int cnt = (s0 + tt + 1) < w ? (s0 + tt + 1) : w; const float ic = 1.f / (float)cnt;
#pragma unroll
              for (int q = 0; q < 8; ++q) { S[q] += self[q]; o[q] = S[q] * ic - self[q]; S[q] -= f[q]; }
              *(GAS v4u*)(CAT + (size_t)(T0 + tt) * 2048 + 1024 + 8 * lane) = pack8f(o); } }
        { f32x4 aA[8], aB[8];
#pragma unroll
          for (int tt = 0; tt < 8; ++tt) { aA[tt] = (f32x4){0.f, 0.f, 0.f, 0.f}; aB[tt] = (f32x4){0.f, 0.f, 0.f, 0.f}; }
          v4u xq[8], xn[8];
#pragma unroll
          for (int q = 0; q < 8; ++q) { xq[q] = (v4u){0u, 0u, 0u, 0u}; if (s0 - 30 + q >= 0) xq[q] = *(const GAS v4u*)(CG + (size_t)(T0 - 30 + q) * 512 + 8 * lane); }
#pragma unroll 1
          for (int c = 0; c < 5; ++c) {
#pragma unroll
              for (int q = 0; q < 8; ++q) { const int rr = 8 * (c + 1) + q; xn[q] = (v4u){0u, 0u, 0u, 0u}; if (rr < 38 && s0 - 30 + rr >= 0) xn[q] = *(const GAS v4u*)(CG + (size_t)(T0 - 30 + rr) * 512 + 8 * lane); }
              f32x4 fa[8], fb[8];
#pragma unroll
              for (int q = 0; q < 8; ++q) { float f[8]; unpack8(xq[q], f); fa[q] = (f32x4){f[0], f[1], f[2], f[3]}; fb[q] = (f32x4){f[4], f[5], f[6], f[7]}; }
#pragma unroll
              for (int dj = -7; dj <= 7; ++dj) { const int j = 8 * c + dj;
                  if (j >= 0 && j <= 30) { const LAS f32x4* wp = (const LAS f32x4*)(dwl + j * 512 + 8 * lane); const f32x4 w0 = wp[0], w1 = wp[1];
#pragma unroll
                      for (int tt = 0; tt < 8; ++tt) { const int q = dj + tt; if (q >= 0 && q < 8) { aA[tt] += w0 * fa[q]; aB[tt] += w1 * fb[q]; } } } }
#pragma unroll
              for (int q = 0; q < 8; ++q) xq[q] = xn[q]; }
          const GAS f32x4* bp = (const GAS f32x4*)(cbias + 8 * lane); const GAS f32x4* gp = (const GAS f32x4*)(clng + 8 * lane); const GAS f32x4* lp = (const GAS f32x4*)(clnb + 8 * lane);
          const f32x4 bA = bp[0], bB = bp[1], gA = gp[0], gB = gp[1], lA = lp[0], lB = lp[1];
#pragma unroll
          for (int tt = 0; tt < 8; ++tt) { f32x4 vA = aA[tt] + bA, vB = aB[tt] + bB;
              const float mean = wave_sum((vA.x + vA.y) + (vA.z + vA.w) + (vB.x + vB.y) + (vB.z + vB.w)) * (1.f / 512.f); vA = vA - mean; vB = vB - mean;
              const float var = wave_sum((vA.x * vA.x + vA.y * vA.y) + (vA.z * vA.z + vA.w * vA.w) + (vB.x * vB.x + vB.y * vB.y) + (vB.z * vB.z + vB.w * vB.w)) * (1.f / 512.f);
              const float rs = 1.f / sqrtf(var + 1e-5f); vA = vA * rs * gA + lA; vB = vB * rs * gB + lB; float o[8] = {vA.x, vA.y, vA.z, vA.w, vB.x, vB.y, vB.z, vB.w};
#pragma unroll
              for (int q = 0; q < 8; ++q) o[q] = o[q] * sigm(o[q]);
              *(GAS v4u*)(CAT + (size_t)(T0 + tt) * 2048 + 1536 + 8 * lane) = pack8f(o); } }
    }
}

struct Args { const void* in[30]; float* out; unsigned char* ws; int ph_lo, ph_hi, li, pad; };
__global__ void __launch_bounds__(NWAVES * 64, 2) mk_fwd(Args args) {
    extern __shared__ __attribute__((aligned(16))) unsigned char lds[];
    LAS unsigned char* const L3 = (LAS unsigned char*)lds;
    const int wave_s = __builtin_amdgcn_readfirstlane((int)threadIdx.x >> 6);
    for (int u = threadIdx.x; u < (LDS_BYTES - LDSCTL_OFF) / 4; u += NWAVES * 64) ((LAS unsigned*)(L3 + LDSCTL_OFF))[u] = 0u;
    __syncthreads();
    if (threadIdx.x == 0) { LAS unsigned long long* t = (LAS unsigned long long*)(L3 + PTR_OFF);
#pragma unroll
        for (int i = 0; i < 30; ++i) t[i] = (unsigned long long)args.in[i];
        t[30] = (unsigned long long)args.out; t[31] = (unsigned long long)args.ws; }
    __syncthreads();
    if (N_LAUNCHES == 1) { const Frame F0 = make_frame(L3, wave_s); (void)xcd_barrier_post((unsigned*)(F0.wsp() + WS_CTL) + CW_BAR, (volatile LAS unsigned*)(L3 + MISC_OFF) + 8); }
#define GRID_BAR() do { if (N_LAUNCHES == 1) { const Frame Fb = make_frame(L3, wave_s); XcdBarrier bar; bar.bar = (unsigned*)(Fb.wsp() + WS_CTL) + CW_BAR; bar.x = xb_xcc_id(); bar.st = (volatile LAS unsigned*)(L3 + MISC_OFF) + 8; xcd_barrier(bar, Fb.tid == 0); } } while (0)
    const int lo = (N_LAUNCHES == 1) ? 0 : args.ph_lo, hi = (N_LAUNCHES == 1) ? N_PHASES : args.ph_hi;
#define IN(k) (lo <= (k) && (k) < hi)
#define F_G_IS(n) ((int)gridDim.x == (n))
#define SEAM(k) do { if (IN(k) && IN((k) + 1)) GRID_BAR(); } while (0)
#ifndef PROBE_DUP
#define PROBE_DUP 0
#endif
#define DUP_BEGIN(b) _Pragma("unroll 1") for (int rep_ = 0; rep_ < (((PROBE_DUP >> (b)) & 1) ? 2 : 1); ++rep_) {
#define DUP_END(b) if (rep_ + 1 < (((PROBE_DUP >> (b)) & 1) ? 2 : 1)) GRID_BAR(); }

    DUP_BEGIN(0) if (IN(0)) { Frame F = make_frame(L3, wave_s); p0_prologue(F); } DUP_END(0)
    SEAM(0);

#pragma unroll 1
    for (int L = 0; L < DEPTH; ++L) {
        const int pb = 1 + 13 * L; const bool moe = (L & 1) != 0; constexpr bool ALL_F8 = (DOWN_I8 == 3u) && MOE_DOWN_F8;
        const bool dq = ALL_F8 ? true : ((DOWN_I8 >> L) & 1u) != 0u; const bool f8 = ALL_F8 ? true : (dq && MOE_DOWN_F8);
        DUP_BEGIN(6) if (IN(pb + 0)) { Frame F = make_frame(L3, wave_s); unsigned char* ws = F.wsp(); if (L == 0 && F.G > 64) norm_rows_q(F, F.inf(0), F.inf(3), (unsigned char*)(ws + WS_U), (float*)(ws + WS_SATOK), (int)blockIdx.x - 64, F.G - 64);
            else norm_rows_q(F, L == 0 ? F.inf(0) : (const float*)F.outp(), F.inf(3) + L * DM, (unsigned char*)(ws + WS_U), (float*)(ws + WS_SATOK)); } DUP_END(6)
        if (IN(pb + 0) && L == 0) { Frame F = make_frame(L3, wave_s); unsigned char* ws = F.wsp();
            pg8::Gemm g{(const bf16*)(ws + WS_WOHI), (const bf16*)(ws + WS_BD), 2 * DM, 1024, 1024, (size_t)1024 * 1024 * 2}; pg8::GOrder S; S.init(16, 4, F.G, (int)blockIdx.x); S.ts[1] = 8;
            pg8::EpiBf16<0> E{(bf16*)(ws + WS_WOUT) + 1024, DM, nullptr, 0, 0, 1.f};
            pg8::gemm_phase<pg8::EpiBf16<0>, pg8::GOrder, PG8_ALIGN, PG8_SP2>(F.lds + RING_OFF, g, S, E, F.tid);
        }
        SEAM(pb + 0);
        DUP_BEGIN(1) if (IN(pb + 1)) { Frame F = make_frame(L3, wave_s); unsigned char* ws = F.wsp();
            pg8::Gemm g{(const bf16*)(ws + WS_U), (const bf16*)(ws + WS_WIN + (size_t)L * INC * DM), M, INC, DM / 2, 0};   pg8::GOrder S; S.init(M / 256, INC / 256, F.G, (int)blockIdx.x);
            pg8::EpiIn E{(bf16*)(ws + WS_Q), (bf16*)(ws + WS_K), (bf16*)(ws + WS_V), (bf16*)(ws + WS_ZP), (bf16*)(ws + WS_CG), (const float*)(ws + WS_ROPE), attn_body::C2, (const float*)(ws + WS_SATOK), (const float*)(ws + WS_SWIN) + L * INC};
            pg8::gemm_phase<pg8::EpiIn, pg8::GOrder, PG8_ALIGN, PG8_SP2, 1>(F.lds + RING_OFF, g, S, E, F.tid);
        } DUP_END(1)
        if (IN(pb + 1)) {
            { Frame F = make_frame(L3, wave_s); unsigned char* ws = F.wsp();
              pg8::Gemm g{(const bf16*)(ws + WS_PBF) + (size_t)L * M * PLED, (const bf16*)(ws + WS_WPP) + (size_t)L * DM * PLED, M, DM, PLED, 0}; pg8::GOrder S; S.init(M / 512, DM / 256, F.G / 2, (int)blockIdx.x - F.G / 2);
              pg8::EpiBf16<0> E{(bf16*)(ws + WS_PP), DM, nullptr, 0, 0, 1.f};
              pg8::gemm_phase<pg8::EpiBf16<0>, pg8::GOrder, PG8_ALIGN, PG8_SP2>(F.lds + RING_OFF, g, S, E, F.tid); }
            if (L == 0 && F_G_IS(256)) { const int j = (int)blockIdx.x - 128;
                if (j >= 0 && j < NS_WIN1 - NS_PRO) { Frame F = make_frame(L3, wave_s); strip_range(F, NS_PRO, NS_WIN1, j, NS_WIN1 - NS_PRO); } }
        }
        SEAM(pb + 1);
        DUP_BEGIN(2) if (IN(pb + 2)) {
#pragma unroll 1
          for (int part = 0; part < 2; ++part) {
            if ((int)((blockIdx.x >> 3) & 1u) == part) { Frame F = make_frame(L3, wave_s);
                if (L == 0) { strip_range(F, NS_WIN1, NS_XHALF); down_q_items(F, 0, 1); }
                else { strip_range(F, NS_XHALF, NSTRIP_ALL); down_q_items(F, 1, 9, 0, -1); } }
            if (part != 0) continue;
            Frame F = make_frame(L3, wave_s); unsigned char* ws = F.wsp();
            const attn_body::AttnTensors AT{(const attn_body::bf16*)(ws + WS_Q), (const attn_body::bf16*)(ws + WS_K), (const attn_body::bf16*)(ws + WS_V), (attn_body::bf16*)(ws + WS_O0), (attn_body::bf16*)(ws + WS_O1)};
            attn_body::attn_phase<8>((char*)(F.lds + RING_OFF), AT, F.vcu, F.G, F.tid);
          }
        } DUP_END(2)
        SEAM(pb + 2);
        DUP_BEGIN(3) if (IN(pb + 3)) { Frame F = make_frame(L3, wave_s); thin_phase(F, L); } DUP_END(3)
        SEAM(pb + 3);
        if (IN(pb + 5)) {
            { Frame F = make_frame(L3, wave_s); unsigned char* ws = F.wsp();
              pg8::Gemm g{(const bf16*)(ws + WS_CAT), (const bf16*)(ws + WS_WOUT) + (size_t)L * DM * DM, M, DM, DM, 0}; pg8::GOrder S; S.init(M / 256, DM / 256, F.G, (int)blockIdx.x);
              pg8::EpiRes E{L == 0 ? F.inf(0) : (const float*)F.outp(), F.outp()};
              pg8::gemm_phase<pg8::EpiRes, pg8::GOrder, PG8_ALIGN, PG8_SP2>(F.lds + RING_OFF, g, S, E, F.tid); }
            { Frame F = make_frame(L3, wave_s); unsigned char* ws = F.wsp();
              pg8::Gemm g{(const bf16*)(ws + WS_PBF) + (size_t)L * M * PLED + (size_t)(M / 2) * PLED, (const bf16*)(ws + WS_WPP) + (size_t)L * DM * PLED, M / 2, DM, PLED, 0}; pg8::GOrder S; S.init(M / 512, DM / 256, F.G, (int)blockIdx.x);
              pg8::EpiBf16<0> E{(bf16*)(ws + WS_PP) + (size_t)(M / 2) * DM, DM, nullptr, 0, 0, 1.f};
              pg8::gemm_phase<pg8::EpiBf16<0>, pg8::GOrder, PG8_ALIGN, PG8_SP2>(F.lds + RING_OFF, g, S, E, F.tid); }
        }
        SEAM(pb + 5);
        DUP_BEGIN(6) if (IN(pb + 6)) { Frame F = make_frame(L3, wave_s); ffn_norm_phase(F, F.inf(18) + L * DM, F.inf(22), (unsigned char*)(F.wsp() + WS_U), moe); } DUP_END(6)
        SEAM(pb + 6);
        DUP_BEGIN(9) if (IN(pb + 7)) { if (moe) { Frame F = make_frame(L3, wave_s); unsigned char* ws = F.wsp(); moe_permute(F, (const unsigned char*)(ws + WS_U), (unsigned char*)(ws + WS_XP)); } } DUP_END(9)
        if (moe) SEAM(pb + 7);
        DUP_BEGIN(4) if (IN(pb + 8)) {
          if (moe && N_LAUNCHES != 1) { Frame F = make_frame(L3, wave_s); moe_offsets(F); }
          const int nseg = 1, grp = (int)((blockIdx.x >> 3) & 1u);
#pragma unroll 1
          for (int seg = 0; seg < 2; ++seg) {
            if (seg == grp) { Frame F = make_frame(L3, wave_s);
                if (false) { }
                }
            if (seg >= nseg) continue;
            Frame F = make_frame(L3, wave_s);
            pg8::GOrder S; pg8::Gemm g;
            if (moe) { unsigned char* ws = F.wsp(); LAS int* mo = (LAS int*)(F.lds + MOE_OFF); S.init(__builtin_amdgcn_readfirstlane(mo[8]), FF / 128, F.G, (int)blockIdx.x);
#pragma unroll
                for (int e = 1; e < 9; ++e) S.ts[e] = __builtin_amdgcn_readfirstlane(mo[e]);
                g = pg8::Gemm{(const bf16*)(ws + WS_XP), (const bf16*)(ws + WS_WGUE), MAXSLOT, 2 * FF, DM / 2, (size_t)2 * FF * DM}; }
            else { unsigned char* ws = F.wsp(); S.init(M / 256, FF / 128, F.G, (int)blockIdx.x); g = pg8::Gemm{(const bf16*)(ws + WS_U), (const bf16*)(ws + WS_WGUD), M, 2 * FF, DM / 2, 0}; }
            { const int R = (S.nwg + F.G - 1) / F.G; S.r0 = seg * R / nseg; if (seg + 1 < nseg) S.r1 = (seg + 1) * R / nseg; }
            unsigned char* ws2 = F.wsp();
            if (f8) { pg8::EpiSwigluI8<true> E{(bf16*)(ws2 + WS_HPQ), FF, (const float*)(ws2 + WS_SAS), (const float*)(ws2 + WS_SWGU) + (moe ? 2 * FF : 0)};
                pg8::gemm_phase<pg8::EpiSwigluI8<true>, pg8::GOrder, PG8_ALIGN, PG8_SP2, 1>(F.lds + RING_OFF, g, S, E, F.tid); }
            else { pg8::EpiSwigluI8<false> E{(bf16*)(ws2 + WS_HP), FF, (const float*)(ws2 + WS_SAS), (const float*)(ws2 + WS_SWGU) + (moe ? 2 * FF : 0)};
                pg8::gemm_phase<pg8::EpiSwigluI8<false>, pg8::GOrder, PG8_ALIGN, PG8_SP2, 1>(F.lds + RING_OFF, g, S, E, F.tid); }
          }
        } DUP_END(4)
        SEAM(pb + 8);
        DUP_BEGIN(10) if (IN(pb + 9)) { if (dq && !f8) { Frame F = make_frame(L3, wave_s); int nrows = M; if (moe) { moe_offsets(F); nrows = 256 * __builtin_amdgcn_readfirstlane(((LAS int*)(F.lds + MOE_OFF))[8]); } hp_quant(F, nrows); } } DUP_END(10)
        if (dq && !f8) SEAM(pb + 9);
        DUP_BEGIN(5) if (IN(pb + 10)) {
          {
            Frame F = make_frame(L3, wave_s);
            pg8::GOrder S; pg8::Gemm g; const size_t kb = dq ? 1 : 2;
            if (moe) { if (N_LAUNCHES != 1) moe_offsets(F); unsigned char* ws = F.wsp(); LAS int* mo = (LAS int*)(F.lds + MOE_OFF); S.init(__builtin_amdgcn_readfirstlane(mo[8]), DM / 256, F.G, (int)blockIdx.x);
#pragma unroll
                for (int e = 1; e < 9; ++e) S.ts[e] = __builtin_amdgcn_readfirstlane(mo[e]);
                g = pg8::Gemm{(const bf16*)(ws + (dq ? WS_HPQ : WS_HP)), (const bf16*)(ws + WS_WDE), MAXSLOT, DM, dq ? FF / 2 : FF, (size_t)DM * FF * kb}; }
            else { unsigned char* ws = F.wsp(); S.init(M / 256, DM / 256, F.G, (int)blockIdx.x); g = pg8::Gemm{(const bf16*)(ws + (dq ? WS_HPQ : WS_HP)), (const bf16*)(ws + WS_WDD), M, DM, dq ? FF / 2 : FF, 0}; }
            unsigned char* ws2 = F.wsp();
            if (f8) { const int nrt = S.nM;
                if (moe && nrt > 128) { S.nM = 128; S.nwg = 128 * S.nN; }
                pg8::EpiScaleBf16 E{(bf16*)(ws2 + WS_Y), DM, (const float*)(ws2 + WS_SWD) + (moe ? DM : 0), 0};
                pg8::gemm_phase<pg8::EpiScaleBf16, pg8::GOrder, PG8_ALIGN, PG8_SP2, 2>(F.lds + RING_OFF, g, S, E, F.tid);
                if (moe && nrt > 128) { pg8::SliceOrder S2; S2.nitems = (nrt - 128) * 32; S2.c = (int)blockIdx.x; S2.pm0 = 128;
#pragma unroll
                    for (int e = 0; e < 9; ++e) S2.ts[e] = S.ts[e];
                    pg8::Gemm g2 = g; g2.K = FF / 8; g2.ldk = FF / 2; g2.kslice = FF / 4;
                    pg8::EpiScaleBf16 E2{(bf16*)(ws2 + WS_HP) - (size_t)32768 * DM, DM, (const float*)(ws2 + WS_SWD) + DM, (size_t)2048 * 2048};
                    pg8::gemm_phase<pg8::EpiScaleBf16, pg8::SliceOrder, PG8_ALIGN, PG8_SP2, 2>(F.lds + RING_OFF, g2, S2, E2, F.tid); } }
            else             if (dq) { const int nrt = S.nM;
                if (moe && nrt > 128) { S.nM = 128; S.nwg = 128 * S.nN; }
                pg8::EpiDqBf16 E{(bf16*)(ws2 + WS_Y), DM, (const float*)(ws2 + WS_SAH), (const float*)(ws2 + WS_SWD) + (moe ? DM : 0), 0};
                pg8::gemm_phase<pg8::EpiDqBf16, pg8::GOrder, PG8_ALIGN, PG8_SP2, 1>(F.lds + RING_OFF, g, S, E, F.tid);
                if (moe && nrt > 128) { pg8::SliceOrder S2; S2.nitems = (nrt - 128) * 32; S2.c = (int)blockIdx.x; S2.pm0 = 128;
#pragma unroll
                    for (int e = 0; e < 9; ++e) S2.ts[e] = S.ts[e];
                    pg8::Gemm g2 = g; g2.K = FF / 8; g2.ldk = FF / 2; g2.kslice = FF / 4;
                    pg8::EpiDqBf16 E2{(bf16*)(ws2 + WS_HP) - (size_t)32768 * DM, DM, (const float*)(ws2 + WS_SAH), (const float*)(ws2 + WS_SWD) + DM, (size_t)2048 * 2048};
                    pg8::gemm_phase<pg8::EpiDqBf16, pg8::SliceOrder, PG8_ALIGN, PG8_SP2, 1>(F.lds + RING_OFF, g2, S2, E2, F.tid); } }
            else { pg8::EpiBf16<0> E{(bf16*)(ws2 + WS_Y), DM, nullptr, 0, 0, 1.f};
                pg8::gemm_phase<pg8::EpiBf16<0>, pg8::GOrder, PG8_ALIGN, PG8_SP2>(F.lds + RING_OFF, g, S, E, F.tid); }
          }
        } DUP_END(5)
        SEAM(pb + 10);
        if (IN(pb + 11)) { Frame F = make_frame(L3, wave_s); unsigned char* ws = F.wsp(); combine_norm(F, (const bf16*)(ws + WS_Y), (const bf16*)(ws + WS_HP), F.inf(26) + L * DM, (unsigned char*)(ws + WS_U), moe, moe && dq); }
        SEAM(pb + 11);
        if (IN(pb + 12)) { Frame F = make_frame(L3, wave_s); unsigned char* ws = F.wsp();
            pg8::Gemm g{(const bf16*)(ws + WS_U), (const bf16*)(ws + WS_WPG + (size_t)L * DM * DM), M, DM, DM / 2, 0};   pg8::GOrder S; S.init(M / 256, DM / 256, F.G, (int)blockIdx.x);
            pg8::EpiPle E{F.outp(), (const bf16*)(ws + WS_PP), (const float*)(ws + WS_SATOK), (const float*)(ws + WS_SWPG) + L * DM};
            pg8::gemm_phase<pg8::EpiPle, pg8::GOrder, PG8_ALIGN, PG8_SP2, 1>(F.lds + RING_OFF, g, S, E, F.tid);
        }
        SEAM(pb + 12);
    }
    if (IN(27)) { Frame F = make_frame(L3, wave_s); final_norm(F, F.inf(29)); }
#undef IN
#undef F_G_IS
#undef SEAM
#undef GRID_BAR
#undef DUP_BEGIN
#undef DUP_END
}

extern "C" void kernel_launch(void* const* d_in, const int* in_sizes, int n_in, void* d_out, int out_size, void* d_ws, size_t ws_size, hipStream_t stream) {
    static int grid = 0;
    if (grid == 0) {
        if (n_in != 30 || in_sizes[0] != M * DM || out_size != M * DM || ws_size < WS_END) { fprintf(stderr, "kernel_launch: shape/workspace mismatch (n_in %d, ws %zu < %zu); nothing launched\n", n_in, ws_size, (size_t)WS_END); grid = -1; return; }
        int dev = 0, cus = 0;
        if (hipGetDevice(&dev) != hipSuccess || hipDeviceGetAttribute(&cus, hipDeviceAttributeMultiprocessorCount, dev) != hipSuccess) { grid = -1; return; }
        if (hipFuncSetAttribute((const void*)mk_fwd, hipFuncAttributeMaxDynamicSharedMemorySize, LDS_BYTES) != hipSuccess) { fprintf(stderr, "kernel_launch: hipFuncSetAttribute failed\n"); grid = -1; return; }
        int per_cu = 0;
        if (hipOccupancyMaxActiveBlocksPerMultiprocessor(&per_cu, (const void*)mk_fwd, NWAVES * 64, LDS_BYTES) != hipSuccess || per_cu < 1) fprintf(stderr, "kernel_launch: note: occupancy query reports %d workgroups per CU\n", per_cu);
        (void)hipGetLastError();
        grid = cus;
        if (grid != 256) { fprintf(stderr, "kernel_launch: this kernel is dealt for 256 CUs, device has %d; nothing launched\n", cus); grid = -1; return; }
    }
    if (grid < 0) return;
    if (hipMemsetAsync((char*)d_ws + WS_CTL, 0, CTL_ZERO_BYTES, stream) != hipSuccess) return;
    Args a{};
    for (int i = 0; i < 30; ++i) a.in[i] = d_in[i];
    a.out = (float*)d_out; a.ws = (unsigned char*)d_ws; a.pad = 0;
    for (int li = 0; li < N_LAUNCHES; ++li) {
        a.ph_lo = (N_LAUNCHES == 1) ? 0 : li; a.ph_hi = (N_LAUNCHES == 1) ? N_PHASES : li + 1; a.li = li;
        hipLaunchKernelGGL(mk_fwd, dim3(grid), dim3(NWAVES * 64), LDS_BYTES, stream, a);
        if (hipPeekAtLastError() != hipSuccess) break;
    }
}
```
